# Optimizing an MI355X kernel written in HIP

```python
import jax, jax.numpy as jnp
from jax import lax
import numpy as np

D_MODEL = 1024
BATCH = 8
SEQ = 4096
DEPTH = 1

CONV_WIDTH = D_MODEL // 2
CONV_KERNEL = 31
FOURIER_WIDTH = D_MODEL // 2
FOURIER_GROUPS = 4
FOURIER_GROUP_DIM = FOURIER_WIDTH // FOURIER_GROUPS
N_BRANCHES = 2
IN_COLS = 2 * CONV_WIDTH + FOURIER_WIDTH + N_BRANCHES * D_MODEL
N_EXPERTS = 16
CAPACITY_FACTOR = 2
D_FF_EXPERT = 2 * D_MODEL
N_MOD = 6
RMS_EPS = 1e-6
LN_EPS = 1e-5

kernel_name = "hybrid_conformer_fnet_ec_moe_block"


def rms_norm(x, g):
    xf = x.astype(jnp.float32)
    y = xf * lax.rsqrt(jnp.mean(xf * xf, axis=-1, keepdims=True) + RMS_EPS)
    return (y * g.astype(jnp.float32)).astype(x.dtype)


def layer_norm(x, g, b):
    xf = x.astype(jnp.float32)
    mu = jnp.mean(xf, axis=-1, keepdims=True)
    xc = xf - mu
    var = jnp.mean(xc * xc, axis=-1, keepdims=True)
    y = xc * lax.rsqrt(var + LN_EPS)
    return (y * g.astype(jnp.float32) + b.astype(jnp.float32)).astype(x.dtype)


def modulate(u, shift, scale):
    return u * (1.0 + scale[:, None, :]) + shift[:, None, :]


def conformer_branch(v2, dw_w, dw_b, ln_g, ln_b, w_o, b_o):
    a, g = jnp.split(v2, 2, axis=-1)
    v = a * jax.nn.sigmoid(g)
    pad = CONV_KERNEL // 2
    v = lax.conv_general_dilated(
        v, dw_w[:, None, :].astype(v.dtype), window_strides=(1,),
        padding=[(pad, pad)], dimension_numbers=("NWC", "WIO", "NWC"),
        feature_group_count=CONV_WIDTH) + dw_b
    v = jax.nn.silu(layer_norm(v, ln_g, ln_b))
    return v @ w_o + b_o


def fourier_branch(f, w_f, b_f):
    B, S, _ = f.shape
    fg = f.reshape(B, S, FOURIER_GROUPS, FOURIER_GROUP_DIM).astype(jnp.float32)
    fr = jnp.fft.fft2(fg, axes=(1, 3), norm="ortho").real
    fr = fr.reshape(B, S, FOURIER_WIDTH).astype(f.dtype)
    return fr @ w_f + b_f


def expert_choice_ffn(u, router_w, w_gate, w_up, w_down):
    B, S, D = u.shape
    cap = CAPACITY_FACTOR * S // N_EXPERTS
    logits = jnp.einsum("bsd,de->bse", u.astype(jnp.float32), router_w.astype(jnp.float32))
    aff = jax.nn.softmax(logits, axis=-1)
    aff_t = jnp.transpose(aff, (0, 2, 1))
    w, idx = lax.top_k(aff_t, cap)
    bidx = jnp.arange(B)[:, None, None]
    tok = u[bidx, idx]
    hg = jnp.einsum("becd,edf->becf", tok, w_gate)
    hu = jnp.einsum("becd,edf->becf", tok, w_up)
    out = jnp.einsum("becf,efd->becd", jax.nn.silu(hg) * hu, w_down)
    out = out * w[..., None].astype(out.dtype)
    return jnp.zeros_like(u).at[bidx, idx].add(out)


def setup_inputs(seed: int = 0) -> dict:
    key = jax.random.key(seed)
    ks = jax.random.split(key, 24)
    D, L, E, F = D_MODEL, DEPTH, N_EXPERTS, D_FF_EXPERT
    nrm = lambda k, shape, s: jax.random.normal(k, shape, jnp.float32) * s
    return {
        "x": nrm(ks[0], (BATCH, SEQ, D), 1.0),
        "c": nrm(ks[1], (BATCH, D), 1.0),
        "ada_w": nrm(ks[2], (L, D, N_MOD * D), 0.5 * D ** -0.5),
        "ada_b": nrm(ks[3], (L, N_MOD * D), 0.01),
        "norm1_g": 1.0 + nrm(ks[4], (L, D), 0.01),
        "w_in": nrm(ks[5], (L, D, IN_COLS), D ** -0.5),
        "b_in": nrm(ks[6], (L, IN_COLS), 0.01),
        "conv_dw_w": nrm(ks[7], (L, CONV_KERNEL, CONV_WIDTH), CONV_KERNEL ** -0.5),
        "conv_dw_b": nrm(ks[8], (L, CONV_WIDTH), 0.01),
        "conv_ln_g": 1.0 + nrm(ks[9], (L, CONV_WIDTH), 0.01),
        "conv_ln_b": nrm(ks[10], (L, CONV_WIDTH), 0.01),
        "conv_w_out": nrm(ks[11], (L, CONV_WIDTH, D), CONV_WIDTH ** -0.5),
        "conv_b_out": nrm(ks[12], (L, D), 0.01),
        "fourier_w": nrm(ks[13], (L, FOURIER_WIDTH, D), FOURIER_WIDTH ** -0.5),
        "fourier_b": nrm(ks[14], (L, D), 0.01),
        "w_out": nrm(ks[15], (L, D, D), D ** -0.5),
        "b_out": nrm(ks[16], (L, D), 0.01),
        "norm2_g": 1.0 + nrm(ks[17], (L, D), 0.01),
        "router_w": nrm(ks[18], (L, D, E), D ** -0.5),
        "expert_w_gate": nrm(ks[19], (L, E, D, F), D ** -0.5),
        "expert_w_up": nrm(ks[20], (L, E, D, F), D ** -0.5),
        "expert_w_down": nrm(ks[21], (L, E, F, D), F ** -0.5),
        "final_norm_g": 1.0 + nrm(ks[22], (D,), 0.01),
    }


def reference(x, c, ada_w, ada_b, norm1_g, w_in, b_in, conv_dw_w, conv_dw_b,
              conv_ln_g, conv_ln_b, conv_w_out, conv_b_out, fourier_w, fourier_b,
              w_out, b_out, norm2_g, router_w, expert_w_gate, expert_w_up,
              expert_w_down, final_norm_g):
    B, S, D = x.shape
    h = x
    c_act = jax.nn.silu(c)
    for l in range(DEPTH):
        mod = (c_act @ ada_w[l] + ada_b[l]).reshape(B, N_MOD, D)
        shift1, scale1, gate1 = mod[:, 0], mod[:, 1], mod[:, 2]
        shift2, scale2, gate2 = mod[:, 3], mod[:, 4], mod[:, 5]

        u = modulate(rms_norm(h, norm1_g[l]), shift1, scale1)
        proj = u @ w_in[l] + b_in[l]
        c0 = 2 * CONV_WIDTH
        c1 = c0 + FOURIER_WIDTH
        y_conv = conformer_branch(proj[..., :c0], conv_dw_w[l], conv_dw_b[l],
                                  conv_ln_g[l], conv_ln_b[l], conv_w_out[l], conv_b_out[l])
        y_four = fourier_branch(proj[..., c0:c1], fourier_w[l], fourier_b[l])
        gates = jax.nn.sigmoid(proj[..., c1:].reshape(B, S, N_BRANCHES, D))
        merged = gates[:, :, 0] * y_conv + gates[:, :, 1] * y_four
        h = h + gate1[:, None, :] * (merged @ w_out[l] + b_out[l])

        u2 = modulate(rms_norm(h, norm2_g[l]), shift2, scale2)
        y_ffn = expert_choice_ffn(u2, router_w[l], expert_w_gate[l],
                                  expert_w_up[l], expert_w_down[l])
        h = h + gate2[:, None, :] * y_ffn
    return rms_norm(h, final_norm_g)
```

```cpp
#include <hip/hip_runtime.h>
#include <hip/hip_cooperative_groups.h>
#include <cstdio>
#include <cstdint>

#define LAS __attribute__((address_space(3)))
#define GAS __attribute__((address_space(1)))
typedef unsigned short bf16_t;
typedef short bf16x8 __attribute__((ext_vector_type(8)));
typedef float f32x4 __attribute__((ext_vector_type(4)));
typedef float f32x2 __attribute__((ext_vector_type(2)));
typedef unsigned u32x4 __attribute__((ext_vector_type(4)));
typedef unsigned u32x2 __attribute__((ext_vector_type(2)));
typedef int i32x8 __attribute__((ext_vector_type(8)));

constexpr int Bn = 8, S = 4096, D = 1024, T = Bn * S;
constexpr int CW = 512, CK = 31, FW = 512, FG = 4, FGD = 128;
constexpr int INC = 2 * CW + FW + 2 * D;
constexpr int E = 16, CAP = 2 * S / E;
constexpr int F = 2 * D;
constexpr int NMOD = 6;
constexpr int ME = Bn * CAP;
constexpr int NWAVES = 8, NTHR = 512;

__device__ __forceinline__ float sigmoidf_(float x) { return __builtin_amdgcn_rcpf(1.f + __expf(-x)); }
__device__ __forceinline__ float siluf_(float x) { return x * __builtin_amdgcn_rcpf(1.f + __expf(-x)); }
__device__ __forceinline__ unsigned f2bf(float f) { unsigned u = __builtin_bit_cast(unsigned, f); return (u + 0x7fffu + ((u >> 16) & 1u)) >> 16; }
__device__ __forceinline__ unsigned pk2(float lo, float hi) { return f2bf(lo) | (f2bf(hi) << 16); }
__device__ __forceinline__ unsigned cvt_pk_bf16(float lo, float hi) { unsigned r; asm volatile("v_cvt_pk_bf16_f32 %0, %1, %2" : "=v"(r) : "v"(lo), "v"(hi)); return r; }
__device__ __forceinline__ float bf_lo(unsigned w) { return __builtin_bit_cast(float, w << 16); }
__device__ __forceinline__ float bf_hi(unsigned w) { return __builtin_bit_cast(float, w & 0xffff0000u); }
__device__ __forceinline__ float wave_sum(float v) {
#pragma unroll
    for (int o = 1; o < 64; o <<= 1) v += __shfl_xor(v, o);
    return v;
}
__device__ __forceinline__ u32x2 pack8_f8(const f32x4 v0, const f32x4 v1, const float sc) {
    unsigned a = 0u, b = 0u;
    a = __builtin_amdgcn_cvt_pk_fp8_f32(v0[0] * sc, v0[1] * sc, a, false); a = __builtin_amdgcn_cvt_pk_fp8_f32(v0[2] * sc, v0[3] * sc, a, true);
    b = __builtin_amdgcn_cvt_pk_fp8_f32(v1[0] * sc, v1[1] * sc, b, false); b = __builtin_amdgcn_cvt_pk_fp8_f32(v1[2] * sc, v1[3] * sc, b, true);
    return (u32x2){a, b};
}
#define LDS_WAIT() asm volatile("s_waitcnt lgkmcnt(0)" ::: "memory")
#define VM_WAIT() asm volatile("s_waitcnt vmcnt(0)" ::: "memory")

namespace pg8 {
constexpr int BM = 256, BK = 64, HALF = 128, HTB = HALF * BK * 2  , STAGE_BYTES = 8 * HTB, NXCD = 8, WGM = 8;
__host__ __device__ __forceinline__ int lds_byte(int r, int c) { const int st = (r >> 4) * 2 + (c >> 5), rr = r & 15, cc = c & 31, ob = rr * 64 + cc * 2; return st * 1024 + (ob ^ (((ob >> 9) & 1) << 5)); }
__host__ __device__ __forceinline__ void stage_rc(int b, int& R, int& C) { const int st = b / 1024, sb = b % 1024, swz = sb ^ (((sb >> 9) & 1) << 5); R = (st >> 1) * 16 + swz / 64; C = (st & 1) * 32 + (swz % 64) / 2; }
__host__ __device__ __forceinline__ int f8_off(int r, int fq) { const int rr = r & 15; return ((r >> 4) * 2 + (fq >> 1)) * 1024 + ((rr * 64 + 32 * (fq & 1)) ^ ((rr >> 3) << 5)); }
__host__ __device__ __forceinline__ int perm32(int rho) { const int n = rho >> 4, i = rho & 15; return 8 * (i >> 2) + 4 * n + (i & 3); }

struct Unit { const char* a; const char* b; const int* rows; int pm, pn, e; };

template <class Epi, class Sched, bool GATHER, bool F8 = false>
__device__ __forceinline__ void gemm_phase(LAS unsigned char* lds, const int KB, const Sched& S, const Epi& E, const int sw = 0x7f7f7f7f, const int sx = 0x7f7f7f7f) {
    int tid_ = threadIdx.x; asm volatile("" : "+v"(tid_));
    const int tid = tid_, wid = __builtin_amdgcn_readfirstlane(tid >> 6), lane = tid & 63, wr = wid >> 2, wc = wid & 3, fr = lane & 15, fq = lane >> 4;
    const int nt = KB / (BK * 2);
    int swv = sw, sxv = sx; if constexpr (F8) { asm volatile("" : "+v"(swv), "+v"(sxv)); }
    unsigned voffA[2], voffB[2]; int R0, C0;
#pragma unroll
    for (int i = 0; i < 2; ++i) { int R, C; stage_rc(tid * 16 + i * 8192, R, C); const int Rb = Epi::PERM ? ((R & ~31) + perm32(R & 31)) : R;
        voffA[i] = (unsigned)(R * KB + C * 2); voffB[i] = (unsigned)(Rb * KB + C * 2); if (i == 0) { R0 = R; C0 = C; } }
    const size_t kstep = (size_t)(BK * 2);
    const size_t hstep = (size_t)HALF * KB;
    const unsigned ldsw = (unsigned)wid * 1024u;
    const int aoff = lds_byte(wr * 64 + fr, fq * 8), boff = lds_byte(wc * 32 + fr, fq * 8);
#define PG8_SA(b, h) (((b) * 2 + (h)) * HTB)
#define PG8_SB(b, h) ((4 + (b) * 2 + (h)) * HTB)
#define PG8_STAGE(bufoff, gbase, voff) do { _Pragma("unroll") for (int _i = 0; _i < 2; ++_i) \
        __builtin_amdgcn_global_load_lds((const unsigned*)((const char*)(gbase) + (voff)[_i]), (LAS unsigned*)(lds + (bufoff) + ldsw + _i * 8192), 16, 0, 0); } while (0)
#define PG8_STGA(bufoff, p, h, v) do { if constexpr (GATHER) { PG8_STAGE(bufoff, p, (v) + 2 * (h)); } else { PG8_STAGE(bufoff, (p) + (h) * hstep, voffA); } } while (0)
#define PG8_LD8(p) __builtin_bit_cast(i32x8, __builtin_shufflevector(*(const LAS u32x4*)(p), *(const LAS u32x4*)((p) + 1024), 0, 1, 2, 3, 4, 5, 6, 7))
#define PG8_LDA(dst, b, h) do { if constexpr (F8) { _Pragma("unroll") for (int m = 0; m < 4; ++m) dst##8[m] = PG8_LD8(lds + PG8_SA(b, h) + aoff + m * 2048); } \
      else { _Pragma("unroll") for (int m = 0; m < 4; ++m) _Pragma("unroll") for (int k = 0; k < 2; ++k) dst[m][k] = *(const LAS bf16x8*)(lds + PG8_SA(b, h) + aoff + m * 2048 + k * 1024); } } while (0)
#define PG8_LDB(dst, b, h) do { if constexpr (F8) { _Pragma("unroll") for (int n = 0; n < 2; ++n) dst##8[n] = PG8_LD8(lds + PG8_SB(b, h) + boff + n * 2048); } \
      else { _Pragma("unroll") for (int n = 0; n < 2; ++n) _Pragma("unroll") for (int k = 0; k < 2; ++k) dst[n][k] = *(const LAS bf16x8*)(lds + PG8_SB(b, h) + boff + n * 2048 + k * 1024); } } while (0)
#define PG8_MMA(ai, bj, At, Bt) do { __builtin_amdgcn_s_setprio(1); if constexpr (F8) { _Pragma("unroll") for (int m = 0; m < 4; ++m) _Pragma("unroll") for (int n = 0; n < 2; ++n) \
        asm volatile("v_mfma_scale_f32_16x16x128_f8f6f4 %0, %1, %2, %0, %3, %4 op_sel_hi:[0,0,0]" : "+v"(acc[ai][bj][m][n]) : "v"(Bt##8[n]), "v"(At##8[m]), "v"(swv), "v"(sxv)); } \
      else { _Pragma("unroll") for (int m = 0; m < 4; ++m) _Pragma("unroll") for (int n = 0; n < 2; ++n) _Pragma("unroll") for (int k = 0; k < 2; ++k) \
        acc[ai][bj][m][n] = __builtin_amdgcn_mfma_f32_16x16x32_bf16(Bt[n][k], At[m][k], acc[ai][bj][m][n], 0, 0, 0); } __builtin_amdgcn_s_setprio(0); } while (0)
#define PG8_WAIT_V(n) asm volatile("s_waitcnt vmcnt(" #n ")" ::: "memory")
#define PG8_WAIT_L(n) asm volatile("s_waitcnt lgkmcnt(" #n ")" ::: "memory")
#define PG8_BAR __builtin_amdgcn_s_barrier()
#define PG8_SCHED __builtin_amdgcn_sched_barrier(0)
#define PG8_ROWS(u, v) do { if constexpr (GATHER) { _Pragma("unroll") for (int _h = 0; _h < 2; ++_h) _Pragma("unroll") for (int _i = 0; _i < 2; ++_i) \
        v[_h * 2 + _i] = (unsigned)((u).rows[_h * 128 + R0 + 64 * _i] * KB + C0 * 2); } } while (0)
    Unit cur, nxt; int ui = 0;
    if (!S.next(0, cur)) return;
    f32x4 acc[2][2][4][2];
#pragma unroll
    for (int a = 0; a < 2; ++a)
#pragma unroll
        for (int b = 0; b < 2; ++b)
#pragma unroll
            for (int m = 0; m < 4; ++m)
#pragma unroll
                for (int n = 0; n < 2; ++n) acc[a][b][m][n] = (f32x4){0.f, 0.f, 0.f, 0.f};
    bf16x8 At[4][2], B0[2][2], B1[2][2]; i32x8 At8[4], B08[2], B18[2];
    unsigned vAc[4] = {0u, 0u, 0u, 0u}, vAn[4] = {0u, 0u, 0u, 0u}, vW[4] = {0u, 0u, 0u, 0u};
    PG8_ROWS(cur, vAc);
    const char* cA = cur.a; const char* cB = cur.b;
    PG8_STAGE(PG8_SB(0, 0), cB, voffB); PG8_STAGE(PG8_SB(0, 1), cB + hstep, voffB); PG8_STGA(PG8_SA(0, 0), cA, 0, vAc); PG8_STGA(PG8_SA(0, 1), cA, 1, vAc);
    if (wr == 1) PG8_BAR;
    PG8_WAIT_V(2); PG8_BAR;
    PG8_STAGE(PG8_SB(1, 0), cB + kstep, voffB); PG8_STGA(PG8_SA(1, 0), cA + kstep, 0, vAc); PG8_STAGE(PG8_SB(1, 1), cB + hstep + kstep, voffB);
    PG8_WAIT_V(6); PG8_BAR;
    for (;;) {
        const bool has_next = S.next(ui + 1, nxt);
        if (has_next) { PG8_ROWS(nxt, vAn); } else {
#pragma unroll
            for (int j = 0; j < 4; ++j) vAn[j] = vAc[j]; }
        const char* nA = has_next ? nxt.a : cA; const char* nB = has_next ? nxt.b : cB;
        for (int t = 0; t < nt; t += 2) {
            const bool last = (t == nt - 2);
            const char* a1 = cA + (size_t)(t + 1) * kstep;
            const char* a2 = last ? nA : cA + (size_t)(t + 2) * kstep; const char* b2 = last ? nB : cB + (size_t)(t + 2) * kstep;
            const char* a3 = a2 + kstep; const char* b3 = b2 + kstep;
            if constexpr (GATHER) {
                if (last) { asm volatile("" ::: "memory");
#pragma unroll
                    for (int j = 0; j < 4; ++j) vW[j] = vAn[j]; }
                else {
#pragma unroll
                    for (int j = 0; j < 4; ++j) vW[j] = vAc[j]; } }
            PG8_LDB(B0, 0, 0); PG8_LDB(B1, 0, 1); PG8_SCHED; PG8_LDA(At, 0, 0); PG8_STGA(PG8_SA(1, 1), a1, 1, vAc);
            PG8_WAIT_V(8); PG8_WAIT_L(0); PG8_BAR; PG8_MMA(0, 0, At, B0); PG8_MMA(0, 1, At, B1); PG8_BAR; PG8_SCHED;
            PG8_LDA(At, 0, 1); PG8_STAGE(PG8_SB(0, 0), b2, voffB); PG8_STAGE(PG8_SB(0, 1), b2 + hstep, voffB); PG8_STGA(PG8_SA(0, 0), a2, 0, vW);
            PG8_WAIT_V(8); PG8_WAIT_L(0); PG8_BAR; PG8_MMA(1, 0, At, B0); PG8_MMA(1, 1, At, B1); PG8_BAR; PG8_SCHED;
            PG8_LDB(B0, 1, 0); PG8_LDB(B1, 1, 1); PG8_SCHED; PG8_LDA(At, 1, 0); PG8_STGA(PG8_SA(0, 1), a2, 1, vW);
            PG8_WAIT_V(8); PG8_WAIT_L(0); PG8_BAR; PG8_MMA(0, 0, At, B0); PG8_MMA(0, 1, At, B1); PG8_BAR; PG8_SCHED;
            PG8_LDA(At, 1, 1); PG8_STAGE(PG8_SB(1, 0), b3, voffB); PG8_STAGE(PG8_SB(1, 1), b3 + hstep, voffB); PG8_STGA(PG8_SA(1, 0), a3, 0, vW);
            PG8_WAIT_V(8); PG8_WAIT_L(0); PG8_BAR; PG8_MMA(1, 0, At, B0); PG8_MMA(1, 1, At, B1); PG8_BAR; PG8_SCHED;
        }
        if (wr == 0) PG8_BAR;
        if constexpr (F8) { asm volatile("s_nop 15\n\ts_nop 15" ::: "memory"); }
        E(acc, cur, wr, wc, fr, fq);
        if (!has_next) break;
#pragma unroll
        for (int a = 0; a < 2; ++a)
#pragma unroll
            for (int b = 0; b < 2; ++b)
#pragma unroll
                for (int m = 0; m < 4; ++m)
#pragma unroll
                    for (int n = 0; n < 2; ++n) acc[a][b][m][n] = (f32x4){0.f, 0.f, 0.f, 0.f};
        cur = nxt; cA = nA; cB = nB; ++ui;
#pragma unroll
        for (int j = 0; j < 4; ++j) vAc[j] = vAn[j];
        if (wr == 1) PG8_BAR;
    }
    PG8_WAIT_V(0);
    PG8_BAR;
#undef PG8_SA
#undef PG8_SB
#undef PG8_STAGE
#undef PG8_STGA
#undef PG8_LDA
#undef PG8_LDB
#undef PG8_MMA
#undef PG8_LD8
#undef PG8_WAIT_V
#undef PG8_WAIT_L
#undef PG8_BAR
#undef PG8_SCHED
#undef PG8_ROWS
}

struct SchedDense {
    const char* A; const char* Bt; int nM, nN, nwg, G, c; size_t tstep;
    __device__ void init(const void* A_, const void* Bt_, int M, int N, int K, int G_, int c_) { A = (const char*)A_; Bt = (const char*)Bt_; nM = M / BM; nN = N / BM; nwg = nM * nN; G = G_; c = c_; tstep = (size_t)BM * K * 2; }
    __device__ bool next(int i, Unit& u) const {
        const long L = (long)i * G + c; if (L >= nwg) return false;
        int wgid = (int)L; { const int q = nwg / NXCD, r = nwg % NXCD, xcd = wgid % NXCD, off = wgid / NXCD; wgid = (xcd < r ? xcd * (q + 1) : r * (q + 1) + (xcd - r) * q) + off; }
        const int nig = WGM * nN, gid = wgid / nig, fm = gid * WGM, gsz = (nM - fm) < WGM ? (nM - fm) : WGM;
        u.pm = fm + ((wgid % nig) % gsz); u.pn = (wgid % nig) / gsz; u.e = 0; u.rows = nullptr;
        u.a = A + (size_t)u.pm * tstep; u.b = Bt + (size_t)u.pn * tstep; return true;
    }
};
}

#ifndef H_DELTA
#define H_DELTA 1
#endif
#ifndef YB_F8
#define YB_F8 1
#endif
#ifndef MOE_F8
#define MOE_F8 1
#endif

namespace epi {
using pg8::Unit;
#define EPI_ROWS(ai, m) (128 * (ai) + 64 * wr + 16 * (m) + fr)
__device__ __forceinline__ u32x4 pack8(const f32x4 v0, const f32x4 v1) { u32x4 w; w.x = cvt_pk_bf16(v0[0], v0[1]); w.y = cvt_pk_bf16(v0[2], v0[3]); w.z = cvt_pk_bf16(v1[0], v1[1]); w.w = cvt_pk_bf16(v1[2], v1[3]); return w; }
__device__ __forceinline__ f32x4 sig4(const f32x4 v) { return (f32x4){sigmoidf_(v[0]), sigmoidf_(v[1]), sigmoidf_(v[2]), sigmoidf_(v[3])}; }
__device__ __forceinline__ f32x4 silu4(const f32x4 v) { return (f32x4){siluf_(v[0]), siluf_(v[1]), siluf_(v[2]), siluf_(v[3])}; }
__device__ __forceinline__ void unpack8(const u32x4 w, f32x4& v0, f32x4& v1) { v0 = (f32x4){bf_lo(w.x), bf_hi(w.x), bf_lo(w.y), bf_hi(w.y)}; v1 = (f32x4){bf_lo(w.z), bf_hi(w.z), bf_lo(w.w), bf_hi(w.w)}; }

struct EpiGlu {
    static constexpr bool PERM = true;
    bf16_t* V; const float* bias;
    __device__ __forceinline__ void operator()(const f32x4 (&acc)[2][2][4][2], const Unit& u, int wr, int wc, int fr, int fq) const {
        const int ch = u.pn * 128 + wc * 32 + 8 * fq;
        f32x4 ba[2], bg[2];
#pragma unroll
        for (int n = 0; n < 2; ++n) { ba[n] = *(const f32x4*)(bias + ch + 4 * n); bg[n] = *(const f32x4*)(bias + CW + ch + 4 * n); }
#pragma unroll
        for (int ai = 0; ai < 2; ++ai)
#pragma unroll
            for (int m = 0; m < 4; ++m) { const size_t row = (size_t)u.pm * 256 + EPI_ROWS(ai, m);
                const f32x4 v0 = (acc[ai][0][m][0] + ba[0]) * sig4(acc[ai][1][m][0] + bg[0]), v1 = (acc[ai][0][m][1] + ba[1]) * sig4(acc[ai][1][m][1] + bg[1]);
                *(u32x4*)(V + row * CW + ch) = pack8(v0, v1); }
    }
};
struct EpiFT {
    static constexpr bool PERM = true;
    bf16_t* FT; const float* bias;
    __device__ __forceinline__ void operator()(const f32x4 (&acc)[2][2][4][2], const Unit& u, int wr, int wc, int fr, int fq) const {
#pragma unroll
        for (int ai = 0; ai < 2; ++ai)
#pragma unroll
            for (int m = 0; m < 4; ++m) { const int ch = u.pm * 256 + EPI_ROWS(ai, m); const float bv = bias[ch];
#pragma unroll
                for (int bj = 0; bj < 2; ++bj) { const int tok = u.pn * 256 + bj * 128 + wc * 32 + 8 * fq; const int b = tok >> 12, s = tok & (S - 1);
                    *(u32x4*)(FT + ((size_t)(b * FW + ch) * S + s)) = pack8(acc[ai][bj][m][0] + bv, acc[ai][bj][m][1] + bv); } }
    }
};
struct EpiFFT {
    static constexpr bool PERM = true;
    bf16_t* YRI;
    __device__ __forceinline__ void operator()(const f32x4 (&acc)[2][2][4][2], const Unit& u, int wr, int wc, int fr, int fq) const {
        const int part = u.pm, chb = u.pn & 1, k2 = (u.pn >> 1) & 15, b = u.pn >> 5;
#pragma unroll
        for (int ai = 0; ai < 2; ++ai)
#pragma unroll
            for (int m = 0; m < 4; ++m) { const int k1 = EPI_ROWS(ai, m);
                bf16_t* rowp = YRI + ((size_t)(b * S + 16 * k1 + k2) * (2 * FW) + part * FW + chb * 256 + wc * 32 + 8 * fq);
#pragma unroll
                for (int bj = 0; bj < 2; ++bj) *(u32x4*)(rowp + bj * 128) = pack8(acc[ai][bj][m][0], acc[ai][bj][m][1]); }
    }
};
struct EpiBias {
    static constexpr bool PERM = true;
    bf16_t* O; int ldc; const float* bias;
    __device__ __forceinline__ void operator()(const f32x4 (&acc)[2][2][4][2], const Unit& u, int wr, int wc, int fr, int fq) const {
        const int col0 = u.pn * 256 + wc * 32 + 8 * fq;
        f32x4 bv[2][2];
#pragma unroll
        for (int bj = 0; bj < 2; ++bj)
#pragma unroll
            for (int n = 0; n < 2; ++n) bv[bj][n] = *(const f32x4*)(bias + col0 + bj * 128 + 4 * n);
#pragma unroll
        for (int ai = 0; ai < 2; ++ai)
#pragma unroll
            for (int m = 0; m < 4; ++m) { bf16_t* rowp = O + ((size_t)u.pm * 256 + EPI_ROWS(ai, m)) * ldc + col0;
#pragma unroll
                for (int bj = 0; bj < 2; ++bj) *(u32x4*)(rowp + bj * 128) = pack8(acc[ai][bj][m][0] + bv[bj][0], acc[ai][bj][m][1] + bv[bj][1]); }
    }
};
struct EpiMerge {
    static constexpr bool PERM = true;
    bf16_t* MG; const bf16_t* YC; const bf16_t* YF; const float* bias;
    __device__ __forceinline__ void operator()(const f32x4 (&acc)[2][2][4][2], const Unit& u, int wr, int wc, int fr, int fq) const {
        const int nn = u.pn * 128 + wc * 32 + 8 * fq;
        f32x4 b0[2], b1[2];
#pragma unroll
        for (int n = 0; n < 2; ++n) { b0[n] = *(const f32x4*)(bias + 2 * CW + FW + nn + 4 * n); b1[n] = *(const f32x4*)(bias + 2 * CW + FW + D + nn + 4 * n); }
#pragma unroll
        for (int ai = 0; ai < 2; ++ai)
#pragma unroll
            for (int m = 0; m < 4; ++m) { const size_t off = ((size_t)u.pm * 256 + EPI_ROWS(ai, m)) * D + nn;
                const u32x4 wc_ = *(const u32x4*)(YC + off), wf_ = *(const u32x4*)(YF + off);
                f32x4 c0, c1, f0, f1; unpack8(wc_, c0, c1); unpack8(wf_, f0, f1);
                const f32x4 v0 = sig4(acc[ai][0][m][0] + b0[0]) * c0 + sig4(acc[ai][1][m][0] + b1[0]) * f0;
                const f32x4 v1 = sig4(acc[ai][0][m][1] + b0[1]) * c1 + sig4(acc[ai][1][m][1] + b1[1]) * f1;
                *(u32x4*)(MG + off) = pack8(v0, v1); }
    }
};
struct EpiResid {
    static constexpr bool PERM = false;
    const float* X; float* H; const float* gate; const float* bias;
    __device__ __forceinline__ void operator()(const f32x4 (&acc)[2][2][4][2], const Unit& u, int wr, int wc, int fr, int fq) const {
        const int col0 = u.pn * 256 + wc * 32 + 4 * fq; const int b = (u.pm * 256) >> 12;
        const float* gp = gate + (size_t)b * NMOD * D + col0; const float* bp = bias + col0;
#pragma unroll
        for (int ai = 0; ai < 2; ++ai) {
            f32x4 xv[4][2][2];
#pragma unroll
            for (int m = 0; m < 4; ++m) { const size_t off = ((size_t)u.pm * 256 + EPI_ROWS(ai, m)) * D + col0;
#pragma unroll
                for (int bj = 0; bj < 2; ++bj)
#pragma unroll
                    for (int n = 0; n < 2; ++n) xv[m][bj][n] = *(const f32x4*)(X + off + bj * 128 + n * 16); }
#pragma unroll
            for (int bj = 0; bj < 2; ++bj)
#pragma unroll
                for (int n = 0; n < 2; ++n) { const f32x4 gv = *(const f32x4*)(gp + bj * 128 + n * 16), bv = *(const f32x4*)(bp + bj * 128 + n * 16);
#pragma unroll
                    for (int m = 0; m < 4; ++m) { const size_t off = ((size_t)u.pm * 256 + EPI_ROWS(ai, m)) * D + col0;
                        *(f32x4*)(H + off + bj * 128 + n * 16) = xv[m][bj][n] + gv * (acc[ai][bj][m][n] + bv); } }
            asm volatile("" ::: "memory");
        }
    }
};
struct EpiDelta {
    static constexpr bool PERM = true;
    bf16_t* DL; const float* gate; const float* bias;
    __device__ __forceinline__ void operator()(const f32x4 (&acc)[2][2][4][2], const Unit& u, int wr, int wc, int fr, int fq) const {
        const int col0 = u.pn * 256 + wc * 32 + 8 * fq; const int b = (u.pm * 256) >> 12;
        f32x4 bv[2][2], gv[2][2];
#pragma unroll
        for (int bj = 0; bj < 2; ++bj)
#pragma unroll
            for (int n = 0; n < 2; ++n) { bv[bj][n] = *(const f32x4*)(bias + col0 + bj * 128 + 4 * n); gv[bj][n] = *(const f32x4*)(gate + (size_t)b * NMOD * D + col0 + bj * 128 + 4 * n); }
#pragma unroll
        for (int ai = 0; ai < 2; ++ai)
#pragma unroll
            for (int m = 0; m < 4; ++m) { bf16_t* rowp = DL + ((size_t)u.pm * 256 + EPI_ROWS(ai, m)) * D + col0;
#pragma unroll
                for (int bj = 0; bj < 2; ++bj) *(u32x4*)(rowp + bj * 128) = pack8(gv[bj][0] * (acc[ai][bj][m][0] + bv[bj][0]), gv[bj][1] * (acc[ai][bj][m][1] + bv[bj][1])); }
    }
};
constexpr float ACT_SC = 2.f, U_SC = 4.f, W_SC = 64.f;
constexpr int MX_U = 0x7d7d7d7d, MX_ACT = 0x7e7e7e7e, MX_W = 0x79797979;
template <bool F8> struct EpiSwiglu {
    static constexpr bool PERM = true;
    void* ACT;
    __device__ __forceinline__ void operator()(const f32x4 (&acc)[2][2][4][2], const Unit& u, int wr, int wc, int fr, int fq) const {
        const int col = u.pn * 128 + wc * 32 + 8 * fq;
#pragma unroll
        for (int ai = 0; ai < 2; ++ai)
#pragma unroll
            for (int m = 0; m < 4; ++m) { const size_t row = (size_t)u.e * ME + u.pm * 256 + EPI_ROWS(ai, m);
                const f32x4 v0 = silu4(acc[ai][0][m][0]) * acc[ai][1][m][0], v1 = silu4(acc[ai][0][m][1]) * acc[ai][1][m][1];
                if constexpr (F8) *(u32x2*)((unsigned char*)ACT + row * F + col) = pack8_f8(v0, v1, ACT_SC);
                else *(u32x4*)((bf16_t*)ACT + row * F + col) = pack8(v0, v1); }
    }
};
constexpr float YB_SC = 32.f;
struct EpiScaleW {
    static constexpr bool PERM = true;
    void* YB; const float* W;
    __device__ __forceinline__ void operator()(const f32x4 (&acc)[2][2][4][2], const Unit& u, int wr, int wc, int fr, int fq) const {
        const int col0 = u.pn * 256 + wc * 32 + 8 * fq;
#pragma unroll
        for (int ai = 0; ai < 2; ++ai)
#pragma unroll
            for (int m = 0; m < 4; ++m) { const size_t row = (size_t)u.e * ME + u.pm * 256 + EPI_ROWS(ai, m); const float w = W[row];
#pragma unroll
                for (int bj = 0; bj < 2; ++bj) {
                    if (YB_F8) *(u32x2*)((unsigned char*)YB + row * D + col0 + bj * 128) = pack8_f8(acc[ai][bj][m][0], acc[ai][bj][m][1], w * YB_SC);
                    else *(u32x4*)((bf16_t*)YB + row * D + col0 + bj * 128) = pack8(acc[ai][bj][m][0] * w, acc[ai][bj][m][1] * w); } }
    }
};
#undef EPI_ROWS
}

namespace pg8 {
struct SchedG1 {
    const char* U; const char* W; const int* rowl; int G, c, esz;
    __device__ bool next(int i, Unit& u) const {
        int e;
        if (G == 256) { if (i >= 16) return false; const int xcd = c & 7, j = c >> 3, ri = i & 7; e = 2 * xcd + (i >> 3); u.pm = (ri & 1) * 8 + (j & 7); u.pn = (ri >> 1) * 4 + (j >> 3); }
        else { const int L = i * G + c; if (L >= E * 256) return false; e = L >> 8; const int l = L & 255; u.pm = l & 15; u.pn = l >> 4; }
        u.e = e; u.a = U; u.rows = rowl + e * ME + u.pm * 256; u.b = W + ((size_t)e * 2 * F + (size_t)u.pn * 256) * D * esz; return true;
    }
};
struct SchedG2 {
    const char* ACT; const char* W; int G, c, esz;
    __device__ bool next(int i, Unit& u) const {
        int e;
        if (G == 256) { if (i >= 4) return false; const int xcd = c & 7, j = c >> 3; e = 2 * xcd + (i >> 1); u.pm = (i & 1) * 8 + (j & 7); u.pn = j >> 3; }
        else { const int L = i * G + c; if (L >= E * 64) return false; e = L >> 6; const int l = L & 63; u.pm = l & 15; u.pn = l >> 4; }
        u.e = e; u.rows = nullptr;
        u.a = ACT + ((size_t)e * ME + (size_t)u.pm * 256) * F * esz; u.b = W + ((size_t)e * D + (size_t)u.pn * 256) * F * esz; return true;
    }
};
}

struct Ctx {
    LAS unsigned char* lds; int tid, lane, wave, vcu, G;
};

__device__ __forceinline__ void transpose_item(const float* W, int ldw, int k0, int n0, bf16_t* WT, int ldt, int dst_row0, LAS float* scr, int lane) {
#pragma unroll 8
    for (int i = 0; i < 32; ++i) { const int kk = 2 * i + (lane >> 5); scr[kk * 33 + (lane & 31)] = W[(size_t)(k0 + kk) * ldw + n0 + (lane & 31)]; }
    LDS_WAIT(); asm volatile("" ::: "memory");
    const int c = lane & 7;
#pragma unroll
    for (int j = 0; j < 4; ++j) { const int n = (lane >> 3) + 8 * j; const LAS float* s = scr + (8 * c) * 33 + n;
        u32x4 o; o.x = pk2(s[0 * 33], s[1 * 33]); o.y = pk2(s[2 * 33], s[3 * 33]); o.z = pk2(s[4 * 33], s[5 * 33]); o.w = pk2(s[6 * 33], s[7 * 33]);
        *(GAS u32x4*)(WT + (size_t)(dst_row0 + n) * ldt + k0 + 8 * c) = o; }
    LDS_WAIT(); asm volatile("" ::: "memory");
}
struct TItem { const float* src; unsigned char* dst; int ldw, ldt; };
__device__ __forceinline__ void titem_load(const TItem& t, int lane, f32x4 (&v)[8]) {
#pragma unroll
    for (int i = 0; i < 8; ++i) v[i] = *(const GAS f32x4*)(t.src + (size_t)(8 * i + (lane >> 3)) * t.ldw + (lane & 7) * 4);
}
__device__ __forceinline__ void titem_store_f8(const TItem& t, int lane, const f32x4 (&v)[8], LAS float* scr, float sc) {
#pragma unroll
    for (int i = 0; i < 8; ++i) { LAS float* d = scr + (8 * i + (lane >> 3)) * 33 + (lane & 7) * 4; d[0] = v[i][0]; d[1] = v[i][1]; d[2] = v[i][2]; d[3] = v[i][3]; }
    LDS_WAIT(); asm volatile("" ::: "memory");
#pragma unroll
    for (int j = 0; j < 2; ++j) { const int idx = lane + 64 * j, n = idx >> 2, c = idx & 3; const LAS float* s = scr + (16 * c) * 33 + n;
        unsigned w[4];
#pragma unroll
        for (int q = 0; q < 4; ++q) { unsigned tt = 0u; tt = __builtin_amdgcn_cvt_pk_fp8_f32(s[(4 * q + 0) * 33] * sc, s[(4 * q + 1) * 33] * sc, tt, false); tt = __builtin_amdgcn_cvt_pk_fp8_f32(s[(4 * q + 2) * 33] * sc, s[(4 * q + 3) * 33] * sc, tt, true); w[q] = tt; }
        *(GAS u32x4*)(t.dst + (size_t)n * t.ldt + 16 * c) = (u32x4){w[0], w[1], w[2], w[3]}; }
    LDS_WAIT(); asm volatile("" ::: "memory");
}
__device__ __forceinline__ int win_row(int n0) {
    if (n0 < 2 * CW) { const int half = n0 / CW, ch = n0 % CW; return 256 * (ch / 128) + 128 * half + (ch % 128); }
    if (n0 < 2 * CW + FW) return n0;
    const int cc = n0 - (2 * CW + FW), half = cc / D, c2 = cc % D; return 2 * CW + FW + 256 * (c2 / 128) + 128 * half + (c2 % 128);
}

struct P {
    const float *x, *c, *ada_w, *ada_b, *norm1_g, *w_in, *b_in, *dw_w, *dw_b, *cln_g, *cln_b, *cw_out, *cb_out, *four_w, *four_b, *w_out, *b_out, *norm2_g, *router_w, *w_gate, *w_up, *w_down, *final_g;
    float* out;
    float* MOD; float* W2F; float* AFF; int* ROWL; float* WTS; short* INV;
    bf16_t *Wt_in, *Wt_conv, *Wt_four, *Wt_out, *D256, *GP, *Wt_gu, *Wt_down;
    bf16_t *U, *V, *FT, *ACONV, *YRI, *YCONV, *YFOUR, *MERGED, *ACT, *YB, *DELTA;
};

__device__ __forceinline__ void titem_store_bf16(const TItem& t, int lane, const f32x4 (&v)[8], LAS float* scr) {
#pragma unroll
    for (int i = 0; i < 8; ++i) { LAS float* d = scr + (8 * i + (lane >> 3)) * 33 + (lane & 7) * 4; d[0] = v[i][0]; d[1] = v[i][1]; d[2] = v[i][2]; d[3] = v[i][3]; }
    LDS_WAIT(); asm volatile("" ::: "memory");
    const int c = lane & 7;
#pragma unroll
    for (int j = 0; j < 4; ++j) { const int n = (lane >> 3) + 8 * j; const LAS float* s = scr + (8 * c) * 33 + n;
        u32x4 o; o.x = pk2(s[0 * 33], s[1 * 33]); o.y = pk2(s[2 * 33], s[3 * 33]); o.z = pk2(s[4 * 33], s[5 * 33]); o.w = pk2(s[6 * 33], s[7 * 33]);
        *(GAS u32x4*)(t.dst + ((size_t)n * t.ldt + 8 * c) * 2) = o; }
    LDS_WAIT(); asm volatile("" ::: "memory");
}
__device__ __forceinline__ TItem small_item(const P& p, int r) {
    constexpr int I1 = (D / 64) * (INC / 32), I2 = (CW / 64) * (D / 32);
    TItem t;
    if (r < I1) { const int kb = r / (INC / 32), nb = r % (INC / 32); t.src = p.w_in + (size_t)(64 * kb) * INC + 32 * nb; t.ldw = INC; t.ldt = D; t.dst = (unsigned char*)(p.Wt_in + (size_t)win_row(32 * nb) * D + 64 * kb); return t; }
    r -= I1;
    if (r < I2) { const int kb = r / (D / 32), nb = r % (D / 32); t.src = p.cw_out + (size_t)(64 * kb) * D + 32 * nb; t.ldw = D; t.ldt = CW; t.dst = (unsigned char*)(p.Wt_conv + (size_t)(32 * nb) * CW + 64 * kb); return t; }
    r -= I2;
    { const int kb = r / (D / 32), nb = r % (D / 32); t.src = p.w_out + (size_t)(64 * kb) * D + 32 * nb; t.ldw = D; t.ldt = D; t.dst = (unsigned char*)(p.Wt_out + (size_t)(32 * nb) * D + 64 * kb); return t; }
}
__device__ __forceinline__ void phase_p0a(const Ctx& X0, const P& p) {
    Ctx X = X0; X.tid = (int)threadIdx.x; asm volatile("" : "+v"(X.tid)); X.lane = X.tid & 63;
    LAS float* scr = (LAS float*)(X.lds + X.wave * 16384);
    const int gw = X.vcu * NWAVES + X.wave, NGW = X.G * NWAVES;
    constexpr int I1 = (D / 64) * (INC / 32), I2 = (CW / 64) * (D / 32), I4 = (D / 64) * (D / 32);
    const bool do_mod = X.vcu < NMOD * D / 32; const int mcol = X.tid & 31, mks = X.tid >> 5, mj0 = X.vcu * 32;
    float mw[64];
    if (do_mod) {
#pragma unroll
        for (int k = 0; k < 64; ++k) mw[k] = p.ada_w[(size_t)(mks * 64 + k) * (NMOD * D) + mj0 + mcol]; }
    const int fg = X.vcu / (D / 16), fn0 = (X.vcu % (D / 16)) * 16;
    f32x4 ftile = (f32x4){0.f, 0.f, 0.f, 0.f};
    if (X.vcu < FG * (D / 16)) ftile = *(const GAS f32x4*)(p.four_w + (size_t)(fg * FGD + (X.tid >> 2)) * D + fn0 + (X.tid & 3) * 4);
    {   f32x4 va[8], vb[8]; TItem cur, nx; int it = gw;
        if (it < I1 + I2 + I4) { cur = small_item(p, it); titem_load(cur, X.lane, va); }
        while (it < I1 + I2 + I4) {
            const int nxt = it + NGW; if (nxt < I1 + I2 + I4) { nx = small_item(p, nxt); titem_load(nx, X.lane, vb); }
            titem_store_bf16(cur, X.lane, va, scr);
#pragma unroll
            for (int i = 0; i < 8; ++i) va[i] = vb[i];
            cur = nx; it = nxt;
        }
    }
    __syncthreads();
    LAS float* ct = (LAS float*)X.lds; LAS float* c128 = ct + S;
    for (int i = X.tid; i < S; i += NTHR) { float sv, cv; sincospif((float)i / (float)(S / 2), &sv, &cv); ct[i] = cv; }
    if (X.tid < FGD) { float sv, cv; sincospif((float)X.tid / 64.f, &sv, &cv); c128[X.tid] = cv; }
    __syncthreads();
    const int gt = X.vcu * NTHR + X.tid, NGT = X.G * NTHR;
    for (int it = gt; it < 512 * 64; it += NGT) { const int r = it >> 6, c0 = (it & 63) * 8; const int part = r >> 8, k1 = r & 255, pc = c0 >> 8, s10 = c0 & 255;
        const int ph = (part == pc) ? 0 : (part == 0 ? -(S / 4) : (S / 4));
        unsigned w[4];
#pragma unroll
        for (int j = 0; j < 4; ++j) { const float a = ct[(16 * k1 * (s10 + 2 * j) + ph) & (S - 1)], b = ct[(16 * k1 * (s10 + 2 * j + 1) + ph) & (S - 1)]; w[j] = pk2(a, b); }
        *(GAS u32x4*)(p.D256 + (size_t)r * 512 + c0) = (u32x4){w[0], w[1], w[2], w[3]}; }
    {
        LAS float* wt = c128 + FGD;
        for (int it = X.vcu; it < FG * (D / 16); it += X.G) { const int g = it / (D / 16), n0 = (it % (D / 16)) * 16;
            __syncthreads();
            if (it == X.vcu) *(LAS f32x4*)(wt + 4 * X.tid) = ftile;
            else for (int i = X.tid; i < FGD * 16; i += NTHR) wt[i] = p.four_w[(size_t)(g * FGD + (i >> 4)) * D + n0 + (i & 15)];
            __syncthreads();
            const int nq = X.tid & 3, c = X.tid >> 2; int idx = 0;
            f32x4 ac = (f32x4){0.f, 0.f, 0.f, 0.f}, as = (f32x4){0.f, 0.f, 0.f, 0.f};
#pragma unroll 8
            for (int j = 0; j < FGD; ++j) { const float tc = c128[idx], ts = c128[(idx + 96) & 127];
                const f32x4 wv = *(const LAS f32x4*)(wt + j * 16 + 4 * nq); ac += wv * tc; as += wv * ts; idx = (idx + c) & 127; }
            *(GAS f32x4*)(p.W2F + (size_t)(g * FGD + c) * D + n0 + 4 * nq) = ac * 0.0013810679320049757f;
            *(GAS f32x4*)(p.W2F + (size_t)(FW + g * FGD + c) * D + n0 + 4 * nq) = as * 0.0013810679320049757f;
        }
    }
    __syncthreads();
    if (do_mod) {
        LAS float* cs = (LAS float*)X.lds;
        LAS float* part = cs + Bn * D;
        for (int i = X.tid; i < Bn * D; i += NTHR) cs[i] = siluf_(p.c[i]);
        __syncthreads();
        const int col = X.tid & 31, ks = X.tid >> 5, j0 = X.vcu * 32;
        float acc[Bn];
#pragma unroll
        for (int b = 0; b < Bn; ++b) acc[b] = 0.f;
#pragma unroll
        for (int k = 0; k < 64; ++k)
#pragma unroll
            for (int b = 0; b < Bn; ++b) acc[b] += cs[b * D + ks * 64 + k] * mw[k];
#pragma unroll
        for (int b = 0; b < Bn; ++b) part[(ks * Bn + b) * 32 + col] = acc[b];
        __syncthreads();
        if (X.tid < Bn * 32) { const int b = X.tid >> 5, cc = X.tid & 31; float s = p.ada_b[j0 + cc];
#pragma unroll
            for (int k2 = 0; k2 < 16; ++k2) s += part[(k2 * Bn + b) * 32 + cc];
            p.MOD[b * NMOD * D + j0 + cc] = s; }
    }
}

__device__ __forceinline__ float row_load_rstd(const float* xr, int lane, f32x4 (&v)[4]) {
    float ss = 0.f;
#pragma unroll
    for (int j = 0; j < 2; ++j) { v[2 * j] = *(const GAS f32x4*)(xr + 8 * lane + 512 * j); v[2 * j + 1] = *(const GAS f32x4*)(xr + 8 * lane + 512 * j + 4); }
#pragma unroll
    for (int q = 0; q < 4; ++q) ss += (v[q][0] * v[q][0] + v[q][1] * v[q][1]) + (v[q][2] * v[q][2] + v[q][3] * v[q][3]);
    return 1.f / sqrtf(wave_sum(ss) * (1.f / D) + 1e-6f);
}
__device__ __forceinline__ void row_issue(const float* xr, int lane, f32x4 (&v)[4]) {
#pragma unroll
    for (int j = 0; j < 4; ++j) v[j] = *(const GAS f32x4*)(xr + 4 * lane + 256 * j);
}
__device__ __forceinline__ float row_rstd(const f32x4 (&v)[4]) {
    float ss = 0.f;
#pragma unroll
    for (int q = 0; q < 4; ++q) ss += (v[q][0] * v[q][0] + v[q][1] * v[q][1]) + (v[q][2] * v[q][2] + v[q][3] * v[q][3]);
    return 1.f / sqrtf(wave_sum(ss) * (1.f / D) + 1e-6f);
}
__device__ __forceinline__ TItem moe_item(const P& p, int r) {
    constexpr int I5 = (D / 64) * (F / 32), I6 = (F / 64) * (D / 32);
    TItem t;
    if (r < E * 2 * I5) { const int eh = r / I5, q = r % I5, e = eh >> 1, half = eh & 1; const int kb = q / (F / 32), nb = q % (F / 32), n0 = 32 * nb;
        t.src = (half ? p.w_up : p.w_gate) + (size_t)e * D * F + (size_t)(64 * kb) * F + n0; t.ldw = F; t.ldt = D;
        t.dst = (unsigned char*)p.Wt_gu + (size_t)e * 2 * F * D + (size_t)(256 * (n0 / 128) + 128 * half + (n0 % 128)) * D + 64 * kb; }
    else { r -= E * 2 * I5; const int e = r / I6, q = r % I6; const int kb = q / (D / 32), nb = q % (D / 32);
        t.src = p.w_down + (size_t)e * F * D + (size_t)(64 * kb) * D + 32 * nb; t.ldw = D; t.ldt = F;
        t.dst = (unsigned char*)p.Wt_down + (size_t)e * D * F + (size_t)(32 * nb) * F + 64 * kb; }
    return t;
}
__device__ __forceinline__ void phase_p0b(const Ctx& X0, const P& p) {
    Ctx X = X0; X.tid = (int)threadIdx.x; asm volatile("" : "+v"(X.tid)); X.lane = X.tid & 63;
    const int gw = X.vcu * NWAVES + X.wave, NGW = X.G * NWAVES;
    {
        f32x4 v[4], vn[4], vn2[4]; int m = gw; if (m < T) row_issue(p.x + (size_t)m * D, X.lane, v);
        if (m + NGW < T) row_issue(p.x + (size_t)(m + NGW) * D, X.lane, vn);
        for (; m < T; m += NGW) {
            const int mn = m + 2 * NGW; if (mn < T) row_issue(p.x + (size_t)mn * D, X.lane, vn2);
            const float rstd = row_rstd(v); const float* md = p.MOD + (size_t)(m >> 12) * NMOD * D;
#pragma unroll
            for (int j = 0; j < 4; ++j) { const int c0 = 4 * X.lane + 256 * j;
                const f32x4 g = *(const f32x4*)(p.norm1_g + c0), sh = *(const f32x4*)(md + c0), sc = *(const f32x4*)(md + D + c0);
                const f32x4 o = v[j] * rstd * g * (sc + 1.f) + sh;
                *(GAS u32x2*)(p.U + (size_t)m * D + c0) = (u32x2){cvt_pk_bf16(o[0], o[1]), cvt_pk_bf16(o[2], o[3])}; }
#pragma unroll
            for (int q = 0; q < 4; ++q) { v[q] = vn[q]; vn[q] = vn2[q]; }
        }
    }
    LAS float* scr = (LAS float*)(X.lds + X.wave * 16384);
    constexpr int I3 = (D / 64) * (D / 32);
    for (int it = gw; it < I3; it += NGW) { const int kb = it / (D / 32), nb = it % (D / 32); transpose_item(p.W2F, D, 64 * kb, 32 * nb, p.Wt_four, D, 32 * nb, scr, X.lane); }
    constexpr int NIT = E * 2 * (D / 64) * (F / 32) + E * (F / 64) * (D / 32);
#if MOE_F8
    {   f32x4 va[8], vb[8], vc[8]; TItem cur, nx, nx2; int it = gw;
        if (it < NIT) { cur = moe_item(p, it); titem_load(cur, X.lane, va); }
        if (it + NGW < NIT) { nx = moe_item(p, it + NGW); titem_load(nx, X.lane, vb); }
        while (it < NIT) {
            const int n2 = it + 2 * NGW; if (n2 < NIT) { nx2 = moe_item(p, n2); titem_load(nx2, X.lane, vc); }
            titem_store_f8(cur, X.lane, va, scr, epi::W_SC);
#pragma unroll
            for (int i = 0; i < 8; ++i) { va[i] = vb[i]; vb[i] = vc[i]; }
            cur = nx; nx = nx2; it += NGW;
        }
    }
#else
    constexpr int I5 = (D / 64) * (F / 32), I6 = (F / 64) * (D / 32);
    for (int it = gw; it < NIT; it += NGW) { int r = it;
        if (r < E * 2 * I5) { const int eh = r / I5, q = r % I5, e = eh >> 1, half = eh & 1; const int kb = q / (F / 32), nb = q % (F / 32), n0 = 32 * nb;
            transpose_item((half ? p.w_up : p.w_gate) + (size_t)e * D * F, F, 64 * kb, n0, p.Wt_gu + (size_t)e * 2 * F * D, D, 256 * (n0 / 128) + 128 * half + (n0 % 128), scr, X.lane); continue; } r -= E * 2 * I5;
        { const int e = r / I6, q = r % I6; const int kb = q / (D / 32), nb = q % (D / 32);
            transpose_item(p.w_down + (size_t)e * F * D, D, 64 * kb, 32 * nb, p.Wt_down + (size_t)e * D * F, F, 32 * nb, scr, X.lane); } }
#endif
}

__device__ __forceinline__ void phase_conv(const Ctx& X0, const P& p) {
    Ctx X = X0; X.tid = (int)threadIdx.x; asm volatile("" : "+v"(X.tid)); X.lane = X.tid & 63;
    constexpr int CH = 32, ROWS = CH + CK - 1;
    LAS unsigned char* rows = X.lds;
    LAS float* wl = (LAS float*)(X.lds + ROWS * 1024);
    for (int i = X.tid; i < CK * CW; i += NTHR) { const int k = i / CW, ch = i % CW; const int ln = ch >> 3, q = (ch >> 2) & 1, r = ch & 3; wl[((k * 2 + q) * 64 + ln) * 4 + r] = p.dw_w[i]; }
    const int lane = X.lane, w = X.wave;
    f32x4 db[2], lg[2], lb[2];
#pragma unroll
    for (int h = 0; h < 2; ++h) { db[h] = *(const f32x4*)(p.dw_b + 8 * lane + 4 * h); lg[h] = *(const f32x4*)(p.cln_g + 8 * lane + 4 * h); lb[h] = *(const f32x4*)(p.cln_b + 8 * lane + 4 * h); }
    for (int chunk = X.vcu; chunk < T / CH; chunk += X.G) {
        const int t0 = chunk * CH, b = t0 >> 12, s0 = t0 & (S - 1);
        __syncthreads();
        for (int i = X.tid; i < ROWS * 64; i += NTHR) { const int r = i >> 6, cseg = i & 63; const int s = s0 + r - CK / 2;
            u32x4 val = (u32x4){0u, 0u, 0u, 0u};
            if (s >= 0 && s < S) val = *(const GAS u32x4*)(p.V + ((size_t)(b * S + s)) * CW + cseg * 8);
            *(LAS u32x4*)(rows + r * 1024 + cseg * 16) = val; }
        __syncthreads();
        f32x4 acc[4][2]; int zo = 0; asm volatile("" : "+v"(zo));
#pragma unroll
        for (int j = 0; j < 4; ++j) { acc[j][0] = db[0]; acc[j][1] = db[1]; }
#pragma unroll
        for (int rr = 0; rr < CK + 3; ++rr) {
            const u32x4 rv = *(const LAS u32x4*)(rows + (4 * w + rr) * 1024 + lane * 16); f32x4 a0, a1; epi::unpack8(rv, a0, a1);
#pragma unroll
            for (int j = 0; j < 4; ++j) { const int k = rr - j;
                if (k >= 0 && k < CK) { const f32x4 w0 = *(const LAS f32x4*)(wl + ((k * 2 + 0) * 64 + lane + zo) * 4), w1 = *(const LAS f32x4*)(wl + ((k * 2 + 1) * 64 + lane + zo) * 4);
                    acc[j][0] += a0 * w0; acc[j][1] += a1 * w1; } }
        }
#pragma unroll
        for (int j = 0; j < 4; ++j) {
            const f32x4 a0 = acc[j][0], a1 = acc[j][1];
            const float mu = wave_sum((a0[0] + a0[1]) + (a0[2] + a0[3]) + (a1[0] + a1[1]) + (a1[2] + a1[3])) * (1.f / CW);
            const f32x4 d0 = a0 - mu, d1 = a1 - mu;
            const float var = wave_sum((d0[0] * d0[0] + d0[1] * d0[1]) + (d0[2] * d0[2] + d0[3] * d0[3]) + (d1[0] * d1[0] + d1[1] * d1[1]) + (d1[2] * d1[2] + d1[3] * d1[3])) * (1.f / CW);
            const float rstd = 1.f / sqrtf(var + 1e-5f);
            const f32x4 z0 = d0 * rstd * lg[0] + lb[0], z1 = d1 * rstd * lg[1] + lb[1];
            *(GAS u32x4*)(p.ACONV + (size_t)(t0 + 4 * w + j) * CW + 8 * lane) = epi::pack8(epi::silu4(z0), epi::silu4(z1));
        }
    }
    __syncthreads();
}


__device__ __forceinline__ void dft16_real(const float (&x)[16], float (&gr)[16], float (&gi)[16]) {
    constexpr float WR[10] = {1.f, 0.92387953251128674f, 0.70710678118654752f, 0.38268343236508977f, 0.f, -0.38268343236508977f, -0.70710678118654752f, -0.92387953251128674f, -1.f, -0.92387953251128674f};
    constexpr float WI[10] = {0.f, -0.38268343236508977f, -0.70710678118654752f, -0.92387953251128674f, -1.f, -0.92387953251128674f, -0.70710678118654752f, -0.38268343236508977f, 0.f, 0.38268343236508977f};
    float zr[4][4], zi[4][4];
#pragma unroll
    for (int b = 0; b < 4; ++b) { const float x0 = x[b], x1 = x[4 + b], x2 = x[8 + b], x3 = x[12 + b];
        const float s02 = x0 + x2, d02 = x0 - x2, s13 = x1 + x3, d13 = x1 - x3;
        const float yr[4] = {s02 + s13, d02, s02 - s13, d02}, yi[4] = {0.f, -d13, 0.f, d13};
#pragma unroll
        for (int c = 0; c < 4; ++c) { const float wr = WR[b * c], wi = WI[b * c]; zr[b][c] = yr[c] * wr - yi[c] * wi; zi[b][c] = yr[c] * wi + yi[c] * wr; } }
#pragma unroll
    for (int c = 0; c < 4; ++c) {
        const float ar = zr[0][c] + zr[2][c], ai = zi[0][c] + zi[2][c], br = zr[0][c] - zr[2][c], bi = zi[0][c] - zi[2][c];
        const float cr = zr[1][c] + zr[3][c], ci = zi[1][c] + zi[3][c], dr = zr[1][c] - zr[3][c], di = zi[1][c] - zi[3][c];
        gr[c] = ar + cr;      gi[c] = ai + ci;
        gr[c + 4] = br + di;  gi[c + 4] = bi - dr;
        gr[c + 8] = ar - cr;  gi[c + 8] = ai - ci;
        gr[c + 12] = br - di; gi[c + 12] = bi + dr;
    }
}
__device__ __forceinline__ void phase_fftA(const Ctx& X0, const P& p) {
    Ctx X = X0; X.tid = (int)threadIdx.x; asm volatile("" : "+v"(X.tid)); X.lane = X.tid & 63;
    LAS float* ct = (LAS float*)X.lds;
    for (int i = X.tid; i < S; i += NTHR) { float sv, cv; sincospif((float)i / (float)(S / 2), &sv, &cv); ct[i] = cv; }
    __syncthreads();
    constexpr float C16[16] = {1.f, 0.92387953251128674f, 0.70710678118654752f, 0.38268343236508977f, 0.f, -0.38268343236508977f, -0.70710678118654752f, -0.92387953251128674f,
                               -1.f, -0.92387953251128674f, -0.70710678118654752f, -0.38268343236508977f, 0.f, 0.38268343236508977f, 0.70710678118654752f, 0.92387953251128674f};
    const int chl = X.tid >> 7, sp = X.tid & 127;
    for (int it = X.vcu; it < Bn * (FW / 4); it += X.G) {
        const int b = it >> 7, ch = (it & 127) * 4 + chl;
        const bf16_t* src = p.FT + ((size_t)(b * FW + ch) * S + 2 * sp);
        float xa[16], xb[16];
#pragma unroll
        for (int s2 = 0; s2 < 16; ++s2) { const unsigned w = *(const GAS unsigned*)(src + 256 * s2); xa[s2] = bf_lo(w); xb[s2] = bf_hi(w); }
        float gar[16], gai[16], gbr[16], gbi[16];
        dft16_real(xa, gar, gai); dft16_real(xb, gbr, gbi);
#pragma unroll
        for (int k2 = 0; k2 < 16; ++k2) {
            const float ar = gar[k2], ai = gai[k2], br = gbr[k2], bi = gbi[k2];
            const int ia = (2 * sp * k2) & (S - 1), ib = ((2 * sp + 1) * k2) & (S - 1);
            const float tca = ct[ia], tsa = ct[(ia - S / 4) & (S - 1)], tcb = ct[ib], tsb = ct[(ib - S / 4) & (S - 1)];
            const float gra = ar * tca + ai * tsa, gia = ai * tca - ar * tsa, grb = br * tcb + bi * tsb, gib = bi * tcb - br * tsb;
            bf16_t* dst = p.GP + ((size_t)((b * 16 + k2) * FW + ch) * 512 + 2 * sp);
            *(GAS unsigned*)dst = cvt_pk_bf16(gra, grb); *(GAS unsigned*)(dst + 256) = cvt_pk_bf16(gia, gib);
        }
    }
    __syncthreads();
}

__device__ __forceinline__ void phase_router(const Ctx& X0, const P& p, const float* H) {
    Ctx X = X0; X.tid = (int)threadIdx.x; asm volatile("" : "+v"(X.tid)); X.lane = X.tid & 63;
    LAS float* GP = (LAS float*)X.lds;
    LAS float* SH = GP + D;
    LAS f32x4* ACCP = (LAS f32x4*)(SH + D);
    LAS float* SSP = (LAS float*)(ACCP + 2 * 8 * 64);
    LAS float* CE = SSP + 2 * 8 * 16;
    const int lane = X.lane, w = X.wave, r = lane & 15, kq = lane >> 4;
    constexpr int NG = T / 16, GPW = NG / 256;
    const int g0 = X.vcu * GPW, b = (g0 * 16) >> 12;
    const float* md = p.MOD + (size_t)b * NMOD * D;
    f32x4 a[4][2], vn[4][2];
    const int cbase = 128 * w + 8 * kq;
#if H_DELTA
#define RT_ISSUE(dst, grp) do { const size_t ro_ = ((size_t)(grp) * 16 + r) * D + cbase; const float* rp = H + ro_; const bf16_t* dp = p.DELTA + ro_; _Pragma("unroll") for (int s = 0; s < 4; ++s) { \
        const u32x4 dw_ = *(const GAS u32x4*)(dp + 32 * s); f32x4 d0_, d1_; epi::unpack8(dw_, d0_, d1_); dst[s][0] = *(const GAS f32x4*)(rp + 32 * s) + d0_; dst[s][1] = *(const GAS f32x4*)(rp + 32 * s + 4) + d1_; } } while (0)
#else
#define RT_ISSUE(dst, grp) do { const float* rp = H + ((size_t)(grp) * 16 + r) * D + cbase; _Pragma("unroll") for (int s = 0; s < 4; ++s) { dst[s][0] = *(const GAS f32x4*)(rp + 32 * s); dst[s][1] = *(const GAS f32x4*)(rp + 32 * s + 4); } } while (0)
#endif
    RT_ISSUE(a, g0);
    for (int i = X.tid; i < D; i += NTHR) { GP[i] = p.norm2_g[i] * (1.f + md[4 * D + i]); SH[i] = md[3 * D + i]; }
    bf16x8 bh[4], bl[4];
#pragma unroll
    for (int s = 0; s < 4; ++s) { unsigned hw[4], lw[4];
#pragma unroll
        for (int j = 0; j < 4; ++j) { const int d = 32 * (4 * w + s) + 8 * kq + 2 * j; const float x0 = p.router_w[(size_t)d * E + r], x1 = p.router_w[(size_t)(d + 1) * E + r];
            const unsigned h = cvt_pk_bf16(x0, x1); hw[j] = h; lw[j] = cvt_pk_bf16(x0 - bf_lo(h), x1 - bf_hi(h)); }
        bh[s] = __builtin_bit_cast(bf16x8, (u32x4){hw[0], hw[1], hw[2], hw[3]}); bl[s] = __builtin_bit_cast(bf16x8, (u32x4){lw[0], lw[1], lw[2], lw[3]}); }
    __syncthreads();
    if (w == 0) {
        float c[E];
#pragma unroll
        for (int e = 0; e < E; ++e) c[e] = 0.f;
        for (int d = lane; d < D; d += 64) { const float sv = SH[d]; const f32x4* wr_ = (const f32x4*)(p.router_w + (size_t)d * E);
#pragma unroll
            for (int q = 0; q < 4; ++q) { const f32x4 wv = wr_[q]; c[4 * q] += sv * wv[0]; c[4 * q + 1] += sv * wv[1]; c[4 * q + 2] += sv * wv[2]; c[4 * q + 3] += sv * wv[3]; } }
#pragma unroll
        for (int e = 0; e < E; ++e) { const float s = wave_sum(c[e]); if (lane == e) CE[e] = s; }
    }
    __syncthreads();
    for (int gi = 0; gi < GPW; ++gi) {
        const int g = g0 + gi, par = gi & 1;
        if (gi + 1 < GPW) RT_ISSUE(vn, g + 1);
        float ss = 0.f; f32x4 acc = (f32x4){0.f, 0.f, 0.f, 0.f};
#pragma unroll
        for (int s = 0; s < 4; ++s) {
            const f32x4 g0v = *(const LAS f32x4*)(GP + cbase + 32 * s), g1v = *(const LAS f32x4*)(GP + cbase + 32 * s + 4);
            const f32x4 v0 = a[s][0], v1 = a[s][1];
            ss += (v0[0] * v0[0] + v0[1] * v0[1]) + (v0[2] * v0[2] + v0[3] * v0[3]) + (v1[0] * v1[0] + v1[1] * v1[1]) + (v1[2] * v1[2] + v1[3] * v1[3]);
            const f32x4 x0 = v0 * g0v, x1 = v1 * g1v; a[s][0] = x0; a[s][1] = x1;
            unsigned hw[4], lw[4];
            hw[0] = cvt_pk_bf16(x0[0], x0[1]); hw[1] = cvt_pk_bf16(x0[2], x0[3]); hw[2] = cvt_pk_bf16(x1[0], x1[1]); hw[3] = cvt_pk_bf16(x1[2], x1[3]);
            lw[0] = cvt_pk_bf16(x0[0] - bf_lo(hw[0]), x0[1] - bf_hi(hw[0])); lw[1] = cvt_pk_bf16(x0[2] - bf_lo(hw[1]), x0[3] - bf_hi(hw[1]));
            lw[2] = cvt_pk_bf16(x1[0] - bf_lo(hw[2]), x1[1] - bf_hi(hw[2])); lw[3] = cvt_pk_bf16(x1[2] - bf_lo(hw[3]), x1[3] - bf_hi(hw[3]));
            const bf16x8 ah = __builtin_bit_cast(bf16x8, (u32x4){hw[0], hw[1], hw[2], hw[3]}), al = __builtin_bit_cast(bf16x8, (u32x4){lw[0], lw[1], lw[2], lw[3]});
            acc = __builtin_amdgcn_mfma_f32_16x16x32_bf16(ah, bh[s], acc, 0, 0, 0);
            acc = __builtin_amdgcn_mfma_f32_16x16x32_bf16(ah, bl[s], acc, 0, 0, 0);
            acc = __builtin_amdgcn_mfma_f32_16x16x32_bf16(al, bh[s], acc, 0, 0, 0);
        }
        ss += __shfl_xor(ss, 16); ss += __shfl_xor(ss, 32);
        ACCP[(par * 8 + w) * 64 + lane] = acc;
        if (lane < 16) SSP[(par * 8 + w) * 16 + lane] = ss;
        __syncthreads();
        float rss = 0.f;
#pragma unroll
        for (int q = 0; q < 8; ++q) rss += SSP[(par * 8 + q) * 16 + r];
        const float rstd = 1.f / sqrtf(rss * (1.f / D) + 1e-6f);
        if (w == (gi & 7)) {
            f32x4 lg = (f32x4){0.f, 0.f, 0.f, 0.f};
#pragma unroll
            for (int q = 0; q < 8; ++q) lg += ACCP[(par * 8 + q) * 64 + lane];
            const float ce = CE[r]; f32x4 o;
#pragma unroll
            for (int q = 0; q < 4; ++q) { const float rs = __shfl(rstd, 4 * kq + q); float z = lg[q] * rs + ce; float mx = z;
#pragma unroll
                for (int sft = 1; sft < 16; sft <<= 1) mx = fmaxf(mx, __shfl_xor(mx, sft));
                const float ex = expf(z - mx); float sm = ex;
#pragma unroll
                for (int sft = 1; sft < 16; sft <<= 1) sm += __shfl_xor(sm, sft);
                o[q] = ex / sm; }
            *(GAS f32x4*)(p.AFF + ((size_t)b * E + r) * S + ((g * 16) & (S - 1)) + 4 * kq) = o;
        }
#pragma unroll
        for (int s = 0; s < 4; ++s) {
            const f32x4 s0 = *(const LAS f32x4*)(SH + cbase + 32 * s), s1 = *(const LAS f32x4*)(SH + cbase + 32 * s + 4);
            const f32x4 u0 = a[s][0] * rstd + s0, u1 = a[s][1] * rstd + s1; const size_t off = ((size_t)g * 16 + r) * D + cbase + 32 * s;
            if (MOE_F8) *(GAS u32x2*)((unsigned char*)p.U + off) = pack8_f8(u0, u1, epi::U_SC);
            else *(GAS u32x4*)(p.U + off) = epi::pack8(u0, u1);
        }
#pragma unroll
        for (int s = 0; s < 4; ++s) { a[s][0] = vn[s][0]; a[s][1] = vn[s][1]; }
    }
#undef RT_ISSUE
    __syncthreads();
}

__device__ __forceinline__ void phase_topk(const Ctx& X0, const P& p) {
    Ctx X = X0; X.tid = (int)threadIdx.x; asm volatile("" : "+v"(X.tid)); X.lane = X.tid & 63;
    LAS unsigned* cnt = (LAS unsigned*)X.lds;
    LAS unsigned* sc = cnt + 48;
    const int lane = X.lane, w = X.wave, tid = X.tid;
    for (int be = X.vcu; be < Bn * E; be += X.G) {
        const int b = be / E, e = be % E;
        const float* src = p.AFF + (size_t)be * S + 8 * tid;
        const f32x4 a0 = *(const GAS f32x4*)src, a1 = *(const GAS f32x4*)(src + 4);
        unsigned key[8];
#pragma unroll
        for (int i = 0; i < 4; ++i) { const float f0 = a0[i], f1 = a1[i]; key[i] = __float_as_uint(f0); key[4 + i] = __float_as_uint(f1); }
        unsigned prefix = 0u, need_k = (unsigned)CAP;
        __syncthreads();
        if (tid < 48) cnt[tid] = 0u;
        __syncthreads();
#pragma unroll 1
        for (int pass = 0; pass < 8; ++pass) {
            const int shift = 28 - 4 * pass; LAS unsigned* hist = cnt + (pass % 3) * 16;
            if (tid < 16) cnt[((pass + 1) % 3) * 16 + tid] = 0u;
#pragma unroll
            for (int i = 0; i < 8; ++i) { const bool match = (pass == 0) || ((key[i] >> (shift + 4)) == (prefix >> (shift + 4)));
                if (match) __hip_atomic_fetch_add(hist + ((key[i] >> shift) & 15u), 1u, __ATOMIC_RELAXED, __HIP_MEMORY_SCOPE_WORKGROUP); }
            __syncthreads();
            unsigned cum = 0u, dsel = 0u, below = 0u; bool found = false;
#pragma unroll
            for (int dgt = 15; dgt >= 0; --dgt) { const unsigned c = hist[dgt]; if (!found) { if (cum + c >= need_k) { dsel = (unsigned)dgt; below = cum; found = true; } else cum += c; } }
            prefix |= dsel << shift; need_k -= below;
        }
        const unsigned Tk = prefix;
        unsigned ngt = 0u, neq = 0u;
#pragma unroll
        for (int i = 0; i < 8; ++i) { ngt += key[i] > Tk; neq += key[i] == Tk; }
        unsigned sg = ngt, se = neq;
#pragma unroll
        for (int o = 1; o < 64; o <<= 1) { const unsigned tg = __shfl_up(sg, o), te = __shfl_up(se, o); if (lane >= o) { sg += tg; se += te; } }
        __syncthreads();
        if (lane == 63) { sc[w] = sg; sc[8 + w] = se; }
        __syncthreads();
        unsigned og = 0u, oe = 0u, totg = 0u;
#pragma unroll
        for (int i = 0; i < 8; ++i) { const unsigned g = sc[i], q = sc[8 + i]; if (i < w) { og += g; oe += q; } totg += g; }
        unsigned pg = og + sg - ngt, pe = oe + se - neq;
        const unsigned need = (unsigned)CAP - totg;
        unsigned iv[4] = {0u, 0u, 0u, 0u};
#pragma unroll
        for (int i = 0; i < 8; ++i) {
            const bool gt = key[i] > Tk, eq = key[i] == Tk; const int s = 8 * tid + i;
            const bool sel = gt || (eq && pe < need);
            const unsigned slot = pg + (pe < need ? pe : need);
            if (sel) { p.ROWL[(size_t)e * ME + b * CAP + slot] = b * S + s; p.WTS[(size_t)e * ME + b * CAP + slot] = __uint_as_float(key[i]); }
            iv[i >> 1] |= (sel ? (slot & 0xffffu) : 0xffffu) << (16 * (i & 1));
            pg += gt; pe += eq;
        }
        *(GAS u32x4*)(p.INV + (size_t)be * S + 8 * tid) = (u32x4){iv[0], iv[1], iv[2], iv[3]};
    }
    __syncthreads();
}

__device__ __forceinline__ void phase_final(const Ctx& X0, const P& p) {
    Ctx X = X0; X.tid = (int)threadIdx.x; asm volatile("" : "+v"(X.tid)); X.lane = X.tid & 63;
    const int gw = X.vcu * NWAVES + X.wave, NGW = X.G * NWAVES, lane = X.lane;
    for (int m = gw; m < T; m += NGW) {
        const int b = m >> 12; float* hr = p.out + (size_t)m * D;
        f32x4 v[4];
#if H_DELTA
#pragma unroll
        for (int j = 0; j < 4; ++j) { const u32x2 dw = *(const GAS u32x2*)(p.DELTA + (size_t)m * D + 4 * lane + 256 * j);
            v[j] = *(const GAS f32x4*)(p.x + (size_t)m * D + 4 * lane + 256 * j) + (f32x4){bf_lo(dw.x), bf_hi(dw.x), bf_lo(dw.y), bf_hi(dw.y)}; }
#else
#pragma unroll
        for (int j = 0; j < 4; ++j) v[j] = *(const GAS f32x4*)(hr + 4 * lane + 256 * j);
#endif
        const int myslot = (lane < E) ? (int)p.INV[((size_t)(b * E + lane)) * S + (m & (S - 1))] : -1;
        f32x4 y[4];
#pragma unroll
        for (int q = 0; q < 4; ++q) y[q] = (f32x4){0.f, 0.f, 0.f, 0.f};
#pragma unroll
        for (int e = 0; e < E; ++e) { const int slot = __builtin_amdgcn_readlane(myslot, e);
            if (slot >= 0) { const size_t yo = ((size_t)e * ME + b * CAP + slot) * D;
#pragma unroll
                for (int j = 0; j < 4; ++j) {
                    if (YB_F8) { const unsigned wv = *(const GAS unsigned*)((const unsigned char*)p.YB + yo + 4 * lane + 256 * j);
                        const f32x2 lo2 = __builtin_amdgcn_cvt_pk_f32_fp8((int)wv, false), hi2 = __builtin_amdgcn_cvt_pk_f32_fp8((int)wv, true); y[j] += (f32x4){lo2[0], lo2[1], hi2[0], hi2[1]}; }
                    else { const u32x2 wv = *(const GAS u32x2*)(p.YB + yo + 4 * lane + 256 * j); y[j] += (f32x4){bf_lo(wv.x), bf_hi(wv.x), bf_lo(wv.y), bf_hi(wv.y)}; } } } }
        const float* g2 = p.MOD + (size_t)b * NMOD * D + 5 * D; float ss = 0.f;
#pragma unroll
        for (int j = 0; j < 4; ++j) { const f32x4 g = *(const f32x4*)(g2 + 4 * lane + 256 * j) * (YB_F8 ? 1.f / epi::YB_SC : 1.f); const f32x4 tt = v[j] + g * y[j]; v[j] = tt;
            ss += (tt[0] * tt[0] + tt[1] * tt[1]) + (tt[2] * tt[2] + tt[3] * tt[3]); }
        const float rstd = 1.f / sqrtf(wave_sum(ss) * (1.f / D) + 1e-6f);
#pragma unroll
        for (int j = 0; j < 4; ++j) { const f32x4 fg = *(const f32x4*)(p.final_g + 4 * lane + 256 * j); *(GAS f32x4*)(hr + 4 * lane + 256 * j) = v[j] * rstd * fg; }
    }
}

constexpr size_t MiB = 1u << 20;
constexpr size_t WS_CTL = 0, CTL_ZERO_BYTES = 1 * MiB;
constexpr size_t WS_MOD = 1 * MiB, WS_AFF = 2 * MiB, WS_ROWL = 4 * MiB, WS_WTS = WS_ROWL + 256 * 1024, WS_INV = WS_WTS + 256 * 1024;
constexpr size_t WS_W2F = 6 * MiB, WS_WIN = 10 * MiB, WS_WCONV = 18 * MiB, WS_WFOUR = 19 * MiB, WS_WOUT = 21 * MiB;
constexpr size_t WS_WGU = 24 * MiB, WS_WDOWN = 152 * MiB, WS_U = 216 * MiB, WS_R1 = 280 * MiB, WS_END = 536 * MiB;
constexpr size_t WS_GP = WS_R1, WS_D256 = 23 * MiB, WS_YCONV = WS_R1, WS_V = WS_R1 + 64 * MiB, WS_FT = WS_R1 + 96 * MiB, WS_YFOUR = WS_R1 + 64 * MiB;
constexpr size_t WS_YRI = WS_R1 + 128 * MiB, WS_MERGED = WS_R1 + 128 * MiB, WS_ACONV = WS_R1 + 192 * MiB, WS_ACT = WS_R1 + 128 * MiB  , WS_YB = WS_WGU, WS_DELTA = WS_R1  ;
static_assert(MOE_F8 || !H_DELTA, "the workspace map places the 128 MiB fp8 ACT beside DELTA; a bf16 ACT (256 MiB) needs H_DELTA = 0");
constexpr int LDS_BYTES = 147456, RING_BYTES = 131072, MISC_OFF = RING_BYTES + 320;


#ifndef BARRIER_KIND
#define BARRIER_KIND 2
#endif
#define RLX_AGENT __ATOMIC_RELAXED, __HIP_MEMORY_SCOPE_AGENT
#define XB_TMO      128
#define XB_XCNT(j)  (256  + 64 * (j))
#define XB_XSUB(j)  (1280 + 64 * (j))
#define XB_XGEN(j)  (2304 + 64 * (j))
#define XB_TOP      3328
#define XB_TOPGEN   3392
#define XCD_BAR_WORDS 3456
#define XB_SPIN_CAP (1u << 18)
__device__ __forceinline__ unsigned xb_ld(unsigned* p)              { return __hip_atomic_load(p, __ATOMIC_RELAXED, __HIP_MEMORY_SCOPE_AGENT); }
__device__ __forceinline__ unsigned xb_add(unsigned* p, unsigned v) { return __hip_atomic_fetch_add(p, v, __ATOMIC_RELAXED, __HIP_MEMORY_SCOPE_AGENT); }
__device__ __forceinline__ unsigned xb_xcc_id() { return (unsigned)__builtin_amdgcn_s_getreg((3 << 11) | 20) & 0xFu; }
#define XB_SPIN(cond, bar) do { unsigned _sp = 0; while (cond) { __builtin_amdgcn_s_sleep(1); \
    if ((++_sp & 255u) == 0u) { if (xb_ld(&(bar)[XB_TMO])) break; if (_sp > XB_SPIN_CAP) { atomicAdd(&(bar)[XB_TMO], 1u); break; } } } } while (0)
struct XcdBarrier { unsigned* bar; unsigned x; volatile LAS unsigned* st; };
__device__ __forceinline__ XcdBarrier xcd_barrier_post(unsigned* bar, volatile LAS unsigned* st) {
    XcdBarrier b; b.bar = bar; b.x = xb_xcc_id(); b.st = st;
    if (threadIdx.x == 0) (void)xb_add(&bar[XB_XCNT(b.x)], 1u);
    return b;
}
__device__ __forceinline__ void xcd_barrier_complete(unsigned* bar, unsigned x, unsigned& nloc, unsigned& nx) {
    const unsigned G = gridDim.x * gridDim.y * gridDim.z;
    unsigned sum, cnt, mine, sp = 0u;
    for (;;) {
        sum = 0u; cnt = 0u; mine = 0u;
#pragma unroll
        for (unsigned j = 0; j < 16; ++j) { const unsigned c = xb_ld(&bar[XB_XCNT(j)]); sum += c; cnt += (c > 0u) ? 1u : 0u; mine = (j == x) ? c : mine; }
        if (sum == G) break;
        __builtin_amdgcn_s_sleep(1);
        if ((++sp & 255u) == 0u) { if (xb_ld(&bar[XB_TMO])) break; if (sp > XB_SPIN_CAP) { atomicAdd(&bar[XB_TMO], 1u); break; } }
    }
    nloc = mine > 0u ? mine : 1u; nx = cnt > 0u ? cnt : 1u;
}
__device__ __forceinline__ void xcd_barrier(const XcdBarrier& b) {
    asm volatile("s_waitcnt vmcnt(0)" ::: "memory");
    __syncthreads();
    if (threadIdx.x == 0) {
        unsigned* bar = b.bar;
        __builtin_amdgcn_s_waitcnt(0);
        unsigned nloc = b.st[0], nx = b.st[1];
        if (nloc == 0u) { xcd_barrier_complete(bar, b.x, nloc, nx); b.st[0] = nloc; b.st[1] = nx; }
        const unsigned old = xb_add(&bar[XB_XSUB(b.x)], 1u);
        const unsigned gen = old / nloc;
        if (old + 1u == (gen + 1u) * nloc) {
            __builtin_amdgcn_fence(__ATOMIC_RELEASE, "agent");
            asm volatile("s_waitcnt vmcnt(0)" ::: "memory");
            const unsigned og = xb_add(&bar[XB_TOP], 1u);
            const unsigned tg = og / nx;
            if (og + 1u == (tg + 1u) * nx) xb_add(&bar[XB_TOPGEN], 1u);
            else XB_SPIN(xb_ld(&bar[XB_TOPGEN]) == tg, bar);
            __builtin_amdgcn_fence(__ATOMIC_ACQUIRE, "agent");
            xb_add(&bar[XB_XGEN(b.x)], 1u);
            asm volatile("s_waitcnt vmcnt(0)" ::: "memory");
        } else {
            XB_SPIN(xb_ld(&bar[XB_XGEN(b.x)]) == gen, bar);
            __builtin_amdgcn_fence(__ATOMIC_ACQUIRE, "agent");
            asm volatile("s_waitcnt vmcnt(0)" ::: "memory");
        }
    }
    __syncthreads();
}
constexpr int CW_BAR = 4096;

struct Args { P p; unsigned* ctl; int ph_lo, ph_hi; };

__global__ void __launch_bounds__(NTHR, 2) mk_fwd(Args args) {
    extern __shared__ __attribute__((aligned(16))) unsigned char lds_raw[];
    Ctx X; X.lds = (LAS unsigned char*)lds_raw; X.tid = threadIdx.x; X.lane = X.tid & 63; X.wave = __builtin_amdgcn_readfirstlane(X.tid >> 6);
    X.G = gridDim.x; { const int bx = blockIdx.x; X.vcu = (X.G % 8 == 0) ? (bx % 8) * (X.G / 8) + bx / 8 : bx; }
    const P& p = args.p; const int lo = args.ph_lo, hi = args.ph_hi;
    const int cid = (int)blockIdx.x;
#define IN(k) (lo <= (k) && (k) < hi)
    for (int u = X.tid; u < (LDS_BYTES - RING_BYTES) / 4; u += NTHR) ((LAS unsigned*)(X.lds + RING_BYTES))[u] = 0u;
    __syncthreads();
#if BARRIER_KIND == 1
    cooperative_groups::grid_group cgrid = cooperative_groups::this_grid();
#define GRID_BAR() do { if (hi - lo > 1) cgrid.sync(); } while (0)
#else
    XcdBarrier xbar = xcd_barrier_post(args.ctl + CW_BAR, (volatile LAS unsigned*)(X.lds + MISC_OFF));
#define GRID_BAR() do { if (hi - lo > 1) xcd_barrier(xbar); } while (0)
#endif
#ifdef PROBE_A
    volatile unsigned long long* ts = (volatile unsigned long long*)(args.ctl + 65536);
    int n_stamp = 0;
#define STAMP() do { if (blockIdx.x == 0 && X.tid == 0) ts[n_stamp] = __builtin_amdgcn_s_memrealtime(); ++n_stamp; } while (0)
#else
#define STAMP() do { } while (0)
#endif
    STAMP();
    if (IN(0)) { phase_p0a(X, p); GRID_BAR(); STAMP(); }
    if (IN(1)) { phase_p0b(X, p); GRID_BAR(); STAMP(); }
    if (IN(2)) {
        { pg8::SchedDense Sd; Sd.init(p.U, p.Wt_in, T, 2 * CW, D, X.G, cid); epi::EpiGlu Ep{p.V, p.b_in};
          pg8::gemm_phase<epi::EpiGlu, pg8::SchedDense, false>(X.lds, 2 * D, Sd, Ep); }
        { pg8::SchedDense Sd; Sd.init(p.Wt_in + (size_t)(2 * CW) * D, p.U, FW, T, D, X.G, cid); epi::EpiFT Ep{p.FT, p.b_in + 2 * CW};
          pg8::gemm_phase<epi::EpiFT, pg8::SchedDense, false>(X.lds, 2 * D, Sd, Ep); }
        GRID_BAR(); STAMP();
    }
    if (IN(3)) {
        phase_conv(X, p);
        phase_fftA(X, p);
        GRID_BAR(); STAMP();
        { pg8::SchedDense Sd; Sd.init(p.D256, p.GP, 512, Bn * 16 * FW, 512, X.G, cid); epi::EpiFFT Ep{p.YRI};
          pg8::gemm_phase<epi::EpiFFT, pg8::SchedDense, false>(X.lds, 2 * 512, Sd, Ep); }
        GRID_BAR(); STAMP();
    }
    if (IN(4)) {
        { pg8::SchedDense Sd; Sd.init(p.ACONV, p.Wt_conv, T, D, CW, X.G, cid); epi::EpiBias Ep{p.YCONV, D, p.cb_out};
          pg8::gemm_phase<epi::EpiBias, pg8::SchedDense, false>(X.lds, 2 * CW, Sd, Ep); }
        { pg8::SchedDense Sd; Sd.init(p.YRI, p.Wt_four, T, D, 2 * FW, X.G, cid); epi::EpiBias Ep{p.YFOUR, D, p.four_b};
          pg8::gemm_phase<epi::EpiBias, pg8::SchedDense, false>(X.lds, 4 * FW, Sd, Ep); }
        GRID_BAR(); STAMP();
    }
    if (IN(5)) {
        pg8::SchedDense Sd; Sd.init(p.U, p.Wt_in + (size_t)(2 * CW + FW) * D, T, 2 * D, D, X.G, cid); epi::EpiMerge Ep{p.MERGED, p.YCONV, p.YFOUR, p.b_in};
        pg8::gemm_phase<epi::EpiMerge, pg8::SchedDense, false>(X.lds, 2 * D, Sd, Ep);
        GRID_BAR(); STAMP();
    }
    if (IN(6)) {
        pg8::SchedDense Sd; Sd.init(p.MERGED, p.Wt_out, T, D, D, X.G, cid);
#if H_DELTA
        epi::EpiDelta Ep{p.DELTA, p.MOD + 2 * D, p.b_out};
        pg8::gemm_phase<epi::EpiDelta, pg8::SchedDense, false>(X.lds, 2 * D, Sd, Ep);
#else
        epi::EpiResid Ep{p.x, p.out, p.MOD + 2 * D, p.b_out};
        pg8::gemm_phase<epi::EpiResid, pg8::SchedDense, false>(X.lds, 2 * D, Sd, Ep);
#endif
        GRID_BAR(); STAMP();
    }
    if (IN(7)) { phase_router(X, p, H_DELTA ? p.x : p.out); GRID_BAR(); STAMP(); }
    if (IN(8)) { phase_topk(X, p); GRID_BAR(); STAMP(); }
    if (IN(9)) {
        constexpr int esz = MOE_F8 ? 1 : 2;
        pg8::SchedG1 Sd{(const char*)p.U, (const char*)p.Wt_gu, p.ROWL, X.G, cid, esz}; epi::EpiSwiglu<MOE_F8 != 0> Ep{p.ACT};
        pg8::gemm_phase<epi::EpiSwiglu<MOE_F8 != 0>, pg8::SchedG1, true, MOE_F8 != 0>(X.lds, D * esz, Sd, Ep, epi::MX_W, epi::MX_U);
        GRID_BAR(); STAMP();
    }
    if (IN(10)) {
        constexpr int esz = MOE_F8 ? 1 : 2;
        pg8::SchedG2 Sd{(const char*)p.ACT, (const char*)p.Wt_down, X.G, cid, esz}; epi::EpiScaleW Ep{p.YB, p.WTS};
        pg8::gemm_phase<epi::EpiScaleW, pg8::SchedG2, false, MOE_F8 != 0>(X.lds, F * esz, Sd, Ep, epi::MX_W, epi::MX_ACT);
        GRID_BAR(); STAMP();
    }
    if (IN(11)) { phase_final(X, p); }
#ifdef PROBE_A
    STAMP();
    if (blockIdx.x == 0 && X.tid == 0) { const unsigned long long dt = (ts[PROBE_B] - ts[PROBE_A]) * PROBE_AMP, t0 = __builtin_amdgcn_s_memrealtime();
        while (__builtin_amdgcn_s_memrealtime() - t0 < dt) __builtin_amdgcn_s_sleep(8); }
#endif
#undef IN
}

extern "C" void kernel_launch(void* const* d_in, const int* in_sizes, int n_in, void* d_out, int out_size, void* d_ws, size_t ws_size, hipStream_t stream) {
    static int grid = 0;
    if (grid == 0) {
        if (n_in != 23 || in_sizes[0] != T * D || out_size != T * D || ws_size < WS_END) { fprintf(stderr, "kernel_launch: unexpected shapes / workspace (%d inputs, ws %zu)\n", n_in, ws_size); grid = -1; return; }
        int dev = 0, cus = 0;
        if (hipGetDevice(&dev) != hipSuccess || hipDeviceGetAttribute(&cus, hipDeviceAttributeMultiprocessorCount, dev) != hipSuccess) { grid = -1; return; }
        if (hipFuncSetAttribute((const void*)mk_fwd, hipFuncAttributeMaxDynamicSharedMemorySize, LDS_BYTES) != hipSuccess) { fprintf(stderr, "kernel_launch: hipFuncSetAttribute failed\n"); grid = -1; return; }
        if (cus < 256) { fprintf(stderr, "kernel_launch: built for a 256-CU device (one workgroup per CU), found %d CUs\n", cus); grid = -1; return; }
        int per_cu = 0;
        if (hipOccupancyMaxActiveBlocksPerMultiprocessor(&per_cu, (const void*)mk_fwd, NTHR, LDS_BYTES) != hipSuccess || per_cu < 1) { fprintf(stderr, "kernel_launch: occupancy query reports %d workgroups per CU\n", per_cu); grid = -1; return; }
        grid = 256;
    }
    if (grid < 0) return;
    unsigned char* ws = (unsigned char*)d_ws;
    Args a{};
    P& p = a.p;
    p.x = (const float*)d_in[0]; p.c = (const float*)d_in[1]; p.ada_w = (const float*)d_in[2]; p.ada_b = (const float*)d_in[3]; p.norm1_g = (const float*)d_in[4];
    p.w_in = (const float*)d_in[5]; p.b_in = (const float*)d_in[6]; p.dw_w = (const float*)d_in[7]; p.dw_b = (const float*)d_in[8]; p.cln_g = (const float*)d_in[9]; p.cln_b = (const float*)d_in[10];
    p.cw_out = (const float*)d_in[11]; p.cb_out = (const float*)d_in[12]; p.four_w = (const float*)d_in[13]; p.four_b = (const float*)d_in[14]; p.w_out = (const float*)d_in[15]; p.b_out = (const float*)d_in[16];
    p.norm2_g = (const float*)d_in[17]; p.router_w = (const float*)d_in[18]; p.w_gate = (const float*)d_in[19]; p.w_up = (const float*)d_in[20]; p.w_down = (const float*)d_in[21]; p.final_g = (const float*)d_in[22];
    p.out = (float*)d_out;
    p.MOD = (float*)(ws + WS_MOD); p.W2F = (float*)(ws + WS_W2F); p.AFF = (float*)(ws + WS_AFF); p.ROWL = (int*)(ws + WS_ROWL); p.WTS = (float*)(ws + WS_WTS); p.INV = (short*)(ws + WS_INV);
    p.Wt_in = (bf16_t*)(ws + WS_WIN); p.Wt_conv = (bf16_t*)(ws + WS_WCONV); p.Wt_four = (bf16_t*)(ws + WS_WFOUR); p.Wt_out = (bf16_t*)(ws + WS_WOUT);
    p.D256 = (bf16_t*)(ws + WS_D256); p.GP = (bf16_t*)(ws + WS_GP); p.Wt_gu = (bf16_t*)(ws + WS_WGU); p.Wt_down = (bf16_t*)(ws + WS_WDOWN);
    p.U = (bf16_t*)(ws + WS_U); p.V = (bf16_t*)(ws + WS_V); p.FT = (bf16_t*)(ws + WS_FT); p.ACONV = (bf16_t*)(ws + WS_ACONV); p.YRI = (bf16_t*)(ws + WS_YRI);
    p.YCONV = (bf16_t*)(ws + WS_YCONV); p.YFOUR = (bf16_t*)(ws + WS_YFOUR); p.MERGED = (bf16_t*)(ws + WS_MERGED); p.ACT = (bf16_t*)(ws + WS_ACT); p.YB = (bf16_t*)(ws + WS_YB); p.DELTA = (bf16_t*)(ws + WS_DELTA);
    (void)hipMemsetAsync(ws + WS_CTL, 0, CTL_ZERO_BYTES, stream);
    a.ctl = (unsigned*)(ws + WS_CTL);
    a.ph_lo = 0; a.ph_hi = 12;
#ifndef PLAIN_LAUNCH
#define PLAIN_LAUNCH 0
#endif
#if PLAIN_LAUNCH
    hipLaunchKernelGGL(mk_fwd, dim3(grid), dim3(NTHR), LDS_BYTES, stream, a);
#else
    { void* kargs[] = {&a}; hipError_t le = hipLaunchCooperativeKernel((const void*)mk_fwd, dim3(grid), dim3(NTHR), kargs, LDS_BYTES, stream);
      if (le != hipSuccess) fprintf(stderr, "kernel_launch: cooperative launch failed: %s\n", hipGetErrorString(le)); }
#endif
}
```

```cpp
#include <hip/hip_runtime.h>
#include <hip/hip_cooperative_groups.h>
#include <cstdio>
#include <cstdint>

#define LAS __attribute__((address_space(3)))
#define GAS __attribute__((address_space(1)))
typedef unsigned short bf16_t;
typedef short bf16x8 __attribute__((ext_vector_type(8)));
typedef float f32x4 __attribute__((ext_vector_type(4)));
typedef float f32x2 __attribute__((ext_vector_type(2)));
typedef unsigned u32x4 __attribute__((ext_vector_type(4)));
typedef unsigned u32x2 __attribute__((ext_vector_type(2)));
typedef int i32x8 __attribute__((ext_vector_type(8)));

constexpr int Bn = 8, S = 4096, D = 1024, T = Bn * S;
constexpr int CW = 512, CK = 31, FW = 512, FG = 4, FGD = 128;
constexpr int INC = 2 * CW + FW + 2 * D;
constexpr int E = 16, CAP = 2 * S / E;
constexpr int F = 2 * D;
constexpr int NMOD = 6;
constexpr int ME = Bn * CAP;
constexpr int NWAVES = 8, NTHR = 512;

__device__ __forceinline__ float sigmoidf_(float x) { return __builtin_amdgcn_rcpf(1.f + __expf(-x)); }
__device__ __forceinline__ float siluf_(float x) { return x * __builtin_amdgcn_rcpf(1.f + __expf(-x)); }
__device__ __forceinline__ unsigned f2bf(float f) { unsigned u = __builtin_bit_cast(unsigned, f); return (u + 0x7fffu + ((u >> 16) & 1u)) >> 16; }
__device__ __forceinline__ unsigned pk2(float lo, float hi) { return f2bf(lo) | (f2bf(hi) << 16); }
__device__ __forceinline__ unsigned cvt_pk_bf16(float lo, float hi) { unsigned r; asm volatile("v_cvt_pk_bf16_f32 %0, %1, %2" : "=v"(r) : "v"(lo), "v"(hi)); return r; }
__device__ __forceinline__ float bf_lo(unsigned w) { return __builtin_bit_cast(float, w << 16); }
__device__ __forceinline__ float bf_hi(unsigned w) { return __builtin_bit_cast(float, w & 0xffff0000u); }
__device__ __forceinline__ float wave_sum(float v) {
#pragma unroll
    for (int o = 1; o < 64; o <<= 1) v += __shfl_xor(v, o);
    return v;
}
__device__ __forceinline__ u32x2 pack8_f8(const f32x4 v0, const f32x4 v1, const float sc) {
    unsigned a = 0u, b = 0u;
    a = __builtin_amdgcn_cvt_pk_fp8_f32(v0[0] * sc, v0[1] * sc, a, false); a = __builtin_amdgcn_cvt_pk_fp8_f32(v0[2] * sc, v0[3] * sc, a, true);
    b = __builtin_amdgcn_cvt_pk_fp8_f32(v1[0] * sc, v1[1] * sc, b, false); b = __builtin_amdgcn_cvt_pk_fp8_f32(v1[2] * sc, v1[3] * sc, b, true);
    return (u32x2){a, b};
}
#define LDS_WAIT() asm volatile("s_waitcnt lgkmcnt(0)" ::: "memory")
#define VM_WAIT() asm volatile("s_waitcnt vmcnt(0)" ::: "memory")

namespace pg8 {
constexpr int BM = 256, BK = 64, HALF = 128, HTB = HALF * BK * 2  , STAGE_BYTES = 8 * HTB, NXCD = 8, WGM = 8;
__host__ __device__ __forceinline__ int lds_byte(int r, int c) { const int st = (r >> 4) * 2 + (c >> 5), rr = r & 15, cc = c & 31, ob = rr * 64 + cc * 2; return st * 1024 + (ob ^ (((ob >> 9) & 1) << 5)); }
__host__ __device__ __forceinline__ void stage_rc(int b, int& R, int& C) { const int st = b / 1024, sb = b % 1024, swz = sb ^ (((sb >> 9) & 1) << 5); R = (st >> 1) * 16 + swz / 64; C = (st & 1) * 32 + (swz % 64) / 2; }
__host__ __device__ __forceinline__ int f8_off(int r, int fq) { const int rr = r & 15; return ((r >> 4) * 2 + (fq >> 1)) * 1024 + ((rr * 64 + 32 * (fq & 1)) ^ ((rr >> 3) << 5)); }
__host__ __device__ __forceinline__ int perm32(int rho) { const int n = rho >> 4, i = rho & 15; return 8 * (i >> 2) + 4 * n + (i & 3); }

struct Unit { const char* a; const char* b; const int* rows; int pm, pn, e; };

template <class Epi, class Sched, bool GATHER, bool F8 = false>
__device__ __forceinline__ void gemm_phase(LAS unsigned char* lds, const int KB, const Sched& S, const Epi& E, const int sw = 0x7f7f7f7f, const int sx = 0x7f7f7f7f) {
    int tid_ = threadIdx.x; asm volatile("" : "+v"(tid_));
    const int tid = tid_, wid = __builtin_amdgcn_readfirstlane(tid >> 6), lane = tid & 63, wr = wid >> 2, wc = wid & 3, fr = lane & 15, fq = lane >> 4;
    const int nt = KB / (BK * 2);
    int swv = sw, sxv = sx; if constexpr (F8) { asm volatile("" : "+v"(swv), "+v"(sxv)); }
    unsigned voffA[2], voffB[2]; int R0, C0;
#pragma unroll
    for (int i = 0; i < 2; ++i) { int R, C; stage_rc(tid * 16 + i * 8192, R, C); const int Rb = Epi::PERM ? ((R & ~31) + perm32(R & 31)) : R;
        voffA[i] = (unsigned)(R * KB + C * 2); voffB[i] = (unsigned)(Rb * KB + C * 2); if (i == 0) { R0 = R; C0 = C; } }
    const size_t kstep = (size_t)(BK * 2);
    const size_t hstep = (size_t)HALF * KB;
    const unsigned ldsw = (unsigned)wid * 1024u;
    const int aoff = lds_byte(wr * 64 + fr, fq * 8), boff = lds_byte(wc * 32 + fr, fq * 8);
#define PG8_SA(b, h) (((b) * 2 + (h)) * HTB)
#define PG8_SB(b, h) ((4 + (b) * 2 + (h)) * HTB)
#define PG8_STAGE(bufoff, gbase, voff) do { _Pragma("unroll") for (int _i = 0; _i < 2; ++_i) \
        __builtin_amdgcn_global_load_lds((const unsigned*)((const char*)(gbase) + (voff)[_i]), (LAS unsigned*)(lds + (bufoff) + ldsw + _i * 8192), 16, 0, 0); } while (0)
#define PG8_STGA(bufoff, p, h, v) do { if constexpr (GATHER) { PG8_STAGE(bufoff, p, (v) + 2 * (h)); } else { PG8_STAGE(bufoff, (p) + (h) * hstep, voffA); } } while (0)
#define PG8_LD8(p) __builtin_bit_cast(i32x8, __builtin_shufflevector(*(const LAS u32x4*)(p), *(const LAS u32x4*)((p) + 1024), 0, 1, 2, 3, 4, 5, 6, 7))
#define PG8_LDA(dst, b, h) do { if constexpr (F8) { _Pragma("unroll") for (int m = 0; m < 4; ++m) dst##8[m] = PG8_LD8(lds + PG8_SA(b, h) + aoff + m * 2048); } \
      else { _Pragma("unroll") for (int m = 0; m < 4; ++m) _Pragma("unroll") for (int k = 0; k < 2; ++k) dst[m][k] = *(const LAS bf16x8*)(lds + PG8_SA(b, h) + aoff + m * 2048 + k * 1024); } } while (0)
#define PG8_LDB(dst, b, h) do { if constexpr (F8) { _Pragma("unroll") for (int n = 0; n < 2; ++n) dst##8[n] = PG8_LD8(lds + PG8_SB(b, h) + boff + n * 2048); } \
      else { _Pragma("unroll") for (int n = 0; n < 2; ++n) _Pragma("unroll") for (int k = 0; k < 2; ++k) dst[n][k] = *(const LAS bf16x8*)(lds + PG8_SB(b, h) + boff + n * 2048 + k * 1024); } } while (0)
#define PG8_MMA(ai, bj, At, Bt) do { __builtin_amdgcn_s_setprio(1); if constexpr (F8) { _Pragma("unroll") for (int m = 0; m < 4; ++m) _Pragma("unroll") for (int n = 0; n < 2; ++n) \
        asm volatile("v_mfma_scale_f32_16x16x128_f8f6f4 %0, %1, %2, %0, %3, %4 op_sel_hi:[0,0,0]" : "+v"(acc[ai][bj][m][n]) : "v"(Bt##8[n]), "v"(At##8[m]), "v"(swv), "v"(sxv)); } \
      else { _Pragma("unroll") for (int m = 0; m < 4; ++m) _Pragma("unroll") for (int n = 0; n < 2; ++n) _Pragma("unroll") for (int k = 0; k < 2; ++k) \
        acc[ai][bj][m][n] = __builtin_amdgcn_mfma_f32_16x16x32_bf16(Bt[n][k], At[m][k], acc[ai][bj][m][n], 0, 0, 0); } __builtin_amdgcn_s_setprio(0); } while (0)
#define PG8_WAIT_V(n) asm volatile("s_waitcnt vmcnt(" #n ")" ::: "memory")
#define PG8_WAIT_L(n) asm volatile("s_waitcnt lgkmcnt(" #n ")" ::: "memory")
#define PG8_BAR __builtin_amdgcn_s_barrier()
#define PG8_SCHED __builtin_amdgcn_sched_barrier(0)
#define PG8_ROWS(u, v) do { if constexpr (GATHER) { _Pragma("unroll") for (int _h = 0; _h < 2; ++_h) _Pragma("unroll") for (int _i = 0; _i < 2; ++_i) \
        v[_h * 2 + _i] = (unsigned)((u).rows[_h * 128 + R0 + 64 * _i] * KB + C0 * 2); } } while (0)
    Unit cur, nxt; int ui = 0;
    if (!S.next(0, cur)) return;
    f32x4 acc[2][2][4][2];
#pragma unroll
    for (int a = 0; a < 2; ++a)
#pragma unroll
        for (int b = 0; b < 2; ++b)
#pragma unroll
            for (int m = 0; m < 4; ++m)
#pragma unroll
                for (int n = 0; n < 2; ++n) acc[a][b][m][n] = (f32x4){0.f, 0.f, 0.f, 0.f};
    bf16x8 At[4][2], B0[2][2], B1[2][2]; i32x8 At8[4], B08[2], B18[2];
    unsigned vAc[4] = {0u, 0u, 0u, 0u}, vAn[4] = {0u, 0u, 0u, 0u}, vW[4] = {0u, 0u, 0u, 0u};
    PG8_ROWS(cur, vAc);
    const char* cA = cur.a; const char* cB = cur.b;
    PG8_STAGE(PG8_SB(0, 0), cB, voffB); PG8_STAGE(PG8_SB(0, 1), cB + hstep, voffB); PG8_STGA(PG8_SA(0, 0), cA, 0, vAc); PG8_STGA(PG8_SA(0, 1), cA, 1, vAc);
    if (wr == 1) PG8_BAR;
    PG8_WAIT_V(2); PG8_BAR;
    PG8_STAGE(PG8_SB(1, 0), cB + kstep, voffB); PG8_STGA(PG8_SA(1, 0), cA + kstep, 0, vAc); PG8_STAGE(PG8_SB(1, 1), cB + hstep + kstep, voffB);
    PG8_WAIT_V(6); PG8_BAR;
    for (;;) {
        const bool has_next = S.next(ui + 1, nxt);
        if (has_next) { PG8_ROWS(nxt, vAn); } else {
#pragma unroll
            for (int j = 0; j < 4; ++j) vAn[j] = vAc[j]; }
        const char* nA = has_next ? nxt.a : cA; const char* nB = has_next ? nxt.b : cB;
        for (int t = 0; t < nt; t += 2) {
            const bool last = (t == nt - 2);
            const char* a1 = cA + (size_t)(t + 1) * kstep;
            const char* a2 = last ? nA : cA + (size_t)(t + 2) * kstep; const char* b2 = last ? nB : cB + (size_t)(t + 2) * kstep;
            const char* a3 = a2 + kstep; const char* b3 = b2 + kstep;
            if constexpr (GATHER) {
                if (last) { asm volatile("" ::: "memory");
#pragma unroll
                    for (int j = 0; j < 4; ++j) vW[j] = vAn[j]; }
                else {
#pragma unroll
                    for (int j = 0; j < 4; ++j) vW[j] = vAc[j]; } }
            PG8_LDB(B0, 0, 0); PG8_LDB(B1, 0, 1); PG8_SCHED; PG8_LDA(At, 0, 0); PG8_STGA(PG8_SA(1, 1), a1, 1, vAc);
            PG8_WAIT_V(8); PG8_WAIT_L(0); PG8_BAR; PG8_MMA(0, 0, At, B0); PG8_MMA(0, 1, At, B1); PG8_BAR; PG8_SCHED;
            PG8_LDA(At, 0, 1); PG8_STAGE(PG8_SB(0, 0), b2, voffB); PG8_STAGE(PG8_SB(0, 1), b2 + hstep, voffB); PG8_STGA(PG8_SA(0, 0), a2, 0, vW);
            PG8_WAIT_V(8); PG8_WAIT_L(0); PG8_BAR; PG8_MMA(1, 0, At, B0); PG8_MMA(1, 1, At, B1); PG8_BAR; PG8_SCHED;
            PG8_LDB(B0, 1, 0); PG8_LDB(B1, 1, 1); PG8_SCHED; PG8_LDA(At, 1, 0); PG8_STGA(PG8_SA(0, 1), a2, 1, vW);
            PG8_WAIT_V(8); PG8_WAIT_L(0); PG8_BAR; PG8_MMA(0, 0, At, B0); PG8_MMA(0, 1, At, B1); PG8_BAR; PG8_SCHED;
            PG8_LDA(At, 1, 1); PG8_STAGE(PG8_SB(1, 0), b3, voffB); PG8_STAGE(PG8_SB(1, 1), b3 + hstep, voffB); PG8_STGA(PG8_SA(1, 0), a3, 0, vW);
            PG8_WAIT_V(8); PG8_WAIT_L(0); PG8_BAR; PG8_MMA(1, 0, At, B0); PG8_MMA(1, 1, At, B1); PG8_BAR; PG8_SCHED;
        }
        if (wr == 0) PG8_BAR;
        if constexpr (F8) { asm volatile("s_nop 15\n\ts_nop 15" ::: "memory"); }
        E(acc, cur, wr, wc, fr, fq);
        if (!has_next) break;
#pragma unroll
        for (int a = 0; a < 2; ++a)
#pragma unroll
            for (int b = 0; b < 2; ++b)
#pragma unroll
                for (int m = 0; m < 4; ++m)
#pragma unroll
                    for (int n = 0; n < 2; ++n) acc[a][b][m][n] = (f32x4){0.f, 0.f, 0.f, 0.f};
        cur = nxt; cA = nA; cB = nB; ++ui;
#pragma unroll
        for (int j = 0; j < 4; ++j) vAc[j] = vAn[j];
        if (wr == 1) PG8_BAR;
    }
    PG8_WAIT_V(0);
    PG8_BAR;
#undef PG8_SA
#undef PG8_SB
#undef PG8_STAGE
#undef PG8_STGA
#undef PG8_LDA
#undef PG8_LDB
#undef PG8_MMA
#undef PG8_LD8
#undef PG8_WAIT_V
#undef PG8_WAIT_L
#undef PG8_BAR
#undef PG8_SCHED
#undef PG8_ROWS
}

struct SchedDense {
    const char* A; const char* Bt; int nM, nN, nwg, G, c; size_t tstep;
    __device__ void init(const void* A_, const void* Bt_, int M, int N, int K, int G_, int c_) { A = (const char*)A_; Bt = (const char*)Bt_; nM = M / BM; nN = N / BM; nwg = nM * nN; G = G_; c = c_; tstep = (size_t)BM * K * 2; }
    __device__ bool next(int i, Unit& u) const {
        const long L = (long)i * G + c; if (L >= nwg) return false;
        int wgid = (int)L; { const int q = nwg / NXCD, r = nwg % NXCD, xcd = wgid % NXCD, off = wgid / NXCD; wgid = (xcd < r ? xcd * (q + 1) : r * (q + 1) + (xcd - r) * q) + off; }
        const int nig = WGM * nN, gid = wgid / nig, fm = gid * WGM, gsz = (nM - fm) < WGM ? (nM - fm) : WGM;
        u.pm = fm + ((wgid % nig) % gsz); u.pn = (wgid % nig) / gsz; u.e = 0; u.rows = nullptr;
        u.a = A + (size_t)u.pm * tstep; u.b = Bt + (size_t)u.pn * tstep; return true;
    }
};
}

#ifndef H_DELTA
#define H_DELTA 1
#endif
#ifndef YB_F8
#define YB_F8 1
#endif
#ifndef MOE_F8
#define MOE_F8 1
#endif

namespace epi {
using pg8::Unit;
#define EPI_ROWS(ai, m) (128 * (ai) + 64 * wr + 16 * (m) + fr)
__device__ __forceinline__ u32x4 pack8(const f32x4 v0, const f32x4 v1) { u32x4 w; w.x = cvt_pk_bf16(v0[0], v0[1]); w.y = cvt_pk_bf16(v0[2], v0[3]); w.z = cvt_pk_bf16(v1[0], v1[1]); w.w = cvt_pk_bf16(v1[2], v1[3]); return w; }
__device__ __forceinline__ f32x4 sig4(const f32x4 v) { return (f32x4){sigmoidf_(v[0]), sigmoidf_(v[1]), sigmoidf_(v[2]), sigmoidf_(v[3])}; }
__device__ __forceinline__ f32x4 silu4(const f32x4 v) { return (f32x4){siluf_(v[0]), siluf_(v[1]), siluf_(v[2]), siluf_(v[3])}; }
__device__ __forceinline__ void unpack8(const u32x4 w, f32x4& v0, f32x4& v1) { v0 = (f32x4){bf_lo(w.x), bf_hi(w.x), bf_lo(w.y), bf_hi(w.y)}; v1 = (f32x4){bf_lo(w.z), bf_hi(w.z), bf_lo(w.w), bf_hi(w.w)}; }

struct EpiGlu {
    static constexpr bool PERM = true;
    bf16_t* V; const float* bias;
    __device__ __forceinline__ void operator()(const f32x4 (&acc)[2][2][4][2], const Unit& u, int wr, int wc, int fr, int fq) const {
        const int ch = u.pn * 128 + wc * 32 + 8 * fq;
        f32x4 ba[2], bg[2];
#pragma unroll
        for (int n = 0; n < 2; ++n) { ba[n] = *(const f32x4*)(bias + ch + 4 * n); bg[n] = *(const f32x4*)(bias + CW + ch + 4 * n); }
#pragma unroll
        for (int ai = 0; ai < 2; ++ai)
#pragma unroll
            for (int m = 0; m < 4; ++m) { const size_t row = (size_t)u.pm * 256 + EPI_ROWS(ai, m);
                const f32x4 v0 = (acc[ai][0][m][0] + ba[0]) * sig4(acc[ai][1][m][0] + bg[0]), v1 = (acc[ai][0][m][1] + ba[1]) * sig4(acc[ai][1][m][1] + bg[1]);
                *(u32x4*)(V + row * CW + ch) = pack8(v0, v1); }
    }
};
struct EpiFT {
    static constexpr bool PERM = true;
    bf16_t* FT; const float* bias;
    __device__ __forceinline__ void operator()(const f32x4 (&acc)[2][2][4][2], const Unit& u, int wr, int wc, int fr, int fq) const {
#pragma unroll
        for (int ai = 0; ai < 2; ++ai)
#pragma unroll
            for (int m = 0; m < 4; ++m) { const int ch = u.pm * 256 + EPI_ROWS(ai, m); const float bv = bias[ch];
#pragma unroll
                for (int bj = 0; bj < 2; ++bj) { const int tok = u.pn * 256 + bj * 128 + wc * 32 + 8 * fq; const int b = tok >> 12, s = tok & (S - 1);
                    *(u32x4*)(FT + ((size_t)(b * FW + ch) * S + s)) = pack8(acc[ai][bj][m][0] + bv, acc[ai][bj][m][1] + bv); } }
    }
};
struct EpiFFT {
    static constexpr bool PERM = true;
    bf16_t* YRI;
    __device__ __forceinline__ void operator()(const f32x4 (&acc)[2][2][4][2], const Unit& u, int wr, int wc, int fr, int fq) const {
        const int part = u.pm, chb = u.pn & 1, k2 = (u.pn >> 1) & 15, b = u.pn >> 5;
#pragma unroll
        for (int ai = 0; ai < 2; ++ai)
#pragma unroll
            for (int m = 0; m < 4; ++m) { const int k1 = EPI_ROWS(ai, m);
                bf16_t* rowp = YRI + ((size_t)(b * S + 16 * k1 + k2) * (2 * FW) + part * FW + chb * 256 + wc * 32 + 8 * fq);
#pragma unroll
                for (int bj = 0; bj < 2; ++bj) *(u32x4*)(rowp + bj * 128) = pack8(acc[ai][bj][m][0], acc[ai][bj][m][1]); }
    }
};
struct EpiBias {
    static constexpr bool PERM = true;
    bf16_t* O; int ldc; const float* bias;
    __device__ __forceinline__ void operator()(const f32x4 (&acc)[2][2][4][2], const Unit& u, int wr, int wc, int fr, int fq) const {
        const int col0 = u.pn * 256 + wc * 32 + 8 * fq;
        f32x4 bv[2][2];
#pragma unroll
        for (int bj = 0; bj < 2; ++bj)
#pragma unroll
            for (int n = 0; n < 2; ++n) bv[bj][n] = *(const f32x4*)(bias + col0 + bj * 128 + 4 * n);
#pragma unroll
        for (int ai = 0; ai < 2; ++ai)
#pragma unroll
            for (int m = 0; m < 4; ++m) { bf16_t* rowp = O + ((size_t)u.pm * 256 + EPI_ROWS(ai, m)) * ldc + col0;
#pragma unroll
                for (int bj = 0; bj < 2; ++bj) *(u32x4*)(rowp + bj * 128) = pack8(acc[ai][bj][m][0] + bv[bj][0], acc[ai][bj][m][1] + bv[bj][1]); }
    }
};
struct EpiMerge {
    static constexpr bool PERM = true;
    bf16_t* MG; const bf16_t* YC; const bf16_t* YF; const float* bias;
    __device__ __forceinline__ void operator()(const f32x4 (&acc)[2][2][4][2], const Unit& u, int wr, int wc, int fr, int fq) const {
        const int nn = u.pn * 128 + wc * 32 + 8 * fq;
        f32x4 b0[2], b1[2];
#pragma unroll
        for (int n = 0; n < 2; ++n) { b0[n] = *(const f32x4*)(bias + 2 * CW + FW + nn + 4 * n); b1[n] = *(const f32x4*)(bias + 2 * CW + FW + D + nn + 4 * n); }
#pragma unroll
        for (int ai = 0; ai < 2; ++ai)
#pragma unroll
            for (int m = 0; m < 4; ++m) { const size_t off = ((size_t)u.pm * 256 + EPI_ROWS(ai, m)) * D + nn;
                const u32x4 wc_ = *(const u32x4*)(YC + off), wf_ = *(const u32x4*)(YF + off);
                f32x4 c0, c1, f0, f1; unpack8(wc_, c0, c1); unpack8(wf_, f0, f1);
                const f32x4 v0 = sig4(acc[ai][0][m][0] + b0[0]) * c0 + sig4(acc[ai][1][m][0] + b1[0]) * f0;
                const f32x4 v1 = sig4(acc[ai][0][m][1] + b0[1]) * c1 + sig4(acc[ai][1][m][1] + b1[1]) * f1;
                *(u32x4*)(MG + off) = pack8(v0, v1); }
    }
};
struct EpiResid {
    static constexpr bool PERM = false;
    const float* X; float* H; const float* gate; const float* bias;
    __device__ __forceinline__ void operator()(const f32x4 (&acc)[2][2][4][2], const Unit& u, int wr, int wc, int fr, int fq) const {
        const int col0 = u.pn * 256 + wc * 32 + 4 * fq; const int b = (u.pm * 256) >> 12;
        const float* gp = gate + (size_t)b * NMOD * D + col0; const float* bp = bias + col0;
#pragma unroll
        for (int ai = 0; ai < 2; ++ai) {
            f32x4 xv[4][2][2];
#pragma unroll
            for (int m = 0; m < 4; ++m) { const size_t off = ((size_t)u.pm * 256 + EPI_ROWS(ai, m)) * D + col0;
#pragma unroll
                for (int bj = 0; bj < 2; ++bj)
#pragma unroll
                    for (int n = 0; n < 2; ++n) xv[m][bj][n] = *(const f32x4*)(X + off + bj * 128 + n * 16); }
#pragma unroll
            for (int bj = 0; bj < 2; ++bj)
#pragma unroll
                for (int n = 0; n < 2; ++n) { const f32x4 gv = *(const f32x4*)(gp + bj * 128 + n * 16), bv = *(const f32x4*)(bp + bj * 128 + n * 16);
#pragma unroll
                    for (int m = 0; m < 4; ++m) { const size_t off = ((size_t)u.pm * 256 + EPI_ROWS(ai, m)) * D + col0;
                        *(f32x4*)(H + off + bj * 128 + n * 16) = xv[m][bj][n] + gv * (acc[ai][bj][m][n] + bv); } }
            asm volatile("" ::: "memory");
        }
    }
};
struct EpiDelta {
    static constexpr bool PERM = true;
    bf16_t* DL; const float* gate; const float* bias;
    __device__ __forceinline__ void operator()(const f32x4 (&acc)[2][2][4][2], const Unit& u, int wr, int wc, int fr, int fq) const {
        const int col0 = u.pn * 256 + wc * 32 + 8 * fq; const int b = (u.pm * 256) >> 12;
        f32x4 bv[2][2], gv[2][2];
#pragma unroll
        for (int bj = 0; bj < 2; ++bj)
#pragma unroll
            for (int n = 0; n < 2; ++n) { bv[bj][n] = *(const f32x4*)(bias + col0 + bj * 128 + 4 * n); gv[bj][n] = *(const f32x4*)(gate + (size_t)b * NMOD * D + col0 + bj * 128 + 4 * n); }
#pragma unroll
        for (int ai = 0; ai < 2; ++ai)
#pragma unroll
            for (int m = 0; m < 4; ++m) { bf16_t* rowp = DL + ((size_t)u.pm * 256 + EPI_ROWS(ai, m)) * D + col0;
#pragma unroll
                for (int bj = 0; bj < 2; ++bj) *(u32x4*)(rowp + bj * 128) = pack8(gv[bj][0] * (acc[ai][bj][m][0] + bv[bj][0]), gv[bj][1] * (acc[ai][bj][m][1] + bv[bj][1])); }
    }
};
constexpr float ACT_SC = 2.f, U_SC = 4.f, W_SC = 64.f;
constexpr int MX_U = 0x7d7d7d7d, MX_ACT = 0x7e7e7e7e, MX_W = 0x79797979;
template <bool F8> struct EpiSwiglu {
    static constexpr bool PERM = true;
    void* ACT;
    __device__ __forceinline__ void operator()(const f32x4 (&acc)[2][2][4][2], const Unit& u, int wr, int wc, int fr, int fq) const {
        const int col = u.pn * 128 + wc * 32 + 8 * fq;
#pragma unroll
        for (int ai = 0; ai < 2; ++ai)
#pragma unroll
            for (int m = 0; m < 4; ++m) { const size_t row = (size_t)u.e * ME + u.pm * 256 + EPI_ROWS(ai, m);
                const f32x4 v0 = silu4(acc[ai][0][m][0]) * acc[ai][1][m][0], v1 = silu4(acc[ai][0][m][1]) * acc[ai][1][m][1];
                if constexpr (F8) *(u32x2*)((unsigned char*)ACT + row * F + col) = pack8_f8(v0, v1, ACT_SC);
                else *(u32x4*)((bf16_t*)ACT + row * F + col) = pack8(v0, v1); }
    }
};
constexpr float YB_SC = 32.f;
struct EpiScaleW {
    static constexpr bool PERM = true;
    void* YB; const float* W;
    __device__ __forceinline__ void operator()(const f32x4 (&acc)[2][2][4][2], const Unit& u, int wr, int wc, int fr, int fq) const {
        const int col0 = u.pn * 256 + wc * 32 + 8 * fq;
#pragma unroll
        for (int ai = 0; ai < 2; ++ai)
#pragma unroll
            for (int m = 0; m < 4; ++m) { const size_t row = (size_t)u.e * ME + u.pm * 256 + EPI_ROWS(ai, m); const float w = W[row];
#pragma unroll
                for (int bj = 0; bj < 2; ++bj) {
                    if (YB_F8) *(u32x2*)((unsigned char*)YB + row * D + col0 + bj * 128) = pack8_f8(acc[ai][bj][m][0], acc[ai][bj][m][1], w * YB_SC);
                    else *(u32x4*)((bf16_t*)YB + row * D + col0 + bj * 128) = pack8(acc[ai][bj][m][0] * w, acc[ai][bj][m][1] * w); } }
    }
};
#undef EPI_ROWS
}

namespace pg8 {
struct SchedG1 {
    const char* U; const char* W; const int* rowl; int G, c, esz;
    __device__ bool next(int i, Unit& u) const {
        int e;
        if (G == 256) { if (i >= 16) return false; const int xcd = c & 7, j = c >> 3, ri = i & 7; e = 2 * xcd + (i >> 3); u.pm = (ri & 1) * 8 + (j & 7); u.pn = (ri >> 1) * 4 + (j >> 3); }
        else { const int L = i * G + c; if (L >= E * 256) return false; e = L >> 8; const int l = L & 255; u.pm = l & 15; u.pn = l >> 4; }
        u.e = e; u.a = U; u.rows = rowl + e * ME + u.pm * 256; u.b = W + ((size_t)e * 2 * F + (size_t)u.pn * 256) * D * esz; return true;
    }
};
struct SchedG2 {
    const char* ACT; const char* W; int G, c, esz;
    __device__ bool next(int i, Unit& u) const {
        int e;
        if (G == 256) { if (i >= 4) return false; const int xcd = c & 7, j = c >> 3; e = 2 * xcd + (i >> 1); u.pm = (i & 1) * 8 + (j & 7); u.pn = j >> 3; }
        else { const int L = i * G + c; if (L >= E * 64) return false; e = L >> 6; const int l = L & 63; u.pm = l & 15; u.pn = l >> 4; }
        u.e = e; u.rows = nullptr;
        u.a = ACT + ((size_t)e * ME + (size_t)u.pm * 256) * F * esz; u.b = W + ((size_t)e * D + (size_t)u.pn * 256) * F * esz; return true;
    }
};
}

struct Ctx {
    LAS unsigned char* lds; int tid, lane, wave, vcu, G;
};

__device__ __forceinline__ void transpose_item(const float* W, int ldw, int k0, int n0, bf16_t* WT, int ldt, int dst_row0, LAS float* scr, int lane) {
#pragma unroll 8
    for (int i = 0; i < 32; ++i) { const int kk = 2 * i + (lane >> 5); scr[kk * 33 + (lane & 31)] = W[(size_t)(k0 + kk) * ldw + n0 + (lane & 31)]; }
    LDS_WAIT(); asm volatile("" ::: "memory");
    const int c = lane & 7;
#pragma unroll
    for (int j = 0; j < 4; ++j) { const int n = (lane >> 3) + 8 * j; const LAS float* s = scr + (8 * c) * 33 + n;
        u32x4 o; o.x = pk2(s[0 * 33], s[1 * 33]); o.y = pk2(s[2 * 33], s[3 * 33]); o.z = pk2(s[4 * 33], s[5 * 33]); o.w = pk2(s[6 * 33], s[7 * 33]);
        *(GAS u32x4*)(WT + (size_t)(dst_row0 + n) * ldt + k0 + 8 * c) = o; }
    LDS_WAIT(); asm volatile("" ::: "memory");
}
struct TItem { const float* src; unsigned char* dst; int ldw, ldt; };
__device__ __forceinline__ void titem_load(const TItem& t, int lane, f32x4 (&v)[8]) {
#pragma unroll
    for (int i = 0; i < 8; ++i) v[i] = *(const GAS f32x4*)(t.src + (size_t)(8 * i + (lane >> 3)) * t.ldw + (lane & 7) * 4);
}
__device__ __forceinline__ void titem_store_f8(const TItem& t, int lane, const f32x4 (&v)[8], LAS float* scr, float sc) {
#pragma unroll
    for (int i = 0; i < 8; ++i) { LAS float* d = scr + (8 * i + (lane >> 3)) * 33 + (lane & 7) * 4; d[0] = v[i][0]; d[1] = v[i][1]; d[2] = v[i][2]; d[3] = v[i][3]; }
    LDS_WAIT(); asm volatile("" ::: "memory");
#pragma unroll
    for (int j = 0; j < 2; ++j) { const int idx = lane + 64 * j, n = idx >> 2, c = idx & 3; const LAS float* s = scr + (16 * c) * 33 + n;
        unsigned w[4];
#pragma unroll
        for (int q = 0; q < 4; ++q) { unsigned tt = 0u; tt = __builtin_amdgcn_cvt_pk_fp8_f32(s[(4 * q + 0) * 33] * sc, s[(4 * q + 1) * 33] * sc, tt, false); tt = __builtin_amdgcn_cvt_pk_fp8_f32(s[(4 * q + 2) * 33] * sc, s[(4 * q + 3) * 33] * sc, tt, true); w[q] = tt; }
        *(GAS u32x4*)(t.dst + (size_t)n * t.ldt + 16 * c) = (u32x4){w[0], w[1], w[2], w[3]}; }
    LDS_WAIT(); asm volatile("" ::: "memory");
}
__device__ __forceinline__ int win_row(int n0) {
    if (n0 < 2 * CW) { const int half = n0 / CW, ch = n0 % CW; return 256 * (ch / 128) + 128 * half + (ch % 128); }
    if (n0 < 2 * CW + FW) return n0;
    const int cc = n0 - (2 * CW + FW), half = cc / D, c2 = cc % D; return 2 * CW + FW + 256 * (c2 / 128) + 128 * half + (c2 % 128);
}

struct P {
    const float *x, *c, *ada_w, *ada_b, *norm1_g, *w_in, *b_in, *dw_w, *dw_b, *cln_g, *cln_b, *cw_out, *cb_out, *four_w, *four_b, *w_out, *b_out, *norm2_g, *router_w, *w_gate, *w_up, *w_down, *final_g;
    float* out;
    float* MOD; float* W2F; float* AFF; int* ROWL; float* WTS; short* INV;
    bf16_t *Wt_in, *Wt_conv, *Wt_four, *Wt_out, *D256, *GP, *Wt_gu, *Wt_down;
    bf16_t *U, *V, *FT, *ACONV, *YRI, *YCONV, *YFOUR, *MERGED, *ACT, *YB, *DELTA;
};

__device__ __forceinline__ void titem_store_bf16(const TItem& t, int lane, const f32x4 (&v)[8], LAS float* scr) {
#pragma unroll
    for (int i = 0; i < 8; ++i) { LAS float* d = scr + (8 * i + (lane >> 3)) * 33 + (lane & 7) * 4; d[0] = v[i][0]; d[1] = v[i][1]; d[2] = v[i][2]; d[3] = v[i][3]; }
    LDS_WAIT(); asm volatile("" ::: "memory");
    const int c = lane & 7;
#pragma unroll
    for (int j = 0; j < 4; ++j) { const int n = (lane >> 3) + 8 * j; const LAS float* s = scr + (8 * c) * 33 + n;
        u32x4 o; o.x = pk2(s[0 * 33], s[1 * 33]); o.y = pk2(s[2 * 33], s[3 * 33]); o.z = pk2(s[4 * 33], s[5 * 33]); o.w = pk2(s[6 * 33], s[7 * 33]);
        *(GAS u32x4*)(t.dst + ((size_t)n * t.ldt + 8 * c) * 2) = o; }
    LDS_WAIT(); asm volatile("" ::: "memory");
}
__device__ __forceinline__ TItem small_item(const P& p, int r) {
    constexpr int I1 = (D / 64) * (INC / 32), I2 = (CW / 64) * (D / 32);
    TItem t;
    if (r < I1) { const int kb = r / (INC / 32), nb = r % (INC / 32); t.src = p.w_in + (size_t)(64 * kb) * INC + 32 * nb; t.ldw = INC; t.ldt = D; t.dst = (unsigned char*)(p.Wt_in + (size_t)win_row(32 * nb) * D + 64 * kb); return t; }
    r -= I1;
    if (r < I2) { const int kb = r / (D / 32), nb = r % (D / 32); t.src = p.cw_out + (size_t)(64 * kb) * D + 32 * nb; t.ldw = D; t.ldt = CW; t.dst = (unsigned char*)(p.Wt_conv + (size_t)(32 * nb) * CW + 64 * kb); return t; }
    r -= I2;
    { const int kb = r / (D / 32), nb = r % (D / 32); t.src = p.w_out + (size_t)(64 * kb) * D + 32 * nb; t.ldw = D; t.ldt = D; t.dst = (unsigned char*)(p.Wt_out + (size_t)(32 * nb) * D + 64 * kb); return t; }
}
__device__ __forceinline__ void phase_p0a(const Ctx& X0, const P& p) {
    Ctx X = X0; X.tid = (int)threadIdx.x; asm volatile("" : "+v"(X.tid)); X.lane = X.tid & 63;
    LAS float* scr = (LAS float*)(X.lds + X.wave * 16384);
    const int gw = X.vcu * NWAVES + X.wave, NGW = X.G * NWAVES;
    constexpr int I1 = (D / 64) * (INC / 32), I2 = (CW / 64) * (D / 32), I4 = (D / 64) * (D / 32);
    const bool do_mod = X.vcu < NMOD * D / 32; const int mcol = X.tid & 31, mks = X.tid >> 5, mj0 = X.vcu * 32;
    float mw[64];
    if (do_mod) {
#pragma unroll
        for (int k = 0; k < 64; ++k) mw[k] = p.ada_w[(size_t)(mks * 64 + k) * (NMOD * D) + mj0 + mcol]; }
    const int fg = X.vcu / (D / 16), fn0 = (X.vcu % (D / 16)) * 16;
    f32x4 ftile = (f32x4){0.f, 0.f, 0.f, 0.f};
    if (X.vcu < FG * (D / 16)) ftile = *(const GAS f32x4*)(p.four_w + (size_t)(fg * FGD + (X.tid >> 2)) * D + fn0 + (X.tid & 3) * 4);
    {   f32x4 va[8], vb[8]; TItem cur, nx; int it = gw;
        if (it < I1 + I2 + I4) { cur = small_item(p, it); titem_load(cur, X.lane, va); }
        while (it < I1 + I2 + I4) {
            const int nxt = it + NGW; if (nxt < I1 + I2 + I4) { nx = small_item(p, nxt); titem_load(nx, X.lane, vb); }
            titem_store_bf16(cur, X.lane, va, scr);
#pragma unroll
            for (int i = 0; i < 8; ++i) va[i] = vb[i];
            cur = nx; it = nxt;
        }
    }
    __syncthreads();
    LAS float* ct = (LAS float*)X.lds; LAS float* c128 = ct + S;
    for (int i = X.tid; i < S; i += NTHR) { float sv, cv; sincospif((float)i / (float)(S / 2), &sv, &cv); ct[i] = cv; }
    if (X.tid < FGD) { float sv, cv; sincospif((float)X.tid / 64.f, &sv, &cv); c128[X.tid] = cv; }
    __syncthreads();
    const int gt = X.vcu * NTHR + X.tid, NGT = X.G * NTHR;
    for (int it = gt; it < 512 * 64; it += NGT) { const int r = it >> 6, c0 = (it & 63) * 8; const int part = r >> 8, k1 = r & 255, pc = c0 >> 8, s10 = c0 & 255;
        const int ph = (part == pc) ? 0 : (part == 0 ? -(S / 4) : (S / 4));
        unsigned w[4];
#pragma unroll
        for (int j = 0; j < 4; ++j) { const float a = ct[(16 * k1 * (s10 + 2 * j) + ph) & (S - 1)], b = ct[(16 * k1 * (s10 + 2 * j + 1) + ph) & (S - 1)]; w[j] = pk2(a, b); }
        *(GAS u32x4*)(p.D256 + (size_t)r * 512 + c0) = (u32x4){w[0], w[1], w[2], w[3]}; }
    {
        LAS float* wt = c128 + FGD;
        for (int it = X.vcu; it < FG * (D / 16); it += X.G) { const int g = it / (D / 16), n0 = (it % (D / 16)) * 16;
            __syncthreads();
            if (it == X.vcu) *(LAS f32x4*)(wt + 4 * X.tid) = ftile;
            else for (int i = X.tid; i < FGD * 16; i += NTHR) wt[i] = p.four_w[(size_t)(g * FGD + (i >> 4)) * D + n0 + (i & 15)];
            __syncthreads();
            const int nq = X.tid & 3, c = X.tid >> 2; int idx = 0;
            f32x4 ac = (f32x4){0.f, 0.f, 0.f, 0.f}, as = (f32x4){0.f, 0.f, 0.f, 0.f};
#pragma unroll 8
            for (int j = 0; j < FGD; ++j) { const float tc = c128[idx], ts = c128[(idx + 96) & 127];
                const f32x4 wv = *(const LAS f32x4*)(wt + j * 16 + 4 * nq); ac += wv * tc; as += wv * ts; idx = (idx + c) & 127; }
            *(GAS f32x4*)(p.W2F + (size_t)(g * FGD + c) * D + n0 + 4 * nq) = ac * 0.0013810679320049757f;
            *(GAS f32x4*)(p.W2F + (size_t)(FW + g * FGD + c) * D + n0 + 4 * nq) = as * 0.0013810679320049757f;
        }
    }
    __syncthreads();
    if (do_mod) {
        LAS float* cs = (LAS float*)X.lds;
        LAS float* part = cs + Bn * D;
        for (int i = X.tid; i < Bn * D; i += NTHR) cs[i] = siluf_(p.c[i]);
        __syncthreads();
        const int col = X.tid & 31, ks = X.tid >> 5, j0 = X.vcu * 32;
        float acc[Bn];
#pragma unroll
        for (int b = 0; b < Bn; ++b) acc[b] = 0.f;
#pragma unroll
        for (int k = 0; k < 64; ++k)
#pragma unroll
            for (int b = 0; b < Bn; ++b) acc[b] += cs[b * D + ks * 64 + k] * mw[k];
#pragma unroll
        for (int b = 0; b < Bn; ++b) part[(ks * Bn + b) * 32 + col] = acc[b];
        __syncthreads();
        if (X.tid < Bn * 32) { const int b = X.tid >> 5, cc = X.tid & 31; float s = p.ada_b[j0 + cc];
#pragma unroll
            for (int k2 = 0; k2 < 16; ++k2) s += part[(k2 * Bn + b) * 32 + cc];
            p.MOD[b * NMOD * D + j0 + cc] = s; }
    }
}

__device__ __forceinline__ float row_load_rstd(const float* xr, int lane, f32x4 (&v)[4]) {
    float ss = 0.f;
#pragma unroll
    for (int j = 0; j < 2; ++j) { v[2 * j] = *(const GAS f32x4*)(xr + 8 * lane + 512 * j); v[2 * j + 1] = *(const GAS f32x4*)(xr + 8 * lane + 512 * j + 4); }
#pragma unroll
    for (int q = 0; q < 4; ++q) ss += (v[q][0] * v[q][0] + v[q][1] * v[q][1]) + (v[q][2] * v[q][2] + v[q][3] * v[q][3]);
    return 1.f / sqrtf(wave_sum(ss) * (1.f / D) + 1e-6f);
}
__device__ __forceinline__ void row_issue(const float* xr, int lane, f32x4 (&v)[4]) {
#pragma unroll
    for (int j = 0; j < 4; ++j) v[j] = *(const GAS f32x4*)(xr + 4 * lane + 256 * j);
}
__device__ __forceinline__ float row_rstd(const f32x4 (&v)[4]) {
    float ss = 0.f;
#pragma unroll
    for (int q = 0; q < 4; ++q) ss += (v[q][0] * v[q][0] + v[q][1] * v[q][1]) + (v[q][2] * v[q][2] + v[q][3] * v[q][3]);
    return 1.f / sqrtf(wave_sum(ss) * (1.f / D) + 1e-6f);
}
__device__ __forceinline__ TItem moe_item(const P& p, int r) {
    constexpr int I5 = (D / 64) * (F / 32), I6 = (F / 64) * (D / 32);
    TItem t;
    if (r < E * 2 * I5) { const int eh = r / I5, q = r % I5, e = eh >> 1, half = eh & 1; const int kb = q / (F / 32), nb = q % (F / 32), n0 = 32 * nb;
        t.src = (half ? p.w_up : p.w_gate) + (size_t)e * D * F + (size_t)(64 * kb) * F + n0; t.ldw = F; t.ldt = D;
        t.dst = (unsigned char*)p.Wt_gu + (size_t)e * 2 * F * D + (size_t)(256 * (n0 / 128) + 128 * half + (n0 % 128)) * D + 64 * kb; }
    else { r -= E * 2 * I5; const int e = r / I6, q = r % I6; const int kb = q / (D / 32), nb = q % (D / 32);
        t.src = p.w_down + (size_t)e * F * D + (size_t)(64 * kb) * D + 32 * nb; t.ldw = D; t.ldt = F;
        t.dst = (unsigned char*)p.Wt_down + (size_t)e * D * F + (size_t)(32 * nb) * F + 64 * kb; }
    return t;
}
__device__ __forceinline__ void phase_p0b(const Ctx& X0, const P& p) {
    Ctx X = X0; X.tid = (int)threadIdx.x; asm volatile("" : "+v"(X.tid)); X.lane = X.tid & 63;
    const int gw = X.vcu * NWAVES + X.wave, NGW = X.G * NWAVES;
    {
        f32x4 v[4], vn[4], vn2[4]; int m = gw; if (m < T) row_issue(p.x + (size_t)m * D, X.lane, v);
        if (m + NGW < T) row_issue(p.x + (size_t)(m + NGW) * D, X.lane, vn);
        for (; m < T; m += NGW) {
            const int mn = m + 2 * NGW; if (mn < T) row_issue(p.x + (size_t)mn * D, X.lane, vn2);
            const float rstd = row_rstd(v); const float* md = p.MOD + (size_t)(m >> 12) * NMOD * D;
#pragma unroll
            for (int j = 0; j < 4; ++j) { const int c0 = 4 * X.lane + 256 * j;
                const f32x4 g = *(const f32x4*)(p.norm1_g + c0), sh = *(const f32x4*)(md + c0), sc = *(const f32x4*)(md + D + c0);
                const f32x4 o = v[j] * rstd * g * (sc + 1.f) + sh;
                *(GAS u32x2*)(p.U + (size_t)m * D + c0) = (u32x2){cvt_pk_bf16(o[0], o[1]), cvt_pk_bf16(o[2], o[3])}; }
#pragma unroll
            for (int q = 0; q < 4; ++q) { v[q] = vn[q]; vn[q] = vn2[q]; }
        }
    }
    LAS float* scr = (LAS float*)(X.lds + X.wave * 16384);
    constexpr int I3 = (D / 64) * (D / 32);
    for (int it = gw; it < I3; it += NGW) { const int kb = it / (D / 32), nb = it % (D / 32); transpose_item(p.W2F, D, 64 * kb, 32 * nb, p.Wt_four, D, 32 * nb, scr, X.lane); }
    constexpr int NIT = E * 2 * (D / 64) * (F / 32) + E * (F / 64) * (D / 32);
#if MOE_F8
    {   f32x4 va[8], vb[8], vc[8]; TItem cur, nx, nx2; int it = gw;
        if (it < NIT) { cur = moe_item(p, it); titem_load(cur, X.lane, va); }
        if (it + NGW < NIT) { nx = moe_item(p, it + NGW); titem_load(nx, X.lane, vb); }
        while (it < NIT) {
            const int n2 = it + 2 * NGW; if (n2 < NIT) { nx2 = moe_item(p, n2); titem_load(nx2, X.lane, vc); }
            titem_store_f8(cur, X.lane, va, scr, epi::W_SC);
#pragma unroll
            for (int i = 0; i < 8; ++i) { va[i] = vb[i]; vb[i] = vc[i]; }
            cur = nx; nx = nx2; it += NGW;
        }
    }
#else
    constexpr int I5 = (D / 64) * (F / 32), I6 = (F / 64) * (D / 32);
    for (int it = gw; it < NIT; it += NGW) { int r = it;
        if (r < E * 2 * I5) { const int eh = r / I5, q = r % I5, e = eh >> 1, half = eh & 1; const int kb = q / (F / 32), nb = q % (F / 32), n0 = 32 * nb;
            transpose_item((half ? p.w_up : p.w_gate) + (size_t)e * D * F, F, 64 * kb, n0, p.Wt_gu + (size_t)e * 2 * F * D, D, 256 * (n0 / 128) + 128 * half + (n0 % 128), scr, X.lane); continue; } r -= E * 2 * I5;
        { const int e = r / I6, q = r % I6; const int kb = q / (D / 32), nb = q % (D / 32);
            transpose_item(p.w_down + (size_t)e * F * D, D, 64 * kb, 32 * nb, p.Wt_down + (size_t)e * D * F, F, 32 * nb, scr, X.lane); } }
#endif
}

__device__ __forceinline__ void phase_conv(const Ctx& X0, const P& p) {
    Ctx X = X0; X.tid = (int)threadIdx.x; asm volatile("" : "+v"(X.tid)); X.lane = X.tid & 63;
    constexpr int CH = 32, ROWS = CH + CK - 1;
    LAS unsigned char* rows = X.lds;
    LAS float* wl = (LAS float*)(X.lds + ROWS * 1024);
    for (int i = X.tid; i < CK * CW; i += NTHR) { const int k = i / CW, ch = i % CW; const int ln = ch >> 3, q = (ch >> 2) & 1, r = ch & 3; wl[((k * 2 + q) * 64 + ln) * 4 + r] = p.dw_w[i]; }
    const int lane = X.lane, w = X.wave;
    f32x4 db[2], lg[2], lb[2];
#pragma unroll
    for (int h = 0; h < 2; ++h) { db[h] = *(const f32x4*)(p.dw_b + 8 * lane + 4 * h); lg[h] = *(const f32x4*)(p.cln_g + 8 * lane + 4 * h); lb[h] = *(const f32x4*)(p.cln_b + 8 * lane + 4 * h); }
    u32x4 pre[8];
#define CV_LOAD(chk) do { const int t0_ = (chk) * CH, b_ = t0_ >> 12, s0_ = t0_ & (S - 1); _Pragma("unroll") for (int q = 0; q < 8; ++q) { const int i = X.tid + q * NTHR, r = i >> 6, cseg = i & 63, s = s0_ + r - CK / 2; \
        pre[q] = (u32x4){0u, 0u, 0u, 0u}; if (i < ROWS * 64 && s >= 0 && s < S) pre[q] = *(const GAS u32x4*)(p.V + ((size_t)(b_ * S + s)) * CW + cseg * 8); } } while (0)
    if (X.vcu < T / CH) CV_LOAD(X.vcu);
    for (int chunk = X.vcu; chunk < T / CH; chunk += X.G) {
        const int t0 = chunk * CH;
        __syncthreads();
#pragma unroll
        for (int q = 0; q < 8; ++q) { const int i = X.tid + q * NTHR; if (i < ROWS * 64) *(LAS u32x4*)(rows + (i >> 6) * 1024 + (i & 63) * 16) = pre[q]; }
        if (chunk + X.G < T / CH) CV_LOAD(chunk + X.G);
        __syncthreads();
        f32x4 acc[4][2]; int zo = 0; asm volatile("" : "+v"(zo));
#pragma unroll
        for (int j = 0; j < 4; ++j) { acc[j][0] = db[0]; acc[j][1] = db[1]; }
#pragma unroll
        for (int rr = 0; rr < CK + 3; ++rr) {
            const u32x4 rv = *(const LAS u32x4*)(rows + (4 * w + rr) * 1024 + lane * 16); f32x4 a0, a1; epi::unpack8(rv, a0, a1);
#pragma unroll
            for (int j = 0; j < 4; ++j) { const int k = rr - j;
                if (k >= 0 && k < CK) { const f32x4 w0 = *(const LAS f32x4*)(wl + ((k * 2 + 0) * 64 + lane + zo) * 4), w1 = *(const LAS f32x4*)(wl + ((k * 2 + 1) * 64 + lane + zo) * 4);
                    acc[j][0] += a0 * w0; acc[j][1] += a1 * w1; } }
        }
#pragma unroll
        for (int j = 0; j < 4; ++j) {
            const f32x4 a0 = acc[j][0], a1 = acc[j][1];
            const float mu = wave_sum((a0[0] + a0[1]) + (a0[2] + a0[3]) + (a1[0] + a1[1]) + (a1[2] + a1[3])) * (1.f / CW);
            const f32x4 d0 = a0 - mu, d1 = a1 - mu;
            const float var = wave_sum((d0[0] * d0[0] + d0[1] * d0[1]) + (d0[2] * d0[2] + d0[3] * d0[3]) + (d1[0] * d1[0] + d1[1] * d1[1]) + (d1[2] * d1[2] + d1[3] * d1[3])) * (1.f / CW);
            const float rstd = 1.f / sqrtf(var + 1e-5f);
            const f32x4 z0 = d0 * rstd * lg[0] + lb[0], z1 = d1 * rstd * lg[1] + lb[1];
            *(GAS u32x4*)(p.ACONV + (size_t)(t0 + 4 * w + j) * CW + 8 * lane) = epi::pack8(epi::silu4(z0), epi::silu4(z1));
        }
    }
#undef CV_LOAD
    __syncthreads();
}


__device__ __forceinline__ void dft16_real(const float (&x)[16], float (&gr)[16], float (&gi)[16]) {
    constexpr float WR[10] = {1.f, 0.92387953251128674f, 0.70710678118654752f, 0.38268343236508977f, 0.f, -0.38268343236508977f, -0.70710678118654752f, -0.92387953251128674f, -1.f, -0.92387953251128674f};
    constexpr float WI[10] = {0.f, -0.38268343236508977f, -0.70710678118654752f, -0.92387953251128674f, -1.f, -0.92387953251128674f, -0.70710678118654752f, -0.38268343236508977f, 0.f, 0.38268343236508977f};
    float zr[4][4], zi[4][4];
#pragma unroll
    for (int b = 0; b < 4; ++b) { const float x0 = x[b], x1 = x[4 + b], x2 = x[8 + b], x3 = x[12 + b];
        const float s02 = x0 + x2, d02 = x0 - x2, s13 = x1 + x3, d13 = x1 - x3;
        const float yr[4] = {s02 + s13, d02, s02 - s13, d02}, yi[4] = {0.f, -d13, 0.f, d13};
#pragma unroll
        for (int c = 0; c < 4; ++c) { const float wr = WR[b * c], wi = WI[b * c]; zr[b][c] = yr[c] * wr - yi[c] * wi; zi[b][c] = yr[c] * wi + yi[c] * wr; } }
#pragma unroll
    for (int c = 0; c < 4; ++c) {
        const float ar = zr[0][c] + zr[2][c], ai = zi[0][c] + zi[2][c], br = zr[0][c] - zr[2][c], bi = zi[0][c] - zi[2][c];
        const float cr = zr[1][c] + zr[3][c], ci = zi[1][c] + zi[3][c], dr = zr[1][c] - zr[3][c], di = zi[1][c] - zi[3][c];
        gr[c] = ar + cr;      gi[c] = ai + ci;
        gr[c + 4] = br + di;  gi[c + 4] = bi - dr;
        gr[c + 8] = ar - cr;  gi[c + 8] = ai - ci;
        gr[c + 12] = br - di; gi[c + 12] = bi + dr;
    }
}
__device__ __forceinline__ void phase_fftA(const Ctx& X0, const P& p) {
    Ctx X = X0; X.tid = (int)threadIdx.x; asm volatile("" : "+v"(X.tid)); X.lane = X.tid & 63;
    LAS float* ct = (LAS float*)X.lds;
    for (int i = X.tid; i < S; i += NTHR) { float sv, cv; sincospif((float)i / (float)(S / 2), &sv, &cv); ct[i] = cv; }
    __syncthreads();
    constexpr float C16[16] = {1.f, 0.92387953251128674f, 0.70710678118654752f, 0.38268343236508977f, 0.f, -0.38268343236508977f, -0.70710678118654752f, -0.92387953251128674f,
                               -1.f, -0.92387953251128674f, -0.70710678118654752f, -0.38268343236508977f, 0.f, 0.38268343236508977f, 0.70710678118654752f, 0.92387953251128674f};
    const int chl = X.tid >> 7, sp = X.tid & 127;
    unsigned pre[16];
#define FA_LOAD(itm) do { const bf16_t* src_ = p.FT + ((size_t)(((itm) >> 7) * FW + ((itm) & 127) * 4 + chl) * S + 2 * sp); _Pragma("unroll") for (int s2 = 0; s2 < 16; ++s2) pre[s2] = *(const GAS unsigned*)(src_ + 256 * s2); } while (0)
    if (X.vcu < Bn * (FW / 4)) FA_LOAD(X.vcu);
    for (int it = X.vcu; it < Bn * (FW / 4); it += X.G) {
        const int b = it >> 7, ch = (it & 127) * 4 + chl;
        float xa[16], xb[16];
#pragma unroll
        for (int s2 = 0; s2 < 16; ++s2) { const unsigned w = pre[s2]; xa[s2] = bf_lo(w); xb[s2] = bf_hi(w); }
        if (it + X.G < Bn * (FW / 4)) FA_LOAD(it + X.G);
        float gar[16], gai[16], gbr[16], gbi[16];
        dft16_real(xa, gar, gai); dft16_real(xb, gbr, gbi);
#pragma unroll
        for (int k2 = 0; k2 < 16; ++k2) {
            const float ar = gar[k2], ai = gai[k2], br = gbr[k2], bi = gbi[k2];
            const int ia = (2 * sp * k2) & (S - 1), ib = ((2 * sp + 1) * k2) & (S - 1);
            const float tca = ct[ia], tsa = ct[(ia - S / 4) & (S - 1)], tcb = ct[ib], tsb = ct[(ib - S / 4) & (S - 1)];
            const float gra = ar * tca + ai * tsa, gia = ai * tca - ar * tsa, grb = br * tcb + bi * tsb, gib = bi * tcb - br * tsb;
            bf16_t* dst = p.GP + ((size_t)((b * 16 + k2) * FW + ch) * 512 + 2 * sp);
            *(GAS unsigned*)dst = cvt_pk_bf16(gra, grb); *(GAS unsigned*)(dst + 256) = cvt_pk_bf16(gia, gib);
        }
    }
    __syncthreads();
}

__device__ __forceinline__ void phase_router(const Ctx& X0, const P& p, const float* H) {
    Ctx X = X0; X.tid = (int)threadIdx.x; asm volatile("" : "+v"(X.tid)); X.lane = X.tid & 63;
    LAS float* GP = (LAS float*)X.lds;
    LAS float* SH = GP + D;
    LAS f32x4* ACCP = (LAS f32x4*)(SH + D);
    LAS float* SSP = (LAS float*)(ACCP + 2 * 8 * 64);
    LAS float* CE = SSP + 2 * 8 * 16;
    const int lane = X.lane, w = X.wave, r = lane & 15, kq = lane >> 4;
    constexpr int NG = T / 16, GPW = NG / 256;
    const int g0 = X.vcu * GPW, b = (g0 * 16) >> 12;
    const float* md = p.MOD + (size_t)b * NMOD * D;
    f32x4 a[4][2], vn[4][2];
    const int cbase = 128 * w + 8 * kq;
#if H_DELTA
#define RT_ISSUE(dst, grp) do { const size_t ro_ = ((size_t)(grp) * 16 + r) * D + cbase; const float* rp = H + ro_; const bf16_t* dp = p.DELTA + ro_; _Pragma("unroll") for (int s = 0; s < 4; ++s) { \
        const u32x4 dw_ = *(const GAS u32x4*)(dp + 32 * s); f32x4 d0_, d1_; epi::unpack8(dw_, d0_, d1_); dst[s][0] = *(const GAS f32x4*)(rp + 32 * s) + d0_; dst[s][1] = *(const GAS f32x4*)(rp + 32 * s + 4) + d1_; } } while (0)
#else
#define RT_ISSUE(dst, grp) do { const float* rp = H + ((size_t)(grp) * 16 + r) * D + cbase; _Pragma("unroll") for (int s = 0; s < 4; ++s) { dst[s][0] = *(const GAS f32x4*)(rp + 32 * s); dst[s][1] = *(const GAS f32x4*)(rp + 32 * s + 4); } } while (0)
#endif
    RT_ISSUE(a, g0);
    for (int i = X.tid; i < D; i += NTHR) { GP[i] = p.norm2_g[i] * (1.f + md[4 * D + i]); SH[i] = md[3 * D + i]; }
    bf16x8 bh[4], bl[4];
#pragma unroll
    for (int s = 0; s < 4; ++s) { unsigned hw[4], lw[4];
#pragma unroll
        for (int j = 0; j < 4; ++j) { const int d = 32 * (4 * w + s) + 8 * kq + 2 * j; const float x0 = p.router_w[(size_t)d * E + r], x1 = p.router_w[(size_t)(d + 1) * E + r];
            const unsigned h = cvt_pk_bf16(x0, x1); hw[j] = h; lw[j] = cvt_pk_bf16(x0 - bf_lo(h), x1 - bf_hi(h)); }
        bh[s] = __builtin_bit_cast(bf16x8, (u32x4){hw[0], hw[1], hw[2], hw[3]}); bl[s] = __builtin_bit_cast(bf16x8, (u32x4){lw[0], lw[1], lw[2], lw[3]}); }
    __syncthreads();
    if (w == 0) {
        float c[E];
#pragma unroll
        for (int e = 0; e < E; ++e) c[e] = 0.f;
        for (int d = lane; d < D; d += 64) { const float sv = SH[d]; const f32x4* wr_ = (const f32x4*)(p.router_w + (size_t)d * E);
#pragma unroll
            for (int q = 0; q < 4; ++q) { const f32x4 wv = wr_[q]; c[4 * q] += sv * wv[0]; c[4 * q + 1] += sv * wv[1]; c[4 * q + 2] += sv * wv[2]; c[4 * q + 3] += sv * wv[3]; } }
#pragma unroll
        for (int e = 0; e < E; ++e) { const float s = wave_sum(c[e]); if (lane == e) CE[e] = s; }
    }
    __syncthreads();
    for (int gi = 0; gi < GPW; ++gi) {
        const int g = g0 + gi, par = gi & 1;
        if (gi + 1 < GPW) RT_ISSUE(vn, g + 1);
        float ss = 0.f; f32x4 acc = (f32x4){0.f, 0.f, 0.f, 0.f};
#pragma unroll
        for (int s = 0; s < 4; ++s) {
            const f32x4 g0v = *(const LAS f32x4*)(GP + cbase + 32 * s), g1v = *(const LAS f32x4*)(GP + cbase + 32 * s + 4);
            const f32x4 v0 = a[s][0], v1 = a[s][1];
            ss += (v0[0] * v0[0] + v0[1] * v0[1]) + (v0[2] * v0[2] + v0[3] * v0[3]) + (v1[0] * v1[0] + v1[1] * v1[1]) + (v1[2] * v1[2] + v1[3] * v1[3]);
            const f32x4 x0 = v0 * g0v, x1 = v1 * g1v; a[s][0] = x0; a[s][1] = x1;
            unsigned hw[4], lw[4];
            hw[0] = cvt_pk_bf16(x0[0], x0[1]); hw[1] = cvt_pk_bf16(x0[2], x0[3]); hw[2] = cvt_pk_bf16(x1[0], x1[1]); hw[3] = cvt_pk_bf16(x1[2], x1[3]);
            lw[0] = cvt_pk_bf16(x0[0] - bf_lo(hw[0]), x0[1] - bf_hi(hw[0])); lw[1] = cvt_pk_bf16(x0[2] - bf_lo(hw[1]), x0[3] - bf_hi(hw[1]));
            lw[2] = cvt_pk_bf16(x1[0] - bf_lo(hw[2]), x1[1] - bf_hi(hw[2])); lw[3] = cvt_pk_bf16(x1[2] - bf_lo(hw[3]), x1[3] - bf_hi(hw[3]));
            const bf16x8 ah = __builtin_bit_cast(bf16x8, (u32x4){hw[0], hw[1], hw[2], hw[3]}), al = __builtin_bit_cast(bf16x8, (u32x4){lw[0], lw[1], lw[2], lw[3]});
            acc = __builtin_amdgcn_mfma_f32_16x16x32_bf16(ah, bh[s], acc, 0, 0, 0);
            acc = __builtin_amdgcn_mfma_f32_16x16x32_bf16(ah, bl[s], acc, 0, 0, 0);
            acc = __builtin_amdgcn_mfma_f32_16x16x32_bf16(al, bh[s], acc, 0, 0, 0);
        }
        ss += __shfl_xor(ss, 16); ss += __shfl_xor(ss, 32);
        ACCP[(par * 8 + w) * 64 + lane] = acc;
        if (lane < 16) SSP[(par * 8 + w) * 16 + lane] = ss;
        __syncthreads();
        float rss = 0.f;
#pragma unroll
        for (int q = 0; q < 8; ++q) rss += SSP[(par * 8 + q) * 16 + r];
        const float rstd = 1.f / sqrtf(rss * (1.f / D) + 1e-6f);
        if (w == (gi & 7)) {
            f32x4 lg = (f32x4){0.f, 0.f, 0.f, 0.f};
#pragma unroll
            for (int q = 0; q < 8; ++q) lg += ACCP[(par * 8 + q) * 64 + lane];
            const float ce = CE[r]; f32x4 o;
#pragma unroll
            for (int q = 0; q < 4; ++q) { const float rs = __shfl(rstd, 4 * kq + q); float z = lg[q] * rs + ce; float mx = z;
#pragma unroll
                for (int sft = 1; sft < 16; sft <<= 1) mx = fmaxf(mx, __shfl_xor(mx, sft));
                const float ex = expf(z - mx); float sm = ex;
#pragma unroll
                for (int sft = 1; sft < 16; sft <<= 1) sm += __shfl_xor(sm, sft);
                o[q] = ex / sm; }
            *(GAS f32x4*)(p.AFF + ((size_t)b * E + r) * S + ((g * 16) & (S - 1)) + 4 * kq) = o;
        }
#pragma unroll
        for (int s = 0; s < 4; ++s) {
            const f32x4 s0 = *(const LAS f32x4*)(SH + cbase + 32 * s), s1 = *(const LAS f32x4*)(SH + cbase + 32 * s + 4);
            const f32x4 u0 = a[s][0] * rstd + s0, u1 = a[s][1] * rstd + s1; const size_t off = ((size_t)g * 16 + r) * D + cbase + 32 * s;
            if (MOE_F8) *(GAS u32x2*)((unsigned char*)p.U + off) = pack8_f8(u0, u1, epi::U_SC);
            else *(GAS u32x4*)(p.U + off) = epi::pack8(u0, u1);
        }
#pragma unroll
        for (int s = 0; s < 4; ++s) { a[s][0] = vn[s][0]; a[s][1] = vn[s][1]; }
    }
#undef RT_ISSUE
    __syncthreads();
}

__device__ __forceinline__ void phase_topk(const Ctx& X0, const P& p) {
    Ctx X = X0; X.tid = (int)threadIdx.x; asm volatile("" : "+v"(X.tid)); X.lane = X.tid & 63;
    LAS unsigned* cnt = (LAS unsigned*)X.lds;
    LAS unsigned* sc = cnt + 48;
    const int lane = X.lane, w = X.wave, tid = X.tid;
    for (int be = X.vcu; be < Bn * E; be += X.G) {
        const int b = be / E, e = be % E;
        const float* src = p.AFF + (size_t)be * S + 8 * tid;
        const f32x4 a0 = *(const GAS f32x4*)src, a1 = *(const GAS f32x4*)(src + 4);
        unsigned key[8];
#pragma unroll
        for (int i = 0; i < 4; ++i) { const float f0 = a0[i], f1 = a1[i]; key[i] = __float_as_uint(f0); key[4 + i] = __float_as_uint(f1); }
        unsigned prefix = 0u, need_k = (unsigned)CAP;
        __syncthreads();
        if (tid < 48) cnt[tid] = 0u;
        __syncthreads();
#pragma unroll 1
        for (int pass = 0; pass < 8; ++pass) {
            const int shift = 28 - 4 * pass; LAS unsigned* hist = cnt + (pass % 3) * 16;
            if (tid < 16) cnt[((pass + 1) % 3) * 16 + tid] = 0u;
#pragma unroll
            for (int i = 0; i < 8; ++i) { const bool match = (pass == 0) || ((key[i] >> (shift + 4)) == (prefix >> (shift + 4)));
                if (match) __hip_atomic_fetch_add(hist + ((key[i] >> shift) & 15u), 1u, __ATOMIC_RELAXED, __HIP_MEMORY_SCOPE_WORKGROUP); }
            __syncthreads();
            unsigned cum = 0u, dsel = 0u, below = 0u; bool found = false;
#pragma unroll
            for (int dgt = 15; dgt >= 0; --dgt) { const unsigned c = hist[dgt]; if (!found) { if (cum + c >= need_k) { dsel = (unsigned)dgt; below = cum; found = true; } else cum += c; } }
            prefix |= dsel << shift; need_k -= below;
        }
        const unsigned Tk = prefix;
        unsigned ngt = 0u, neq = 0u;
#pragma unroll
        for (int i = 0; i < 8; ++i) { ngt += key[i] > Tk; neq += key[i] == Tk; }
        unsigned sg = ngt, se = neq;
#pragma unroll
        for (int o = 1; o < 64; o <<= 1) { const unsigned tg = __shfl_up(sg, o), te = __shfl_up(se, o); if (lane >= o) { sg += tg; se += te; } }
        __syncthreads();
        if (lane == 63) { sc[w] = sg; sc[8 + w] = se; }
        __syncthreads();
        unsigned og = 0u, oe = 0u, totg = 0u;
#pragma unroll
        for (int i = 0; i < 8; ++i) { const unsigned g = sc[i], q = sc[8 + i]; if (i < w) { og += g; oe += q; } totg += g; }
        unsigned pg = og + sg - ngt, pe = oe + se - neq;
        const unsigned need = (unsigned)CAP - totg;
        unsigned iv[4] = {0u, 0u, 0u, 0u};
#pragma unroll
        for (int i = 0; i < 8; ++i) {
            const bool gt = key[i] > Tk, eq = key[i] == Tk; const int s = 8 * tid + i;
            const bool sel = gt || (eq && pe < need);
            const unsigned slot = pg + (pe < need ? pe : need);
            if (sel) { p.ROWL[(size_t)e * ME + b * CAP + slot] = b * S + s; p.WTS[(size_t)e * ME + b * CAP + slot] = __uint_as_float(key[i]); }
            iv[i >> 1] |= (sel ? (slot & 0xffffu) : 0xffffu) << (16 * (i & 1));
            pg += gt; pe += eq;
        }
        *(GAS u32x4*)(p.INV + (size_t)be * S + 8 * tid) = (u32x4){iv[0], iv[1], iv[2], iv[3]};
    }
    __syncthreads();
}

__device__ __forceinline__ void phase_final(const Ctx& X0, const P& p) {
    Ctx X = X0; X.tid = (int)threadIdx.x; asm volatile("" : "+v"(X.tid)); X.lane = X.tid & 63;
    const int gw = X.vcu * NWAVES + X.wave, NGW = X.G * NWAVES, lane = X.lane;
    for (int m = gw; m < T; m += NGW) {
        const int b = m >> 12; float* hr = p.out + (size_t)m * D;
        f32x4 v[4];
#if H_DELTA
#pragma unroll
        for (int j = 0; j < 4; ++j) { const u32x2 dw = *(const GAS u32x2*)(p.DELTA + (size_t)m * D + 4 * lane + 256 * j);
            v[j] = *(const GAS f32x4*)(p.x + (size_t)m * D + 4 * lane + 256 * j) + (f32x4){bf_lo(dw.x), bf_hi(dw.x), bf_lo(dw.y), bf_hi(dw.y)}; }
#else
#pragma unroll
        for (int j = 0; j < 4; ++j) v[j] = *(const GAS f32x4*)(hr + 4 * lane + 256 * j);
#endif
        const int myslot = (lane < E) ? (int)p.INV[((size_t)(b * E + lane)) * S + (m & (S - 1))] : -1;
        f32x4 y[4];
#pragma unroll
        for (int q = 0; q < 4; ++q) y[q] = (f32x4){0.f, 0.f, 0.f, 0.f};
#pragma unroll
        for (int e = 0; e < E; ++e) { const int slot = __builtin_amdgcn_readlane(myslot, e);
            if (slot >= 0) { const size_t yo = ((size_t)e * ME + b * CAP + slot) * D;
#pragma unroll
                for (int j = 0; j < 4; ++j) {
                    if (YB_F8) { const unsigned wv = *(const GAS unsigned*)((const unsigned char*)p.YB + yo + 4 * lane + 256 * j);
                        const f32x2 lo2 = __builtin_amdgcn_cvt_pk_f32_fp8((int)wv, false), hi2 = __builtin_amdgcn_cvt_pk_f32_fp8((int)wv, true); y[j] += (f32x4){lo2[0], lo2[1], hi2[0], hi2[1]}; }
                    else { const u32x2 wv = *(const GAS u32x2*)(p.YB + yo + 4 * lane + 256 * j); y[j] += (f32x4){bf_lo(wv.x), bf_hi(wv.x), bf_lo(wv.y), bf_hi(wv.y)}; } } } }
        const float* g2 = p.MOD + (size_t)b * NMOD * D + 5 * D; float ss = 0.f;
#pragma unroll
        for (int j = 0; j < 4; ++j) { const f32x4 g = *(const f32x4*)(g2 + 4 * lane + 256 * j) * (YB_F8 ? 1.f / epi::YB_SC : 1.f); const f32x4 tt = v[j] + g * y[j]; v[j] = tt;
            ss += (tt[0] * tt[0] + tt[1] * tt[1]) + (tt[2] * tt[2] + tt[3] * tt[3]); }
        const float rstd = 1.f / sqrtf(wave_sum(ss) * (1.f / D) + 1e-6f);
#pragma unroll
        for (int j = 0; j < 4; ++j) { const f32x4 fg = *(const f32x4*)(p.final_g + 4 * lane + 256 * j); *(GAS f32x4*)(hr + 4 * lane + 256 * j) = v[j] * rstd * fg; }
    }
}

constexpr size_t MiB = 1u << 20;
constexpr size_t WS_CTL = 0, CTL_ZERO_BYTES = 1 * MiB;
constexpr size_t WS_MOD = 1 * MiB, WS_AFF = 2 * MiB, WS_ROWL = 4 * MiB, WS_WTS = WS_ROWL + 256 * 1024, WS_INV = WS_WTS + 256 * 1024;
constexpr size_t WS_W2F = 6 * MiB, WS_WIN = 10 * MiB, WS_WCONV = 18 * MiB, WS_WFOUR = 19 * MiB, WS_WOUT = 21 * MiB;
constexpr size_t WS_WGU = 24 * MiB, WS_WDOWN = 152 * MiB, WS_U = 216 * MiB, WS_R1 = 280 * MiB, WS_END = 536 * MiB;
constexpr size_t WS_GP = WS_R1, WS_D256 = 23 * MiB, WS_YCONV = WS_R1, WS_V = WS_R1 + 64 * MiB, WS_FT = WS_R1 + 96 * MiB, WS_YFOUR = WS_R1 + 64 * MiB;
constexpr size_t WS_YRI = WS_R1 + 128 * MiB, WS_MERGED = WS_R1 + 128 * MiB, WS_ACONV = WS_R1 + 192 * MiB, WS_ACT = WS_R1 + 128 * MiB  , WS_YB = WS_WGU, WS_DELTA = WS_R1  ;
static_assert(MOE_F8 || !H_DELTA, "the workspace map places the 128 MiB fp8 ACT beside DELTA; a bf16 ACT (256 MiB) needs H_DELTA = 0");
constexpr int LDS_BYTES = 147456, RING_BYTES = 131072, MISC_OFF = RING_BYTES + 320;


#ifndef BARRIER_KIND
#define BARRIER_KIND 2
#endif
#define RLX_AGENT __ATOMIC_RELAXED, __HIP_MEMORY_SCOPE_AGENT
#define XB_TMO      128
#define XB_XCNT(j)  (256  + 64 * (j))
#define XB_XSUB(j)  (1280 + 64 * (j))
#define XB_XGEN(j)  (2304 + 64 * (j))
#define XB_TOP      3328
#define XB_TOPGEN   3392
#define XCD_BAR_WORDS 3456
#define XB_SPIN_CAP (1u << 18)
__device__ __forceinline__ unsigned xb_ld(unsigned* p)              { return __hip_atomic_load(p, __ATOMIC_RELAXED, __HIP_MEMORY_SCOPE_AGENT); }
__device__ __forceinline__ unsigned xb_add(unsigned* p, unsigned v) { return __hip_atomic_fetch_add(p, v, __ATOMIC_RELAXED, __HIP_MEMORY_SCOPE_AGENT); }
__device__ __forceinline__ unsigned xb_xcc_id() { return (unsigned)__builtin_amdgcn_s_getreg((3 << 11) | 20) & 0xFu; }
#define XB_SPIN(cond, bar) do { unsigned _sp = 0; while (cond) { __builtin_amdgcn_s_sleep(1); \
    if ((++_sp & 255u) == 0u) { if (xb_ld(&(bar)[XB_TMO])) break; if (_sp > XB_SPIN_CAP) { atomicAdd(&(bar)[XB_TMO], 1u); break; } } } } while (0)
struct XcdBarrier { unsigned* bar; unsigned x; volatile LAS unsigned* st; };
__device__ __forceinline__ XcdBarrier xcd_barrier_post(unsigned* bar, volatile LAS unsigned* st) {
    XcdBarrier b; b.bar = bar; b.x = xb_xcc_id(); b.st = st;
    if (threadIdx.x == 0) (void)xb_add(&bar[XB_XCNT(b.x)], 1u);
    return b;
}
__device__ __forceinline__ void xcd_barrier_complete(unsigned* bar, unsigned x, unsigned& nloc, unsigned& nx) {
    const unsigned G = gridDim.x * gridDim.y * gridDim.z;
    unsigned sum, cnt, mine, sp = 0u;
    for (;;) {
        sum = 0u; cnt = 0u; mine = 0u;
#pragma unroll
        for (unsigned j = 0; j < 16; ++j) { const unsigned c = xb_ld(&bar[XB_XCNT(j)]); sum += c; cnt += (c > 0u) ? 1u : 0u; mine = (j == x) ? c : mine; }
        if (sum == G) break;
        __builtin_amdgcn_s_sleep(1);
        if ((++sp & 255u) == 0u) { if (xb_ld(&bar[XB_TMO])) break; if (sp > XB_SPIN_CAP) { atomicAdd(&bar[XB_TMO], 1u); break; } }
    }
    nloc = mine > 0u ? mine : 1u; nx = cnt > 0u ? cnt : 1u;
}
__device__ __forceinline__ void xcd_barrier(const XcdBarrier& b) {
    asm volatile("s_waitcnt vmcnt(0)" ::: "memory");
    __syncthreads();
    if (threadIdx.x == 0) {
        unsigned* bar = b.bar;
        __builtin_amdgcn_s_waitcnt(0);
        unsigned nloc = b.st[0], nx = b.st[1];
        if (nloc == 0u) { xcd_barrier_complete(bar, b.x, nloc, nx); b.st[0] = nloc; b.st[1] = nx; }
        const unsigned old = xb_add(&bar[XB_XSUB(b.x)], 1u);
        const unsigned gen = old / nloc;
        if (old + 1u == (gen + 1u) * nloc) {
            __builtin_amdgcn_fence(__ATOMIC_RELEASE, "agent");
            asm volatile("s_waitcnt vmcnt(0)" ::: "memory");
            const unsigned og = xb_add(&bar[XB_TOP], 1u);
            const unsigned tg = og / nx;
            if (og + 1u == (tg + 1u) * nx) xb_add(&bar[XB_TOPGEN], 1u);
            else XB_SPIN(xb_ld(&bar[XB_TOPGEN]) == tg, bar);
            __builtin_amdgcn_fence(__ATOMIC_ACQUIRE, "agent");
            xb_add(&bar[XB_XGEN(b.x)], 1u);
            asm volatile("s_waitcnt vmcnt(0)" ::: "memory");
        } else {
            XB_SPIN(xb_ld(&bar[XB_XGEN(b.x)]) == gen, bar);
            __builtin_amdgcn_fence(__ATOMIC_ACQUIRE, "agent");
            asm volatile("s_waitcnt vmcnt(0)" ::: "memory");
        }
    }
    __syncthreads();
}
constexpr int CW_BAR = 4096;

struct Args { P p; unsigned* ctl; int ph_lo, ph_hi; };

__global__ void __launch_bounds__(NTHR, 2) mk_fwd(Args args) {
    extern __shared__ __attribute__((aligned(16))) unsigned char lds_raw[];
    Ctx X; X.lds = (LAS unsigned char*)lds_raw; X.tid = threadIdx.x; X.lane = X.tid & 63; X.wave = __builtin_amdgcn_readfirstlane(X.tid >> 6);
    X.G = gridDim.x; { const int bx = blockIdx.x; X.vcu = (X.G % 8 == 0) ? (bx % 8) * (X.G / 8) + bx / 8 : bx; }
    const P& p = args.p; const int lo = args.ph_lo, hi = args.ph_hi;
    const int cid = (int)blockIdx.x;
#define IN(k) (lo <= (k) && (k) < hi)
    for (int u = X.tid; u < (LDS_BYTES - RING_BYTES) / 4; u += NTHR) ((LAS unsigned*)(X.lds + RING_BYTES))[u] = 0u;
    __syncthreads();
#if BARRIER_KIND == 1
    cooperative_groups::grid_group cgrid = cooperative_groups::this_grid();
#define GRID_BAR() do { if (hi - lo > 1) cgrid.sync(); } while (0)
#else
    XcdBarrier xbar = xcd_barrier_post(args.ctl + CW_BAR, (volatile LAS unsigned*)(X.lds + MISC_OFF));
#define GRID_BAR() do { if (hi - lo > 1) xcd_barrier(xbar); } while (0)
#endif
#ifdef PROBE_A
    volatile unsigned long long* ts = (volatile unsigned long long*)(args.ctl + 65536);
    int n_stamp = 0;
#define STAMP() do { if (blockIdx.x == 0 && X.tid == 0) ts[n_stamp] = __builtin_amdgcn_s_memrealtime(); ++n_stamp; } while (0)
#else
#define STAMP() do { } while (0)
#endif
    STAMP();
    if (IN(0)) { phase_p0a(X, p); GRID_BAR(); STAMP(); }
    if (IN(1)) { phase_p0b(X, p); GRID_BAR(); STAMP(); }
    if (IN(2)) {
        { pg8::SchedDense Sd; Sd.init(p.U, p.Wt_in, T, 2 * CW, D, X.G, cid); epi::EpiGlu Ep{p.V, p.b_in};
          pg8::gemm_phase<epi::EpiGlu, pg8::SchedDense, false>(X.lds, 2 * D, Sd, Ep); }
        { pg8::SchedDense Sd; Sd.init(p.Wt_in + (size_t)(2 * CW) * D, p.U, FW, T, D, X.G, cid); epi::EpiFT Ep{p.FT, p.b_in + 2 * CW};
          pg8::gemm_phase<epi::EpiFT, pg8::SchedDense, false>(X.lds, 2 * D, Sd, Ep); }
        GRID_BAR(); STAMP();
    }
    if (IN(3)) {
        phase_conv(X, p);
        phase_fftA(X, p);
        GRID_BAR(); STAMP();
        { pg8::SchedDense Sd; Sd.init(p.D256, p.GP, 512, Bn * 16 * FW, 512, X.G, cid); epi::EpiFFT Ep{p.YRI};
          pg8::gemm_phase<epi::EpiFFT, pg8::SchedDense, false>(X.lds, 2 * 512, Sd, Ep); }
        GRID_BAR(); STAMP();
    }
    if (IN(4)) {
        { pg8::SchedDense Sd; Sd.init(p.ACONV, p.Wt_conv, T, D, CW, X.G, cid); epi::EpiBias Ep{p.YCONV, D, p.cb_out};
          pg8::gemm_phase<epi::EpiBias, pg8::SchedDense, false>(X.lds, 2 * CW, Sd, Ep); }
        { pg8::SchedDense Sd; Sd.init(p.YRI, p.Wt_four, T, D, 2 * FW, X.G, cid); epi::EpiBias Ep{p.YFOUR, D, p.four_b};
          pg8::gemm_phase<epi::EpiBias, pg8::SchedDense, false>(X.lds, 4 * FW, Sd, Ep); }
        GRID_BAR(); STAMP();
    }
    if (IN(5)) {
        pg8::SchedDense Sd; Sd.init(p.U, p.Wt_in + (size_t)(2 * CW + FW) * D, T, 2 * D, D, X.G, cid); epi::EpiMerge Ep{p.MERGED, p.YCONV, p.YFOUR, p.b_in};
        pg8::gemm_phase<epi::EpiMerge, pg8::SchedDense, false>(X.lds, 2 * D, Sd, Ep);
        GRID_BAR(); STAMP();
    }
    if (IN(6)) {
        pg8::SchedDense Sd; Sd.init(p.MERGED, p.Wt_out, T, D, D, X.G, cid);
#if H_DELTA
        epi::EpiDelta Ep{p.DELTA, p.MOD + 2 * D, p.b_out};
        pg8::gemm_phase<epi::EpiDelta, pg8::SchedDense, false>(X.lds, 2 * D, Sd, Ep);
#else
        epi::EpiResid Ep{p.x, p.out, p.MOD + 2 * D, p.b_out};
        pg8::gemm_phase<epi::EpiResid, pg8::SchedDense, false>(X.lds, 2 * D, Sd, Ep);
#endif
        GRID_BAR(); STAMP();
    }
    if (IN(7)) { phase_router(X, p, H_DELTA ? p.x : p.out); GRID_BAR(); STAMP(); }
    if (IN(8)) { phase_topk(X, p); GRID_BAR(); STAMP(); }
    if (IN(9)) {
        constexpr int esz = MOE_F8 ? 1 : 2;
        pg8::SchedG1 Sd{(const char*)p.U, (const char*)p.Wt_gu, p.ROWL, X.G, cid, esz}; epi::EpiSwiglu<MOE_F8 != 0> Ep{p.ACT};
        pg8::gemm_phase<epi::EpiSwiglu<MOE_F8 != 0>, pg8::SchedG1, true, MOE_F8 != 0>(X.lds, D * esz, Sd, Ep, epi::MX_W, epi::MX_U);
        GRID_BAR(); STAMP();
    }
    if (IN(10)) {
        constexpr int esz = MOE_F8 ? 1 : 2;
        pg8::SchedG2 Sd{(const char*)p.ACT, (const char*)p.Wt_down, X.G, cid, esz}; epi::EpiScaleW Ep{p.YB, p.WTS};
        pg8::gemm_phase<epi::EpiScaleW, pg8::SchedG2, false, MOE_F8 != 0>(X.lds, F * esz, Sd, Ep, epi::MX_W, epi::MX_ACT);
        GRID_BAR(); STAMP();
    }
    if (IN(11)) { phase_final(X, p); }
#ifdef PROBE_A
    STAMP();
    if (blockIdx.x == 0 && X.tid == 0) { const unsigned long long dt = (ts[PROBE_B] - ts[PROBE_A]) * PROBE_AMP, t0 = __builtin_amdgcn_s_memrealtime();
        while (__builtin_amdgcn_s_memrealtime() - t0 < dt) __builtin_amdgcn_s_sleep(8); }
#endif
#undef IN
}

extern "C" void kernel_launch(void* const* d_in, const int* in_sizes, int n_in, void* d_out, int out_size, void* d_ws, size_t ws_size, hipStream_t stream) {
    static int grid = 0;
    if (grid == 0) {
        if (n_in != 23 || in_sizes[0] != T * D || out_size != T * D || ws_size < WS_END) { fprintf(stderr, "kernel_launch: unexpected shapes / workspace (%d inputs, ws %zu)\n", n_in, ws_size); grid = -1; return; }
        int dev = 0, cus = 0;
        if (hipGetDevice(&dev) != hipSuccess || hipDeviceGetAttribute(&cus, hipDeviceAttributeMultiprocessorCount, dev) != hipSuccess) { grid = -1; return; }
        if (hipFuncSetAttribute((const void*)mk_fwd, hipFuncAttributeMaxDynamicSharedMemorySize, LDS_BYTES) != hipSuccess) { fprintf(stderr, "kernel_launch: hipFuncSetAttribute failed\n"); grid = -1; return; }
        if (cus < 256) { fprintf(stderr, "kernel_launch: built for a 256-CU device (one workgroup per CU), found %d CUs\n", cus); grid = -1; return; }
        int per_cu = 0;
        if (hipOccupancyMaxActiveBlocksPerMultiprocessor(&per_cu, (const void*)mk_fwd, NTHR, LDS_BYTES) != hipSuccess || per_cu < 1) { fprintf(stderr, "kernel_launch: occupancy query reports %d workgroups per CU\n", per_cu); grid = -1; return; }
        grid = 256;
    }
    if (grid < 0) return;
    unsigned char* ws = (unsigned char*)d_ws;
    Args a{};
    P& p = a.p;
    p.x = (const float*)d_in[0]; p.c = (const float*)d_in[1]; p.ada_w = (const float*)d_in[2]; p.ada_b = (const float*)d_in[3]; p.norm1_g = (const float*)d_in[4];
    p.w_in = (const float*)d_in[5]; p.b_in = (const float*)d_in[6]; p.dw_w = (const float*)d_in[7]; p.dw_b = (const float*)d_in[8]; p.cln_g = (const float*)d_in[9]; p.cln_b = (const float*)d_in[10];
    p.cw_out = (const float*)d_in[11]; p.cb_out = (const float*)d_in[12]; p.four_w = (const float*)d_in[13]; p.four_b = (const float*)d_in[14]; p.w_out = (const float*)d_in[15]; p.b_out = (const float*)d_in[16];
    p.norm2_g = (const float*)d_in[17]; p.router_w = (const float*)d_in[18]; p.w_gate = (const float*)d_in[19]; p.w_up = (const float*)d_in[20]; p.w_down = (const float*)d_in[21]; p.final_g = (const float*)d_in[22];
    p.out = (float*)d_out;
    p.MOD = (float*)(ws + WS_MOD); p.W2F = (float*)(ws + WS_W2F); p.AFF = (float*)(ws + WS_AFF); p.ROWL = (int*)(ws + WS_ROWL); p.WTS = (float*)(ws + WS_WTS); p.INV = (short*)(ws + WS_INV);
    p.Wt_in = (bf16_t*)(ws + WS_WIN); p.Wt_conv = (bf16_t*)(ws + WS_WCONV); p.Wt_four = (bf16_t*)(ws + WS_WFOUR); p.Wt_out = (bf16_t*)(ws + WS_WOUT);
    p.D256 = (bf16_t*)(ws + WS_D256); p.GP = (bf16_t*)(ws + WS_GP); p.Wt_gu = (bf16_t*)(ws + WS_WGU); p.Wt_down = (bf16_t*)(ws + WS_WDOWN);
    p.U = (bf16_t*)(ws + WS_U); p.V = (bf16_t*)(ws + WS_V); p.FT = (bf16_t*)(ws + WS_FT); p.ACONV = (bf16_t*)(ws + WS_ACONV); p.YRI = (bf16_t*)(ws + WS_YRI);
    p.YCONV = (bf16_t*)(ws + WS_YCONV); p.YFOUR = (bf16_t*)(ws + WS_YFOUR); p.MERGED = (bf16_t*)(ws + WS_MERGED); p.ACT = (bf16_t*)(ws + WS_ACT); p.YB = (bf16_t*)(ws + WS_YB); p.DELTA = (bf16_t*)(ws + WS_DELTA);
    (void)hipMemsetAsync(ws + WS_CTL, 0, CTL_ZERO_BYTES, stream);
    a.ctl = (unsigned*)(ws + WS_CTL);
    a.ph_lo = 0; a.ph_hi = 12;
#ifndef PLAIN_LAUNCH
#define PLAIN_LAUNCH 0
#endif
#if PLAIN_LAUNCH
    hipLaunchKernelGGL(mk_fwd, dim3(grid), dim3(NTHR), LDS_BYTES, stream, a);
#else
    { void* kargs[] = {&a}; hipError_t le = hipLaunchCooperativeKernel((const void*)mk_fwd, dim3(grid), dim3(NTHR), kargs, LDS_BYTES, stream);
      if (le != hipSuccess) fprintf(stderr, "kernel_launch: cooperative launch failed: %s\n", hipGetErrorString(le)); }
#endif
}
```

```cpp
#include <hip/hip_runtime.h>
#include <hip/hip_cooperative_groups.h>
#include <cstdio>
#include <cstdint>

#define LAS __attribute__((address_space(3)))
#define GAS __attribute__((address_space(1)))
typedef unsigned short bf16_t;
typedef short bf16x8 __attribute__((ext_vector_type(8)));
typedef float f32x4 __attribute__((ext_vector_type(4)));
typedef float f32x2 __attribute__((ext_vector_type(2)));
typedef unsigned u32x4 __attribute__((ext_vector_type(4)));
typedef unsigned u32x2 __attribute__((ext_vector_type(2)));
typedef int i32x8 __attribute__((ext_vector_type(8)));

constexpr int Bn = 8, S = 4096, D = 1024, T = Bn * S;
constexpr int CW = 512, CK = 31, FW = 512, FG = 4, FGD = 128;
constexpr int INC = 2 * CW + FW + 2 * D;
constexpr int E = 16, CAP = 2 * S / E;
constexpr int F = 2 * D;
constexpr int NMOD = 6;
constexpr int ME = Bn * CAP;
constexpr int NWAVES = 8, NTHR = 512;

__device__ __forceinline__ float sigmoidf_(float x) { return __builtin_amdgcn_rcpf(1.f + __expf(-x)); }
__device__ __forceinline__ float siluf_(float x) { return x * __builtin_amdgcn_rcpf(1.f + __expf(-x)); }
__device__ __forceinline__ unsigned f2bf(float f) { unsigned u = __builtin_bit_cast(unsigned, f); return (u + 0x7fffu + ((u >> 16) & 1u)) >> 16; }
__device__ __forceinline__ unsigned pk2(float lo, float hi) { return f2bf(lo) | (f2bf(hi) << 16); }
__device__ __forceinline__ unsigned cvt_pk_bf16(float lo, float hi) { unsigned r; asm volatile("v_cvt_pk_bf16_f32 %0, %1, %2" : "=v"(r) : "v"(lo), "v"(hi)); return r; }
__device__ __forceinline__ float bf_lo(unsigned w) { return __builtin_bit_cast(float, w << 16); }
__device__ __forceinline__ float bf_hi(unsigned w) { return __builtin_bit_cast(float, w & 0xffff0000u); }
__device__ __forceinline__ float wave_sum(float v) {
#pragma unroll
    for (int o = 1; o < 64; o <<= 1) v += __shfl_xor(v, o);
    return v;
}
__device__ __forceinline__ u32x2 pack8_f8(const f32x4 v0, const f32x4 v1, const float sc) {
    unsigned a = 0u, b = 0u;
    a = __builtin_amdgcn_cvt_pk_fp8_f32(v0[0] * sc, v0[1] * sc, a, false); a = __builtin_amdgcn_cvt_pk_fp8_f32(v0[2] * sc, v0[3] * sc, a, true);
    b = __builtin_amdgcn_cvt_pk_fp8_f32(v1[0] * sc, v1[1] * sc, b, false); b = __builtin_amdgcn_cvt_pk_fp8_f32(v1[2] * sc, v1[3] * sc, b, true);
    return (u32x2){a, b};
}
#define LDS_WAIT() asm volatile("s_waitcnt lgkmcnt(0)" ::: "memory")
#define VM_WAIT() asm volatile("s_waitcnt vmcnt(0)" ::: "memory")

namespace pg8 {
constexpr int BM = 256, BK = 64, HALF = 128, HTB = HALF * BK * 2  , STAGE_BYTES = 8 * HTB, NXCD = 8, WGM = 8;
__host__ __device__ __forceinline__ int lds_byte(int r, int c) { const int st = (r >> 4) * 2 + (c >> 5), rr = r & 15, cc = c & 31, ob = rr * 64 + cc * 2; return st * 1024 + (ob ^ (((ob >> 9) & 1) << 5)); }
__host__ __device__ __forceinline__ void stage_rc(int b, int& R, int& C) { const int st = b / 1024, sb = b % 1024, swz = sb ^ (((sb >> 9) & 1) << 5); R = (st >> 1) * 16 + swz / 64; C = (st & 1) * 32 + (swz % 64) / 2; }
__host__ __device__ __forceinline__ int f8_off(int r, int fq) { const int rr = r & 15; return ((r >> 4) * 2 + (fq >> 1)) * 1024 + ((rr * 64 + 32 * (fq & 1)) ^ ((rr >> 3) << 5)); }
__host__ __device__ __forceinline__ int perm32(int rho) { const int n = rho >> 4, i = rho & 15; return 8 * (i >> 2) + 4 * n + (i & 3); }

struct Unit { const char* a; const char* b; const int* rows; int pm, pn, e; };

template <class Epi, class Sched, bool GATHER, bool F8 = false>
__device__ __forceinline__ void gemm_phase(LAS unsigned char* lds, const int KB, const Sched& S, const Epi& E, const int sw = 0x7f7f7f7f, const int sx = 0x7f7f7f7f) {
    int tid_ = threadIdx.x; asm volatile("" : "+v"(tid_));
    const int tid = tid_, wid = __builtin_amdgcn_readfirstlane(tid >> 6), lane = tid & 63, wr = wid >> 2, wc = wid & 3, fr = lane & 15, fq = lane >> 4;
    const int nt = KB / (BK * 2);
    int swv = sw, sxv = sx; if constexpr (F8) { asm volatile("" : "+v"(swv), "+v"(sxv)); }
    unsigned voffA[2], voffB[2]; int R0, C0;
#pragma unroll
    for (int i = 0; i < 2; ++i) { int R, C; stage_rc(tid * 16 + i * 8192, R, C); const int Rb = Epi::PERM ? ((R & ~31) + perm32(R & 31)) : R;
        voffA[i] = (unsigned)(R * KB + C * 2); voffB[i] = (unsigned)(Rb * KB + C * 2); if (i == 0) { R0 = R; C0 = C; } }
    const size_t kstep = (size_t)(BK * 2);
    const size_t hstep = (size_t)HALF * KB;
    const unsigned ldsw = (unsigned)wid * 1024u;
    const int aoff = lds_byte(wr * 64 + fr, fq * 8), boff = lds_byte(wc * 32 + fr, fq * 8);
#define PG8_SA(b, h) (((b) * 2 + (h)) * HTB)
#define PG8_SB(b, h) ((4 + (b) * 2 + (h)) * HTB)
#define PG8_STAGE(bufoff, gbase, voff) do { _Pragma("unroll") for (int _i = 0; _i < 2; ++_i) \
        __builtin_amdgcn_global_load_lds((const unsigned*)((const char*)(gbase) + (voff)[_i]), (LAS unsigned*)(lds + (bufoff) + ldsw + _i * 8192), 16, 0, 0); } while (0)
#define PG8_STGA(bufoff, p, h, v) do { if constexpr (GATHER) { PG8_STAGE(bufoff, p, (v) + 2 * (h)); } else { PG8_STAGE(bufoff, (p) + (h) * hstep, voffA); } } while (0)
#define PG8_LD8(p) __builtin_bit_cast(i32x8, __builtin_shufflevector(*(const LAS u32x4*)(p), *(const LAS u32x4*)((p) + 1024), 0, 1, 2, 3, 4, 5, 6, 7))
#define PG8_LDA(dst, b, h) do { if constexpr (F8) { _Pragma("unroll") for (int m = 0; m < 4; ++m) dst##8[m] = PG8_LD8(lds + PG8_SA(b, h) + aoff + m * 2048); } \
      else { _Pragma("unroll") for (int m = 0; m < 4; ++m) _Pragma("unroll") for (int k = 0; k < 2; ++k) dst[m][k] = *(const LAS bf16x8*)(lds + PG8_SA(b, h) + aoff + m * 2048 + k * 1024); } } while (0)
#define PG8_LDB(dst, b, h) do { if constexpr (F8) { _Pragma("unroll") for (int n = 0; n < 2; ++n) dst##8[n] = PG8_LD8(lds + PG8_SB(b, h) + boff + n * 2048); } \
      else { _Pragma("unroll") for (int n = 0; n < 2; ++n) _Pragma("unroll") for (int k = 0; k < 2; ++k) dst[n][k] = *(const LAS bf16x8*)(lds + PG8_SB(b, h) + boff + n * 2048 + k * 1024); } } while (0)
#define PG8_MMA(ai, bj, At, Bt) do { __builtin_amdgcn_s_setprio(1); if constexpr (F8) { _Pragma("unroll") for (int m = 0; m < 4; ++m) _Pragma("unroll") for (int n = 0; n < 2; ++n) \
        asm volatile("v_mfma_scale_f32_16x16x128_f8f6f4 %0, %1, %2, %0, %3, %4 op_sel_hi:[0,0,0]" : "+v"(acc[ai][bj][m][n]) : "v"(Bt##8[n]), "v"(At##8[m]), "v"(swv), "v"(sxv)); } \
      else { _Pragma("unroll") for (int m = 0; m < 4; ++m) _Pragma("unroll") for (int n = 0; n < 2; ++n) _Pragma("unroll") for (int k = 0; k < 2; ++k) \
        acc[ai][bj][m][n] = __builtin_amdgcn_mfma_f32_16x16x32_bf16(Bt[n][k], At[m][k], acc[ai][bj][m][n], 0, 0, 0); } __builtin_amdgcn_s_setprio(0); } while (0)
#define PG8_WAIT_V(n) asm volatile("s_waitcnt vmcnt(" #n ")" ::: "memory")
#define PG8_WAIT_L(n) asm volatile("s_waitcnt lgkmcnt(" #n ")" ::: "memory")
#define PG8_BAR __builtin_amdgcn_s_barrier()
#define PG8_SCHED __builtin_amdgcn_sched_barrier(0)
#define PG8_ROWS(u, v) do { if constexpr (GATHER) { _Pragma("unroll") for (int _h = 0; _h < 2; ++_h) _Pragma("unroll") for (int _i = 0; _i < 2; ++_i) \
        v[_h * 2 + _i] = (unsigned)((u).rows[_h * 128 + R0 + 64 * _i] * KB + C0 * 2); } } while (0)
    Unit cur, nxt; int ui = 0;
    if (!S.next(0, cur)) return;
    f32x4 acc[2][2][4][2];
#pragma unroll
    for (int a = 0; a < 2; ++a)
#pragma unroll
        for (int b = 0; b < 2; ++b)
#pragma unroll
            for (int m = 0; m < 4; ++m)
#pragma unroll
                for (int n = 0; n < 2; ++n) acc[a][b][m][n] = (f32x4){0.f, 0.f, 0.f, 0.f};
    bf16x8 At[4][2], B0[2][2], B1[2][2]; i32x8 At8[4], B08[2], B18[2];
    unsigned vAc[4] = {0u, 0u, 0u, 0u}, vAn[4] = {0u, 0u, 0u, 0u}, vW[4] = {0u, 0u, 0u, 0u};
    PG8_ROWS(cur, vAc);
    const char* cA = cur.a; const char* cB = cur.b;
    PG8_STAGE(PG8_SB(0, 0), cB, voffB); PG8_STAGE(PG8_SB(0, 1), cB + hstep, voffB); PG8_STGA(PG8_SA(0, 0), cA, 0, vAc); PG8_STGA(PG8_SA(0, 1), cA, 1, vAc);
    if (wr == 1) PG8_BAR;
    PG8_WAIT_V(2); PG8_BAR;
    PG8_STAGE(PG8_SB(1, 0), cB + kstep, voffB); PG8_STGA(PG8_SA(1, 0), cA + kstep, 0, vAc); PG8_STAGE(PG8_SB(1, 1), cB + hstep + kstep, voffB);
    PG8_WAIT_V(6); PG8_BAR;
    for (;;) {
        const bool has_next = S.next(ui + 1, nxt);
        if (has_next) { PG8_ROWS(nxt, vAn); } else {
#pragma unroll
            for (int j = 0; j < 4; ++j) vAn[j] = vAc[j]; }
        const char* nA = has_next ? nxt.a : cA; const char* nB = has_next ? nxt.b : cB;
        for (int t = 0; t < nt; t += 2) {
            const bool last = (t == nt - 2);
            const char* a1 = cA + (size_t)(t + 1) * kstep;
            const char* a2 = last ? nA : cA + (size_t)(t + 2) * kstep; const char* b2 = last ? nB : cB + (size_t)(t + 2) * kstep;
            const char* a3 = a2 + kstep; const char* b3 = b2 + kstep;
            if constexpr (GATHER) {
                if (last) { asm volatile("" ::: "memory");
#pragma unroll
                    for (int j = 0; j < 4; ++j) vW[j] = vAn[j]; }
                else {
#pragma unroll
                    for (int j = 0; j < 4; ++j) vW[j] = vAc[j]; } }
            PG8_LDB(B0, 0, 0); PG8_LDB(B1, 0, 1); PG8_SCHED; PG8_LDA(At, 0, 0); PG8_STGA(PG8_SA(1, 1), a1, 1, vAc);
            PG8_WAIT_V(8); PG8_WAIT_L(0); PG8_BAR; PG8_MMA(0, 0, At, B0); PG8_MMA(0, 1, At, B1); PG8_BAR; PG8_SCHED;
            PG8_LDA(At, 0, 1); PG8_STAGE(PG8_SB(0, 0), b2, voffB); PG8_STAGE(PG8_SB(0, 1), b2 + hstep, voffB); PG8_STGA(PG8_SA(0, 0), a2, 0, vW);
            PG8_WAIT_V(8); PG8_WAIT_L(0); PG8_BAR; PG8_MMA(1, 0, At, B0); PG8_MMA(1, 1, At, B1); PG8_BAR; PG8_SCHED;
            PG8_LDB(B0, 1, 0); PG8_LDB(B1, 1, 1); PG8_SCHED; PG8_LDA(At, 1, 0); PG8_STGA(PG8_SA(0, 1), a2, 1, vW);
            PG8_WAIT_V(8); PG8_WAIT_L(0); PG8_BAR; PG8_MMA(0, 0, At, B0); PG8_MMA(0, 1, At, B1); PG8_BAR; PG8_SCHED;
            PG8_LDA(At, 1, 1); PG8_STAGE(PG8_SB(1, 0), b3, voffB); PG8_STAGE(PG8_SB(1, 1), b3 + hstep, voffB); PG8_STGA(PG8_SA(1, 0), a3, 0, vW);
            PG8_WAIT_V(8); PG8_WAIT_L(0); PG8_BAR; PG8_MMA(1, 0, At, B0); PG8_MMA(1, 1, At, B1); PG8_BAR; PG8_SCHED;
        }
        if (wr == 0) PG8_BAR;
        if constexpr (F8) { asm volatile("s_nop 15\n\ts_nop 15" ::: "memory"); }
        E(acc, cur, wr, wc, fr, fq);
        if (!has_next) break;
#pragma unroll
        for (int a = 0; a < 2; ++a)
#pragma unroll
            for (int b = 0; b < 2; ++b)
#pragma unroll
                for (int m = 0; m < 4; ++m)
#pragma unroll
                    for (int n = 0; n < 2; ++n) acc[a][b][m][n] = (f32x4){0.f, 0.f, 0.f, 0.f};
        cur = nxt; cA = nA; cB = nB; ++ui;
#pragma unroll
        for (int j = 0; j < 4; ++j) vAc[j] = vAn[j];
        if (wr == 1) PG8_BAR;
    }
    PG8_WAIT_V(0);
    PG8_BAR;
#undef PG8_SA
#undef PG8_SB
#undef PG8_STAGE
#undef PG8_STGA
#undef PG8_LDA
#undef PG8_LDB
#undef PG8_MMA
#undef PG8_LD8
#undef PG8_WAIT_V
#undef PG8_WAIT_L
#undef PG8_BAR
#undef PG8_SCHED
#undef PG8_ROWS
}

struct SchedDense {
    const char* A; const char* Bt; int nM, nN, nwg, G, c; size_t tstep;
    __device__ void init(const void* A_, const void* Bt_, int M, int N, int K, int G_, int c_) { A = (const char*)A_; Bt = (const char*)Bt_; nM = M / BM; nN = N / BM; nwg = nM * nN; G = G_; c = c_; tstep = (size_t)BM * K * 2; }
    __device__ bool next(int i, Unit& u) const {
        const long L = (long)i * G + c; if (L >= nwg) return false;
        int wgid = (int)L; { const int q = nwg / NXCD, r = nwg % NXCD, xcd = wgid % NXCD, off = wgid / NXCD; wgid = (xcd < r ? xcd * (q + 1) : r * (q + 1) + (xcd - r) * q) + off; }
        const int nig = WGM * nN, gid = wgid / nig, fm = gid * WGM, gsz = (nM - fm) < WGM ? (nM - fm) : WGM;
        u.pm = fm + ((wgid % nig) % gsz); u.pn = (wgid % nig) / gsz; u.e = 0; u.rows = nullptr;
        u.a = A + (size_t)u.pm * tstep; u.b = Bt + (size_t)u.pn * tstep; return true;
    }
};
}

#ifndef H_DELTA
#define H_DELTA 1
#endif
#ifndef YB_F8
#define YB_F8 1
#endif
#ifndef MOE_F8
#define MOE_F8 1
#endif

namespace epi {
using pg8::Unit;
#define EPI_ROWS(ai, m) (128 * (ai) + 64 * wr + 16 * (m) + fr)
__device__ __forceinline__ u32x4 pack8(const f32x4 v0, const f32x4 v1) { u32x4 w; w.x = cvt_pk_bf16(v0[0], v0[1]); w.y = cvt_pk_bf16(v0[2], v0[3]); w.z = cvt_pk_bf16(v1[0], v1[1]); w.w = cvt_pk_bf16(v1[2], v1[3]); return w; }
__device__ __forceinline__ f32x4 sig4(const f32x4 v) { return (f32x4){sigmoidf_(v[0]), sigmoidf_(v[1]), sigmoidf_(v[2]), sigmoidf_(v[3])}; }
__device__ __forceinline__ f32x4 silu4(const f32x4 v) { return (f32x4){siluf_(v[0]), siluf_(v[1]), siluf_(v[2]), siluf_(v[3])}; }
__device__ __forceinline__ void unpack8(const u32x4 w, f32x4& v0, f32x4& v1) { v0 = (f32x4){bf_lo(w.x), bf_hi(w.x), bf_lo(w.y), bf_hi(w.y)}; v1 = (f32x4){bf_lo(w.z), bf_hi(w.z), bf_lo(w.w), bf_hi(w.w)}; }

struct EpiGlu {
    static constexpr bool PERM = true;
    bf16_t* V; const float* bias;
    __device__ __forceinline__ void operator()(const f32x4 (&acc)[2][2][4][2], const Unit& u, int wr, int wc, int fr, int fq) const {
        const int ch = u.pn * 128 + wc * 32 + 8 * fq;
        f32x4 ba[2], bg[2];
#pragma unroll
        for (int n = 0; n < 2; ++n) { ba[n] = *(const f32x4*)(bias + ch + 4 * n); bg[n] = *(const f32x4*)(bias + CW + ch + 4 * n); }
#pragma unroll
        for (int ai = 0; ai < 2; ++ai)
#pragma unroll
            for (int m = 0; m < 4; ++m) { const size_t row = (size_t)u.pm * 256 + EPI_ROWS(ai, m);
                const f32x4 v0 = (acc[ai][0][m][0] + ba[0]) * sig4(acc[ai][1][m][0] + bg[0]), v1 = (acc[ai][0][m][1] + ba[1]) * sig4(acc[ai][1][m][1] + bg[1]);
                *(u32x4*)(V + row * CW + ch) = pack8(v0, v1); }
    }
};
struct EpiFT {
    static constexpr bool PERM = true;
    bf16_t* FT; const float* bias;
    __device__ __forceinline__ void operator()(const f32x4 (&acc)[2][2][4][2], const Unit& u, int wr, int wc, int fr, int fq) const {
#pragma unroll
        for (int ai = 0; ai < 2; ++ai)
#pragma unroll
            for (int m = 0; m < 4; ++m) { const int ch = u.pm * 256 + EPI_ROWS(ai, m); const float bv = bias[ch];
#pragma unroll
                for (int bj = 0; bj < 2; ++bj) { const int tok = u.pn * 256 + bj * 128 + wc * 32 + 8 * fq; const int b = tok >> 12, s = tok & (S - 1);
                    *(u32x4*)(FT + ((size_t)(b * FW + ch) * S + s)) = pack8(acc[ai][bj][m][0] + bv, acc[ai][bj][m][1] + bv); } }
    }
};
struct EpiFFT {
    static constexpr bool PERM = true;
    bf16_t* YRI;
    __device__ __forceinline__ void operator()(const f32x4 (&acc)[2][2][4][2], const Unit& u, int wr, int wc, int fr, int fq) const {
        const int part = u.pm, chb = u.pn & 1, k2 = (u.pn >> 1) & 15, b = u.pn >> 5;
#pragma unroll
        for (int ai = 0; ai < 2; ++ai)
#pragma unroll
            for (int m = 0; m < 4; ++m) { const int k1 = EPI_ROWS(ai, m);
                bf16_t* rowp = YRI + ((size_t)(b * S + 16 * k1 + k2) * (2 * FW) + part * FW + chb * 256 + wc * 32 + 8 * fq);
#pragma unroll
                for (int bj = 0; bj < 2; ++bj) *(u32x4*)(rowp + bj * 128) = pack8(acc[ai][bj][m][0], acc[ai][bj][m][1]); }
    }
};
struct EpiBias {
    static constexpr bool PERM = true;
    bf16_t* O; int ldc; const float* bias;
    __device__ __forceinline__ void operator()(const f32x4 (&acc)[2][2][4][2], const Unit& u, int wr, int wc, int fr, int fq) const {
        const int col0 = u.pn * 256 + wc * 32 + 8 * fq;
        f32x4 bv[2][2];
#pragma unroll
        for (int bj = 0; bj < 2; ++bj)
#pragma unroll
            for (int n = 0; n < 2; ++n) bv[bj][n] = *(const f32x4*)(bias + col0 + bj * 128 + 4 * n);
#pragma unroll
        for (int ai = 0; ai < 2; ++ai)
#pragma unroll
            for (int m = 0; m < 4; ++m) { bf16_t* rowp = O + ((size_t)u.pm * 256 + EPI_ROWS(ai, m)) * ldc + col0;
#pragma unroll
                for (int bj = 0; bj < 2; ++bj) *(u32x4*)(rowp + bj * 128) = pack8(acc[ai][bj][m][0] + bv[bj][0], acc[ai][bj][m][1] + bv[bj][1]); }
    }
};
struct EpiMerge {
    static constexpr bool PERM = true;
    bf16_t* MG; const bf16_t* YC; const bf16_t* YF; const float* bias;
    __device__ __forceinline__ void operator()(const f32x4 (&acc)[2][2][4][2], const Unit& u, int wr, int wc, int fr, int fq) const {
        const int nn = u.pn * 128 + wc * 32 + 8 * fq;
        f32x4 b0[2], b1[2];
#pragma unroll
        for (int n = 0; n < 2; ++n) { b0[n] = *(const f32x4*)(bias + 2 * CW + FW + nn + 4 * n); b1[n] = *(const f32x4*)(bias + 2 * CW + FW + D + nn + 4 * n); }
#pragma unroll
        for (int ai = 0; ai < 2; ++ai)
#pragma unroll
            for (int m = 0; m < 4; ++m) { const size_t off = ((size_t)u.pm * 256 + EPI_ROWS(ai, m)) * D + nn;
                const u32x4 wc_ = *(const u32x4*)(YC + off), wf_ = *(const u32x4*)(YF + off);
                f32x4 c0, c1, f0, f1; unpack8(wc_, c0, c1); unpack8(wf_, f0, f1);
                const f32x4 v0 = sig4(acc[ai][0][m][0] + b0[0]) * c0 + sig4(acc[ai][1][m][0] + b1[0]) * f0;
                const f32x4 v1 = sig4(acc[ai][0][m][1] + b0[1]) * c1 + sig4(acc[ai][1][m][1] + b1[1]) * f1;
                *(u32x4*)(MG + off) = pack8(v0, v1); }
    }
};
struct EpiResid {
    static constexpr bool PERM = false;
    const float* X; float* H; const float* gate; const float* bias;
    __device__ __forceinline__ void operator()(const f32x4 (&acc)[2][2][4][2], const Unit& u, int wr, int wc, int fr, int fq) const {
        const int col0 = u.pn * 256 + wc * 32 + 4 * fq; const int b = (u.pm * 256) >> 12;
        const float* gp = gate + (size_t)b * NMOD * D + col0; const float* bp = bias + col0;
#pragma unroll
        for (int ai = 0; ai < 2; ++ai) {
            f32x4 xv[4][2][2];
#pragma unroll
            for (int m = 0; m < 4; ++m) { const size_t off = ((size_t)u.pm * 256 + EPI_ROWS(ai, m)) * D + col0;
#pragma unroll
                for (int bj = 0; bj < 2; ++bj)
#pragma unroll
                    for (int n = 0; n < 2; ++n) xv[m][bj][n] = *(const f32x4*)(X + off + bj * 128 + n * 16); }
#pragma unroll
            for (int bj = 0; bj < 2; ++bj)
#pragma unroll
                for (int n = 0; n < 2; ++n) { const f32x4 gv = *(const f32x4*)(gp + bj * 128 + n * 16), bv = *(const f32x4*)(bp + bj * 128 + n * 16);
#pragma unroll
                    for (int m = 0; m < 4; ++m) { const size_t off = ((size_t)u.pm * 256 + EPI_ROWS(ai, m)) * D + col0;
                        *(f32x4*)(H + off + bj * 128 + n * 16) = xv[m][bj][n] + gv * (acc[ai][bj][m][n] + bv); } }
            asm volatile("" ::: "memory");
        }
    }
};
struct EpiDelta {
    static constexpr bool PERM = true;
    bf16_t* DL; const float* gate; const float* bias;
    __device__ __forceinline__ void operator()(const f32x4 (&acc)[2][2][4][2], const Unit& u, int wr, int wc, int fr, int fq) const {
        const int col0 = u.pn * 256 + wc * 32 + 8 * fq; const int b = (u.pm * 256) >> 12;
        f32x4 bv[2][2], gv[2][2];
#pragma unroll
        for (int bj = 0; bj < 2; ++bj)
#pragma unroll
            for (int n = 0; n < 2; ++n) { bv[bj][n] = *(const f32x4*)(bias + col0 + bj * 128 + 4 * n); gv[bj][n] = *(const f32x4*)(gate + (size_t)b * NMOD * D + col0 + bj * 128 + 4 * n); }
#pragma unroll
        for (int ai = 0; ai < 2; ++ai)
#pragma unroll
            for (int m = 0; m < 4; ++m) { bf16_t* rowp = DL + ((size_t)u.pm * 256 + EPI_ROWS(ai, m)) * D + col0;
#pragma unroll
                for (int bj = 0; bj < 2; ++bj) *(u32x4*)(rowp + bj * 128) = pack8(gv[bj][0] * (acc[ai][bj][m][0] + bv[bj][0]), gv[bj][1] * (acc[ai][bj][m][1] + bv[bj][1])); }
    }
};
constexpr float ACT_SC = 2.f, U_SC = 4.f, W_SC = 64.f;
constexpr int MX_U = 0x7d7d7d7d, MX_ACT = 0x7e7e7e7e, MX_W = 0x79797979;
template <bool F8> struct EpiSwiglu {
    static constexpr bool PERM = true;
    void* ACT;
    __device__ __forceinline__ void operator()(const f32x4 (&acc)[2][2][4][2], const Unit& u, int wr, int wc, int fr, int fq) const {
        const int col = u.pn * 128 + wc * 32 + 8 * fq;
#pragma unroll
        for (int ai = 0; ai < 2; ++ai)
#pragma unroll
            for (int m = 0; m < 4; ++m) { const size_t row = (size_t)u.e * ME + u.pm * 256 + EPI_ROWS(ai, m);
                const f32x4 v0 = silu4(acc[ai][0][m][0]) * acc[ai][1][m][0], v1 = silu4(acc[ai][0][m][1]) * acc[ai][1][m][1];
                if constexpr (F8) *(u32x2*)((unsigned char*)ACT + row * F + col) = pack8_f8(v0, v1, ACT_SC);
                else *(u32x4*)((bf16_t*)ACT + row * F + col) = pack8(v0, v1); }
    }
};
constexpr float YB_SC = 32.f;
struct EpiScaleW {
    static constexpr bool PERM = true;
    void* YB; const float* W;
    __device__ __forceinline__ void operator()(const f32x4 (&acc)[2][2][4][2], const Unit& u, int wr, int wc, int fr, int fq) const {
        const int col0 = u.pn * 256 + wc * 32 + 8 * fq;
#pragma unroll
        for (int ai = 0; ai < 2; ++ai)
#pragma unroll
            for (int m = 0; m < 4; ++m) { const size_t row = (size_t)u.e * ME + u.pm * 256 + EPI_ROWS(ai, m); const float w = W[row];
#pragma unroll
                for (int bj = 0; bj < 2; ++bj) {
                    if (YB_F8) *(u32x2*)((unsigned char*)YB + row * D + col0 + bj * 128) = pack8_f8(acc[ai][bj][m][0], acc[ai][bj][m][1], w * YB_SC);
                    else *(u32x4*)((bf16_t*)YB + row * D + col0 + bj * 128) = pack8(acc[ai][bj][m][0] * w, acc[ai][bj][m][1] * w); } }
    }
};
#undef EPI_ROWS
}

namespace pg8 {
struct SchedG1 {
    const char* U; const char* W; const int* rowl; int G, c, esz;
    __device__ bool next(int i, Unit& u) const {
        int e;
        if (G == 256) { if (i >= 16) return false; const int xcd = c & 7, j = c >> 3, ri = i & 7; e = 2 * xcd + (i >> 3); u.pm = (ri & 1) * 8 + (j & 7); u.pn = (ri >> 1) * 4 + (j >> 3); }
        else { const int L = i * G + c; if (L >= E * 256) return false; e = L >> 8; const int l = L & 255; u.pm = l & 15; u.pn = l >> 4; }
        u.e = e; u.a = U; u.rows = rowl + e * ME + u.pm * 256; u.b = W + ((size_t)e * 2 * F + (size_t)u.pn * 256) * D * esz; return true;
    }
};
struct SchedG2 {
    const char* ACT; const char* W; int G, c, esz;
    __device__ bool next(int i, Unit& u) const {
        int e;
        if (G == 256) { if (i >= 4) return false; const int xcd = c & 7, j = c >> 3; e = 2 * xcd + (i >> 1); u.pm = (i & 1) * 8 + (j & 7); u.pn = j >> 3; }
        else { const int L = i * G + c; if (L >= E * 64) return false; e = L >> 6; const int l = L & 63; u.pm = l & 15; u.pn = l >> 4; }
        u.e = e; u.rows = nullptr;
        u.a = ACT + ((size_t)e * ME + (size_t)u.pm * 256) * F * esz; u.b = W + ((size_t)e * D + (size_t)u.pn * 256) * F * esz; return true;
    }
};
}

struct Ctx {
    LAS unsigned char* lds; int tid, lane, wave, vcu, G;
};

__device__ __forceinline__ void transpose_item(const float* W, int ldw, int k0, int n0, bf16_t* WT, int ldt, int dst_row0, LAS float* scr, int lane) {
#pragma unroll 8
    for (int i = 0; i < 32; ++i) { const int kk = 2 * i + (lane >> 5); scr[kk * 33 + (lane & 31)] = W[(size_t)(k0 + kk) * ldw + n0 + (lane & 31)]; }
    LDS_WAIT(); asm volatile("" ::: "memory");
    const int c = lane & 7;
#pragma unroll
    for (int j = 0; j < 4; ++j) { const int n = (lane >> 3) + 8 * j; const LAS float* s = scr + (8 * c) * 33 + n;
        u32x4 o; o.x = pk2(s[0 * 33], s[1 * 33]); o.y = pk2(s[2 * 33], s[3 * 33]); o.z = pk2(s[4 * 33], s[5 * 33]); o.w = pk2(s[6 * 33], s[7 * 33]);
        *(GAS u32x4*)(WT + (size_t)(dst_row0 + n) * ldt + k0 + 8 * c) = o; }
    LDS_WAIT(); asm volatile("" ::: "memory");
}
struct TItem { const float* src; unsigned char* dst; int ldw, ldt; };
__device__ __forceinline__ void titem_load(const TItem& t, int lane, f32x4 (&v)[8]) {
#pragma unroll
    for (int i = 0; i < 8; ++i) v[i] = *(const GAS f32x4*)(t.src + (size_t)(8 * i + (lane >> 3)) * t.ldw + (lane & 7) * 4);
}
__device__ __forceinline__ void titem_store_f8(const TItem& t, int lane, const f32x4 (&v)[8], LAS float* scr, float sc) {
#pragma unroll
    for (int i = 0; i < 8; ++i) { LAS float* d = scr + (8 * i + (lane >> 3)) * 33 + (lane & 7) * 4; d[0] = v[i][0]; d[1] = v[i][1]; d[2] = v[i][2]; d[3] = v[i][3]; }
    LDS_WAIT(); asm volatile("" ::: "memory");
#pragma unroll
    for (int j = 0; j < 2; ++j) { const int idx = lane + 64 * j, n = idx >> 2, c = idx & 3; const LAS float* s = scr + (16 * c) * 33 + n;
        unsigned w[4];
#pragma unroll
        for (int q = 0; q < 4; ++q) { unsigned tt = 0u; tt = __builtin_amdgcn_cvt_pk_fp8_f32(s[(4 * q + 0) * 33] * sc, s[(4 * q + 1) * 33] * sc, tt, false); tt = __builtin_amdgcn_cvt_pk_fp8_f32(s[(4 * q + 2) * 33] * sc, s[(4 * q + 3) * 33] * sc, tt, true); w[q] = tt; }
        *(GAS u32x4*)(t.dst + (size_t)n * t.ldt + 16 * c) = (u32x4){w[0], w[1], w[2], w[3]}; }
    LDS_WAIT(); asm volatile("" ::: "memory");
}
__device__ __forceinline__ int win_row(int n0) {
    if (n0 < 2 * CW) { const int half = n0 / CW, ch = n0 % CW; return 256 * (ch / 128) + 128 * half + (ch % 128); }
    if (n0 < 2 * CW + FW) return n0;
    const int cc = n0 - (2 * CW + FW), half = cc / D, c2 = cc % D; return 2 * CW + FW + 256 * (c2 / 128) + 128 * half + (c2 % 128);
}

struct P {
    const float *x, *c, *ada_w, *ada_b, *norm1_g, *w_in, *b_in, *dw_w, *dw_b, *cln_g, *cln_b, *cw_out, *cb_out, *four_w, *four_b, *w_out, *b_out, *norm2_g, *router_w, *w_gate, *w_up, *w_down, *final_g;
    float* out;
    float* MOD; float* W2F; float* AFF; int* ROWL; float* WTS; short* INV;
    bf16_t *Wt_in, *Wt_conv, *Wt_four, *Wt_out, *D256, *GP, *Wt_gu, *Wt_down;
    bf16_t *U, *V, *FT, *ACONV, *YRI, *YCONV, *YFOUR, *MERGED, *ACT, *YB, *DELTA;
};

__device__ __forceinline__ void titem_store_bf16(const TItem& t, int lane, const f32x4 (&v)[8], LAS float* scr) {
#pragma unroll
    for (int i = 0; i < 8; ++i) { LAS float* d = scr + (8 * i + (lane >> 3)) * 33 + (lane & 7) * 4; d[0] = v[i][0]; d[1] = v[i][1]; d[2] = v[i][2]; d[3] = v[i][3]; }
    LDS_WAIT(); asm volatile("" ::: "memory");
    const int c = lane & 7;
#pragma unroll
    for (int j = 0; j < 4; ++j) { const int n = (lane >> 3) + 8 * j; const LAS float* s = scr + (8 * c) * 33 + n;
        u32x4 o; o.x = pk2(s[0 * 33], s[1 * 33]); o.y = pk2(s[2 * 33], s[3 * 33]); o.z = pk2(s[4 * 33], s[5 * 33]); o.w = pk2(s[6 * 33], s[7 * 33]);
        *(GAS u32x4*)(t.dst + ((size_t)n * t.ldt + 8 * c) * 2) = o; }
    LDS_WAIT(); asm volatile("" ::: "memory");
}
__device__ __forceinline__ TItem small_item(const P& p, int r) {
    constexpr int I1 = (D / 64) * (INC / 32), I2 = (CW / 64) * (D / 32);
    TItem t;
    if (r < I1) { const int kb = r / (INC / 32), nb = r % (INC / 32); t.src = p.w_in + (size_t)(64 * kb) * INC + 32 * nb; t.ldw = INC; t.ldt = D; t.dst = (unsigned char*)(p.Wt_in + (size_t)win_row(32 * nb) * D + 64 * kb); return t; }
    r -= I1;
    if (r < I2) { const int kb = r / (D / 32), nb = r % (D / 32); t.src = p.cw_out + (size_t)(64 * kb) * D + 32 * nb; t.ldw = D; t.ldt = CW; t.dst = (unsigned char*)(p.Wt_conv + (size_t)(32 * nb) * CW + 64 * kb); return t; }
    r -= I2;
    { const int kb = r / (D / 32), nb = r % (D / 32); t.src = p.w_out + (size_t)(64 * kb) * D + 32 * nb; t.ldw = D; t.ldt = D; t.dst = (unsigned char*)(p.Wt_out + (size_t)(32 * nb) * D + 64 * kb); return t; }
}
__device__ __forceinline__ void phase_p0a(const Ctx& X0, const P& p) {
    Ctx X = X0; X.tid = (int)threadIdx.x; asm volatile("" : "+v"(X.tid)); X.lane = X.tid & 63;
    LAS float* scr = (LAS float*)(X.lds + X.wave * 16384);
    const int gw = X.vcu * NWAVES + X.wave, NGW = X.G * NWAVES;
    constexpr int I1 = (D / 64) * (INC / 32), I2 = (CW / 64) * (D / 32), I4 = (D / 64) * (D / 32);
    const bool do_mod = X.vcu < NMOD * D / 32; const int mcol = X.tid & 31, mks = X.tid >> 5, mj0 = X.vcu * 32;
    float mw[64];
    if (do_mod) {
#pragma unroll
        for (int k = 0; k < 64; ++k) mw[k] = p.ada_w[(size_t)(mks * 64 + k) * (NMOD * D) + mj0 + mcol]; }
    const int fg = X.vcu / (D / 16), fn0 = (X.vcu % (D / 16)) * 16;
    f32x4 ftile = (f32x4){0.f, 0.f, 0.f, 0.f};
    if (X.vcu < FG * (D / 16)) ftile = *(const GAS f32x4*)(p.four_w + (size_t)(fg * FGD + (X.tid >> 2)) * D + fn0 + (X.tid & 3) * 4);
    {   f32x4 va[8], vb[8]; TItem cur, nx; int it = gw;
        if (it < I1 + I2 + I4) { cur = small_item(p, it); titem_load(cur, X.lane, va); }
        while (it < I1 + I2 + I4) {
            const int nxt = it + NGW; if (nxt < I1 + I2 + I4) { nx = small_item(p, nxt); titem_load(nx, X.lane, vb); }
            titem_store_bf16(cur, X.lane, va, scr);
#pragma unroll
            for (int i = 0; i < 8; ++i) va[i] = vb[i];
            cur = nx; it = nxt;
        }
    }
    __syncthreads();
    LAS float* ct = (LAS float*)X.lds; LAS float* c128 = ct + S;
    for (int i = X.tid; i < S; i += NTHR) { float sv, cv; sincospif((float)i / (float)(S / 2), &sv, &cv); ct[i] = cv; }
    if (X.tid < FGD) { float sv, cv; sincospif((float)X.tid / 64.f, &sv, &cv); c128[X.tid] = cv; }
    __syncthreads();
    const int gt = X.vcu * NTHR + X.tid, NGT = X.G * NTHR;
    for (int it = gt; it < 512 * 64; it += NGT) { const int r = it >> 6, c0 = (it & 63) * 8; const int part = r >> 8, k1 = r & 255, pc = c0 >> 8, s10 = c0 & 255;
        const int ph = (part == pc) ? 0 : (part == 0 ? -(S / 4) : (S / 4));
        unsigned w[4];
#pragma unroll
        for (int j = 0; j < 4; ++j) { const float a = ct[(16 * k1 * (s10 + 2 * j) + ph) & (S - 1)], b = ct[(16 * k1 * (s10 + 2 * j + 1) + ph) & (S - 1)]; w[j] = pk2(a, b); }
        *(GAS u32x4*)(p.D256 + (size_t)r * 512 + c0) = (u32x4){w[0], w[1], w[2], w[3]}; }
    {
        LAS float* wt = c128 + FGD;
        for (int it = X.vcu; it < FG * (D / 16); it += X.G) { const int g = it / (D / 16), n0 = (it % (D / 16)) * 16;
            __syncthreads();
            if (it == X.vcu) *(LAS f32x4*)(wt + 4 * X.tid) = ftile;
            else for (int i = X.tid; i < FGD * 16; i += NTHR) wt[i] = p.four_w[(size_t)(g * FGD + (i >> 4)) * D + n0 + (i & 15)];
            __syncthreads();
            const int nq = X.tid & 3, c = X.tid >> 2; int idx = 0;
            f32x4 ac = (f32x4){0.f, 0.f, 0.f, 0.f}, as = (f32x4){0.f, 0.f, 0.f, 0.f};
#pragma unroll 8
            for (int j = 0; j < FGD; ++j) { const float tc = c128[idx], ts = c128[(idx + 96) & 127];
                const f32x4 wv = *(const LAS f32x4*)(wt + j * 16 + 4 * nq); ac += wv * tc; as += wv * ts; idx = (idx + c) & 127; }
            *(GAS f32x4*)(p.W2F + (size_t)(g * FGD + c) * D + n0 + 4 * nq) = ac * 0.0013810679320049757f;
            *(GAS f32x4*)(p.W2F + (size_t)(FW + g * FGD + c) * D + n0 + 4 * nq) = as * 0.0013810679320049757f;
        }
    }
    __syncthreads();
    if (do_mod) {
        LAS float* cs = (LAS float*)X.lds;
        LAS float* part = cs + Bn * D;
        for (int i = X.tid; i < Bn * D; i += NTHR) cs[i] = siluf_(p.c[i]);
        __syncthreads();
        const int col = X.tid & 31, ks = X.tid >> 5, j0 = X.vcu * 32;
        float acc[Bn];
#pragma unroll
        for (int b = 0; b < Bn; ++b) acc[b] = 0.f;
#pragma unroll
        for (int k = 0; k < 64; ++k)
#pragma unroll
            for (int b = 0; b < Bn; ++b) acc[b] += cs[b * D + ks * 64 + k] * mw[k];
#pragma unroll
        for (int b = 0; b < Bn; ++b) part[(ks * Bn + b) * 32 + col] = acc[b];
        __syncthreads();
        if (X.tid < Bn * 32) { const int b = X.tid >> 5, cc = X.tid & 31; float s = p.ada_b[j0 + cc];
#pragma unroll
            for (int k2 = 0; k2 < 16; ++k2) s += part[(k2 * Bn + b) * 32 + cc];
            p.MOD[b * NMOD * D + j0 + cc] = s; }
    }
}

__device__ __forceinline__ float row_load_rstd(const float* xr, int lane, f32x4 (&v)[4]) {
    float ss = 0.f;
#pragma unroll
    for (int j = 0; j < 2; ++j) { v[2 * j] = *(const GAS f32x4*)(xr + 8 * lane + 512 * j); v[2 * j + 1] = *(const GAS f32x4*)(xr + 8 * lane + 512 * j + 4); }
#pragma unroll
    for (int q = 0; q < 4; ++q) ss += (v[q][0] * v[q][0] + v[q][1] * v[q][1]) + (v[q][2] * v[q][2] + v[q][3] * v[q][3]);
    return 1.f / sqrtf(wave_sum(ss) * (1.f / D) + 1e-6f);
}
__device__ __forceinline__ void row_issue(const float* xr, int lane, f32x4 (&v)[4]) {
#pragma unroll
    for (int j = 0; j < 4; ++j) v[j] = *(const GAS f32x4*)(xr + 4 * lane + 256 * j);
}
__device__ __forceinline__ float row_rstd(const f32x4 (&v)[4]) {
    float ss = 0.f;
#pragma unroll
    for (int q = 0; q < 4; ++q) ss += (v[q][0] * v[q][0] + v[q][1] * v[q][1]) + (v[q][2] * v[q][2] + v[q][3] * v[q][3]);
    return 1.f / sqrtf(wave_sum(ss) * (1.f / D) + 1e-6f);
}
__device__ __forceinline__ TItem moe_item(const P& p, int r) {
    constexpr int I5 = (D / 64) * (F / 32), I6 = (F / 64) * (D / 32);
    TItem t;
    if (r < E * 2 * I5) { const int eh = r / I5, q = r % I5, e = eh >> 1, half = eh & 1; const int kb = q / (F / 32), nb = q % (F / 32), n0 = 32 * nb;
        t.src = (half ? p.w_up : p.w_gate) + (size_t)e * D * F + (size_t)(64 * kb) * F + n0; t.ldw = F; t.ldt = D;
        t.dst = (unsigned char*)p.Wt_gu + (size_t)e * 2 * F * D + (size_t)(256 * (n0 / 128) + 128 * half + (n0 % 128)) * D + 64 * kb; }
    else { r -= E * 2 * I5; const int e = r / I6, q = r % I6; const int kb = q / (D / 32), nb = q % (D / 32);
        t.src = p.w_down + (size_t)e * F * D + (size_t)(64 * kb) * D + 32 * nb; t.ldw = D; t.ldt = F;
        t.dst = (unsigned char*)p.Wt_down + (size_t)e * D * F + (size_t)(32 * nb) * F + 64 * kb; }
    return t;
}
__device__ __forceinline__ void phase_p0b(const Ctx& X0, const P& p) {
    Ctx X = X0; X.tid = (int)threadIdx.x; asm volatile("" : "+v"(X.tid)); X.lane = X.tid & 63;
    const int gw = X.vcu * NWAVES + X.wave, NGW = X.G * NWAVES;
    {
        const int RPW = T / X.G, base = X.vcu * RPW; const float* md = p.MOD + (size_t)(base >> 12) * NMOD * D;
        f32x4 av[4], sv[4];
#pragma unroll
        for (int j = 0; j < 4; ++j) { const int c0 = 4 * X.lane + 256 * j; av[j] = *(const f32x4*)(p.norm1_g + c0) * (*(const f32x4*)(md + D + c0) + 1.f); sv[j] = *(const f32x4*)(md + c0); }
        f32x4 v[4], vn[4], vn2[4]; int i = X.wave; if (i < RPW) row_issue(p.x + (size_t)(base + i) * D, X.lane, v);
        if (i + NWAVES < RPW) row_issue(p.x + (size_t)(base + i + NWAVES) * D, X.lane, vn);
        for (; i < RPW; i += NWAVES) {
            const int m = base + i, in2 = i + 2 * NWAVES; if (in2 < RPW) row_issue(p.x + (size_t)(base + in2) * D, X.lane, vn2);
            const float rstd = row_rstd(v);
#pragma unroll
            for (int j = 0; j < 4; ++j) { const int c0 = 4 * X.lane + 256 * j; const f32x4 o = v[j] * rstd * av[j] + sv[j];
                *(GAS u32x2*)(p.U + (size_t)m * D + c0) = (u32x2){cvt_pk_bf16(o[0], o[1]), cvt_pk_bf16(o[2], o[3])}; }
#pragma unroll
            for (int q = 0; q < 4; ++q) { v[q] = vn[q]; vn[q] = vn2[q]; }
        }
    }
    LAS float* scr = (LAS float*)(X.lds + X.wave * 16384);
    constexpr int I3 = (D / 64) * (D / 32);
    for (int it = gw; it < I3; it += NGW) { const int kb = it / (D / 32), nb = it % (D / 32); transpose_item(p.W2F, D, 64 * kb, 32 * nb, p.Wt_four, D, 32 * nb, scr, X.lane); }
    constexpr int NIT = E * 2 * (D / 64) * (F / 32) + E * (F / 64) * (D / 32);
#if MOE_F8
    {   f32x4 va[8], vb[8], vc[8]; TItem cur, nx, nx2; int it = gw;
        if (it < NIT) { cur = moe_item(p, it); titem_load(cur, X.lane, va); }
        if (it + NGW < NIT) { nx = moe_item(p, it + NGW); titem_load(nx, X.lane, vb); }
        while (it < NIT) {
            const int n2 = it + 2 * NGW; if (n2 < NIT) { nx2 = moe_item(p, n2); titem_load(nx2, X.lane, vc); }
            titem_store_f8(cur, X.lane, va, scr, epi::W_SC);
#pragma unroll
            for (int i = 0; i < 8; ++i) { va[i] = vb[i]; vb[i] = vc[i]; }
            cur = nx; nx = nx2; it += NGW;
        }
    }
#else
    constexpr int I5 = (D / 64) * (F / 32), I6 = (F / 64) * (D / 32);
    for (int it = gw; it < NIT; it += NGW) { int r = it;
        if (r < E * 2 * I5) { const int eh = r / I5, q = r % I5, e = eh >> 1, half = eh & 1; const int kb = q / (F / 32), nb = q % (F / 32), n0 = 32 * nb;
            transpose_item((half ? p.w_up : p.w_gate) + (size_t)e * D * F, F, 64 * kb, n0, p.Wt_gu + (size_t)e * 2 * F * D, D, 256 * (n0 / 128) + 128 * half + (n0 % 128), scr, X.lane); continue; } r -= E * 2 * I5;
        { const int e = r / I6, q = r % I6; const int kb = q / (D / 32), nb = q % (D / 32);
            transpose_item(p.w_down + (size_t)e * F * D, D, 64 * kb, 32 * nb, p.Wt_down + (size_t)e * D * F, F, 32 * nb, scr, X.lane); } }
#endif
}

__device__ __forceinline__ void phase_conv(const Ctx& X0, const P& p) {
    Ctx X = X0; X.tid = (int)threadIdx.x; asm volatile("" : "+v"(X.tid)); X.lane = X.tid & 63;
    constexpr int CH = 32, ROWS = CH + CK - 1;
    LAS unsigned char* rows = X.lds;
    LAS float* wl = (LAS float*)(X.lds + ROWS * 1024);
    for (int i = X.tid; i < CK * CW; i += NTHR) { const int k = i / CW, ch = i % CW; const int ln = ch >> 3, q = (ch >> 2) & 1, r = ch & 3; wl[((k * 2 + q) * 64 + ln) * 4 + r] = p.dw_w[i]; }
    const int lane = X.lane, w = X.wave;
    f32x4 db[2], lg[2], lb[2];
#pragma unroll
    for (int h = 0; h < 2; ++h) { db[h] = *(const f32x4*)(p.dw_b + 8 * lane + 4 * h); lg[h] = *(const f32x4*)(p.cln_g + 8 * lane + 4 * h); lb[h] = *(const f32x4*)(p.cln_b + 8 * lane + 4 * h); }
    u32x4 pre[8];
#define CV_LOAD(chk) do { const int t0_ = (chk) * CH, b_ = t0_ >> 12, s0_ = t0_ & (S - 1); _Pragma("unroll") for (int q = 0; q < 8; ++q) { const int i = X.tid + q * NTHR, r = i >> 6, cseg = i & 63, s = s0_ + r - CK / 2; \
        pre[q] = (u32x4){0u, 0u, 0u, 0u}; if (i < ROWS * 64 && s >= 0 && s < S) pre[q] = *(const GAS u32x4*)(p.V + ((size_t)(b_ * S + s)) * CW + cseg * 8); } } while (0)
    if (X.vcu < T / CH) CV_LOAD(X.vcu);
    for (int chunk = X.vcu; chunk < T / CH; chunk += X.G) {
        const int t0 = chunk * CH;
        __syncthreads();
#pragma unroll
        for (int q = 0; q < 8; ++q) { const int i = X.tid + q * NTHR; if (i < ROWS * 64) *(LAS u32x4*)(rows + (i >> 6) * 1024 + (i & 63) * 16) = pre[q]; }
        if (chunk + X.G < T / CH) CV_LOAD(chunk + X.G);
        __syncthreads();
        f32x4 acc[4][2]; int zo = 0; asm volatile("" : "+v"(zo));
#pragma unroll
        for (int j = 0; j < 4; ++j) { acc[j][0] = db[0]; acc[j][1] = db[1]; }
#pragma unroll
        for (int rr = 0; rr < CK + 3; ++rr) {
            const u32x4 rv = *(const LAS u32x4*)(rows + (4 * w + rr) * 1024 + lane * 16); f32x4 a0, a1; epi::unpack8(rv, a0, a1);
#pragma unroll
            for (int j = 0; j < 4; ++j) { const int k = rr - j;
                if (k >= 0 && k < CK) { const f32x4 w0 = *(const LAS f32x4*)(wl + ((k * 2 + 0) * 64 + lane + zo) * 4), w1 = *(const LAS f32x4*)(wl + ((k * 2 + 1) * 64 + lane + zo) * 4);
                    acc[j][0] += a0 * w0; acc[j][1] += a1 * w1; } }
        }
#pragma unroll
        for (int j = 0; j < 4; ++j) {
            const f32x4 a0 = acc[j][0], a1 = acc[j][1];
            const float mu = wave_sum((a0[0] + a0[1]) + (a0[2] + a0[3]) + (a1[0] + a1[1]) + (a1[2] + a1[3])) * (1.f / CW);
            const f32x4 d0 = a0 - mu, d1 = a1 - mu;
            const float var = wave_sum((d0[0] * d0[0] + d0[1] * d0[1]) + (d0[2] * d0[2] + d0[3] * d0[3]) + (d1[0] * d1[0] + d1[1] * d1[1]) + (d1[2] * d1[2] + d1[3] * d1[3])) * (1.f / CW);
            const float rstd = 1.f / sqrtf(var + 1e-5f);
            const f32x4 z0 = d0 * rstd * lg[0] + lb[0], z1 = d1 * rstd * lg[1] + lb[1];
            *(GAS u32x4*)(p.ACONV + (size_t)(t0 + 4 * w + j) * CW + 8 * lane) = epi::pack8(epi::silu4(z0), epi::silu4(z1));
        }
    }
#undef CV_LOAD
    __syncthreads();
}


__device__ __forceinline__ void dft16_real(const float (&x)[16], float (&gr)[16], float (&gi)[16]) {
    constexpr float WR[10] = {1.f, 0.92387953251128674f, 0.70710678118654752f, 0.38268343236508977f, 0.f, -0.38268343236508977f, -0.70710678118654752f, -0.92387953251128674f, -1.f, -0.92387953251128674f};
    constexpr float WI[10] = {0.f, -0.38268343236508977f, -0.70710678118654752f, -0.92387953251128674f, -1.f, -0.92387953251128674f, -0.70710678118654752f, -0.38268343236508977f, 0.f, 0.38268343236508977f};
    float zr[4][4], zi[4][4];
#pragma unroll
    for (int b = 0; b < 4; ++b) { const float x0 = x[b], x1 = x[4 + b], x2 = x[8 + b], x3 = x[12 + b];
        const float s02 = x0 + x2, d02 = x0 - x2, s13 = x1 + x3, d13 = x1 - x3;
        const float yr[4] = {s02 + s13, d02, s02 - s13, d02}, yi[4] = {0.f, -d13, 0.f, d13};
#pragma unroll
        for (int c = 0; c < 4; ++c) { const float wr = WR[b * c], wi = WI[b * c]; zr[b][c] = yr[c] * wr - yi[c] * wi; zi[b][c] = yr[c] * wi + yi[c] * wr; } }
#pragma unroll
    for (int c = 0; c < 4; ++c) {
        const float ar = zr[0][c] + zr[2][c], ai = zi[0][c] + zi[2][c], br = zr[0][c] - zr[2][c], bi = zi[0][c] - zi[2][c];
        const float cr = zr[1][c] + zr[3][c], ci = zi[1][c] + zi[3][c], dr = zr[1][c] - zr[3][c], di = zi[1][c] - zi[3][c];
        gr[c] = ar + cr;      gi[c] = ai + ci;
        gr[c + 4] = br + di;  gi[c + 4] = bi - dr;
        gr[c + 8] = ar - cr;  gi[c + 8] = ai - ci;
        gr[c + 12] = br - di; gi[c + 12] = bi + dr;
    }
}
__device__ __forceinline__ void phase_fftA(const Ctx& X0, const P& p) {
    Ctx X = X0; X.tid = (int)threadIdx.x; asm volatile("" : "+v"(X.tid)); X.lane = X.tid & 63;
    LAS float* ct = (LAS float*)X.lds;
    for (int i = X.tid; i < S; i += NTHR) { float sv, cv; sincospif((float)i / (float)(S / 2), &sv, &cv); ct[i] = cv; }
    __syncthreads();
    constexpr float C16[16] = {1.f, 0.92387953251128674f, 0.70710678118654752f, 0.38268343236508977f, 0.f, -0.38268343236508977f, -0.70710678118654752f, -0.92387953251128674f,
                               -1.f, -0.92387953251128674f, -0.70710678118654752f, -0.38268343236508977f, 0.f, 0.38268343236508977f, 0.70710678118654752f, 0.92387953251128674f};
    const int chl = X.tid >> 7, sp = X.tid & 127;
    unsigned pre[16];
#define FA_LOAD(itm) do { const bf16_t* src_ = p.FT + ((size_t)(((itm) >> 7) * FW + ((itm) & 127) * 4 + chl) * S + 2 * sp); _Pragma("unroll") for (int s2 = 0; s2 < 16; ++s2) pre[s2] = *(const GAS unsigned*)(src_ + 256 * s2); } while (0)
    if (X.vcu < Bn * (FW / 4)) FA_LOAD(X.vcu);
    for (int it = X.vcu; it < Bn * (FW / 4); it += X.G) {
        const int b = it >> 7, ch = (it & 127) * 4 + chl;
        float xa[16], xb[16];
#pragma unroll
        for (int s2 = 0; s2 < 16; ++s2) { const unsigned w = pre[s2]; xa[s2] = bf_lo(w); xb[s2] = bf_hi(w); }
        if (it + X.G < Bn * (FW / 4)) FA_LOAD(it + X.G);
        float gar[16], gai[16], gbr[16], gbi[16];
        dft16_real(xa, gar, gai); dft16_real(xb, gbr, gbi);
#pragma unroll
        for (int k2 = 0; k2 < 16; ++k2) {
            const float ar = gar[k2], ai = gai[k2], br = gbr[k2], bi = gbi[k2];
            const int ia = (2 * sp * k2) & (S - 1), ib = ((2 * sp + 1) * k2) & (S - 1);
            const float tca = ct[ia], tsa = ct[(ia - S / 4) & (S - 1)], tcb = ct[ib], tsb = ct[(ib - S / 4) & (S - 1)];
            const float gra = ar * tca + ai * tsa, gia = ai * tca - ar * tsa, grb = br * tcb + bi * tsb, gib = bi * tcb - br * tsb;
            bf16_t* dst = p.GP + ((size_t)((b * 16 + k2) * FW + ch) * 512 + 2 * sp);
            *(GAS unsigned*)dst = cvt_pk_bf16(gra, grb); *(GAS unsigned*)(dst + 256) = cvt_pk_bf16(gia, gib);
        }
    }
    __syncthreads();
}

__device__ __forceinline__ void phase_router(const Ctx& X0, const P& p, const float* H) {
    Ctx X = X0; X.tid = (int)threadIdx.x; asm volatile("" : "+v"(X.tid)); X.lane = X.tid & 63;
    LAS float* GP = (LAS float*)X.lds;
    LAS float* SH = GP + D;
    LAS f32x4* ACCP = (LAS f32x4*)(SH + D);
    LAS float* SSP = (LAS float*)(ACCP + 2 * 8 * 64);
    LAS float* CE = SSP + 2 * 8 * 16;
    const int lane = X.lane, w = X.wave, r = lane & 15, kq = lane >> 4;
    constexpr int NG = T / 16, GPW = NG / 256;
    const int g0 = X.vcu * GPW, b = (g0 * 16) >> 12;
    const float* md = p.MOD + (size_t)b * NMOD * D;
    f32x4 a[4][2], vn[4][2];
    const int cbase = 128 * w + 8 * kq;
#if H_DELTA
#define RT_ISSUE(dst, grp) do { const size_t ro_ = ((size_t)(grp) * 16 + r) * D + cbase; const float* rp = H + ro_; const bf16_t* dp = p.DELTA + ro_; _Pragma("unroll") for (int s = 0; s < 4; ++s) { \
        const u32x4 dw_ = *(const GAS u32x4*)(dp + 32 * s); f32x4 d0_, d1_; epi::unpack8(dw_, d0_, d1_); dst[s][0] = *(const GAS f32x4*)(rp + 32 * s) + d0_; dst[s][1] = *(const GAS f32x4*)(rp + 32 * s + 4) + d1_; } } while (0)
#else
#define RT_ISSUE(dst, grp) do { const float* rp = H + ((size_t)(grp) * 16 + r) * D + cbase; _Pragma("unroll") for (int s = 0; s < 4; ++s) { dst[s][0] = *(const GAS f32x4*)(rp + 32 * s); dst[s][1] = *(const GAS f32x4*)(rp + 32 * s + 4); } } while (0)
#endif
    RT_ISSUE(a, g0);
    for (int i = X.tid; i < D; i += NTHR) { GP[i] = p.norm2_g[i] * (1.f + md[4 * D + i]); SH[i] = md[3 * D + i]; }
    bf16x8 bh[4], bl[4];
#pragma unroll
    for (int s = 0; s < 4; ++s) { unsigned hw[4], lw[4];
#pragma unroll
        for (int j = 0; j < 4; ++j) { const int d = 32 * (4 * w + s) + 8 * kq + 2 * j; const float x0 = p.router_w[(size_t)d * E + r], x1 = p.router_w[(size_t)(d + 1) * E + r];
            const unsigned h = cvt_pk_bf16(x0, x1); hw[j] = h; lw[j] = cvt_pk_bf16(x0 - bf_lo(h), x1 - bf_hi(h)); }
        bh[s] = __builtin_bit_cast(bf16x8, (u32x4){hw[0], hw[1], hw[2], hw[3]}); bl[s] = __builtin_bit_cast(bf16x8, (u32x4){lw[0], lw[1], lw[2], lw[3]}); }
    __syncthreads();
    if (w == 0) {
        float c[E];
#pragma unroll
        for (int e = 0; e < E; ++e) c[e] = 0.f;
        for (int d = lane; d < D; d += 64) { const float sv = SH[d]; const f32x4* wr_ = (const f32x4*)(p.router_w + (size_t)d * E);
#pragma unroll
            for (int q = 0; q < 4; ++q) { const f32x4 wv = wr_[q]; c[4 * q] += sv * wv[0]; c[4 * q + 1] += sv * wv[1]; c[4 * q + 2] += sv * wv[2]; c[4 * q + 3] += sv * wv[3]; } }
#pragma unroll
        for (int e = 0; e < E; ++e) { const float s = wave_sum(c[e]); if (lane == e) CE[e] = s; }
    }
    __syncthreads();
    for (int gi = 0; gi < GPW; ++gi) {
        const int g = g0 + gi, par = gi & 1;
        if (gi + 1 < GPW) RT_ISSUE(vn, g + 1);
        float ss = 0.f; f32x4 acc = (f32x4){0.f, 0.f, 0.f, 0.f};
#pragma unroll
        for (int s = 0; s < 4; ++s) {
            const f32x4 g0v = *(const LAS f32x4*)(GP + cbase + 32 * s), g1v = *(const LAS f32x4*)(GP + cbase + 32 * s + 4);
            const f32x4 v0 = a[s][0], v1 = a[s][1];
            ss += (v0[0] * v0[0] + v0[1] * v0[1]) + (v0[2] * v0[2] + v0[3] * v0[3]) + (v1[0] * v1[0] + v1[1] * v1[1]) + (v1[2] * v1[2] + v1[3] * v1[3]);
            const f32x4 x0 = v0 * g0v, x1 = v1 * g1v; a[s][0] = x0; a[s][1] = x1;
            unsigned hw[4], lw[4];
            hw[0] = cvt_pk_bf16(x0[0], x0[1]); hw[1] = cvt_pk_bf16(x0[2], x0[3]); hw[2] = cvt_pk_bf16(x1[0], x1[1]); hw[3] = cvt_pk_bf16(x1[2], x1[3]);
            lw[0] = cvt_pk_bf16(x0[0] - bf_lo(hw[0]), x0[1] - bf_hi(hw[0])); lw[1] = cvt_pk_bf16(x0[2] - bf_lo(hw[1]), x0[3] - bf_hi(hw[1]));
            lw[2] = cvt_pk_bf16(x1[0] - bf_lo(hw[2]), x1[1] - bf_hi(hw[2])); lw[3] = cvt_pk_bf16(x1[2] - bf_lo(hw[3]), x1[3] - bf_hi(hw[3]));
            const bf16x8 ah = __builtin_bit_cast(bf16x8, (u32x4){hw[0], hw[1], hw[2], hw[3]}), al = __builtin_bit_cast(bf16x8, (u32x4){lw[0], lw[1], lw[2], lw[3]});
            acc = __builtin_amdgcn_mfma_f32_16x16x32_bf16(ah, bh[s], acc, 0, 0, 0);
            acc = __builtin_amdgcn_mfma_f32_16x16x32_bf16(ah, bl[s], acc, 0, 0, 0);
            acc = __builtin_amdgcn_mfma_f32_16x16x32_bf16(al, bh[s], acc, 0, 0, 0);
        }
        ss += __shfl_xor(ss, 16); ss += __shfl_xor(ss, 32);
        ACCP[(par * 8 + w) * 64 + lane] = acc;
        if (lane < 16) SSP[(par * 8 + w) * 16 + lane] = ss;
        __syncthreads();
        float rss = 0.f;
#pragma unroll
        for (int q = 0; q < 8; ++q) rss += SSP[(par * 8 + q) * 16 + r];
        const float rstd = 1.f / sqrtf(rss * (1.f / D) + 1e-6f);
        if (w == (gi & 7)) {
            f32x4 lg = (f32x4){0.f, 0.f, 0.f, 0.f};
#pragma unroll
            for (int q = 0; q < 8; ++q) lg += ACCP[(par * 8 + q) * 64 + lane];
            const float ce = CE[r]; f32x4 o;
#pragma unroll
            for (int q = 0; q < 4; ++q) { const float rs = __shfl(rstd, 4 * kq + q); float z = lg[q] * rs + ce; float mx = z;
#pragma unroll
                for (int sft = 1; sft < 16; sft <<= 1) mx = fmaxf(mx, __shfl_xor(mx, sft));
                const float ex = expf(z - mx); float sm = ex;
#pragma unroll
                for (int sft = 1; sft < 16; sft <<= 1) sm += __shfl_xor(sm, sft);
                o[q] = ex / sm; }
            *(GAS f32x4*)(p.AFF + ((size_t)b * E + r) * S + ((g * 16) & (S - 1)) + 4 * kq) = o;
        }
#pragma unroll
        for (int s = 0; s < 4; ++s) {
            const f32x4 s0 = *(const LAS f32x4*)(SH + cbase + 32 * s), s1 = *(const LAS f32x4*)(SH + cbase + 32 * s + 4);
            const f32x4 u0 = a[s][0] * rstd + s0, u1 = a[s][1] * rstd + s1; const size_t off = ((size_t)g * 16 + r) * D + cbase + 32 * s;
            if (MOE_F8) *(GAS u32x2*)((unsigned char*)p.U + off) = pack8_f8(u0, u1, epi::U_SC);
            else *(GAS u32x4*)(p.U + off) = epi::pack8(u0, u1);
        }
#pragma unroll
        for (int s = 0; s < 4; ++s) { a[s][0] = vn[s][0]; a[s][1] = vn[s][1]; }
    }
#undef RT_ISSUE
    __syncthreads();
}

__device__ __forceinline__ void phase_topk(const Ctx& X0, const P& p) {
    Ctx X = X0; X.tid = (int)threadIdx.x; asm volatile("" : "+v"(X.tid)); X.lane = X.tid & 63;
    LAS unsigned* cnt = (LAS unsigned*)X.lds;
    LAS unsigned* sc = cnt + 48;
    const int lane = X.lane, w = X.wave, tid = X.tid;
    for (int be = X.vcu; be < Bn * E; be += X.G) {
        const int b = be / E, e = be % E;
        const float* src = p.AFF + (size_t)be * S + 8 * tid;
        const f32x4 a0 = *(const GAS f32x4*)src, a1 = *(const GAS f32x4*)(src + 4);
        unsigned key[8];
#pragma unroll
        for (int i = 0; i < 4; ++i) { const float f0 = a0[i], f1 = a1[i]; key[i] = __float_as_uint(f0); key[4 + i] = __float_as_uint(f1); }
        unsigned prefix = 0u, need_k = (unsigned)CAP;
        __syncthreads();
        if (tid < 48) cnt[tid] = 0u;
        __syncthreads();
#pragma unroll 1
        for (int pass = 0; pass < 8; ++pass) {
            const int shift = 28 - 4 * pass; LAS unsigned* hist = cnt + (pass % 3) * 16;
            if (tid < 16) cnt[((pass + 1) % 3) * 16 + tid] = 0u;
#pragma unroll
            for (int i = 0; i < 8; ++i) { const bool match = (pass == 0) || ((key[i] >> (shift + 4)) == (prefix >> (shift + 4)));
                if (match) __hip_atomic_fetch_add(hist + ((key[i] >> shift) & 15u), 1u, __ATOMIC_RELAXED, __HIP_MEMORY_SCOPE_WORKGROUP); }
            __syncthreads();
            unsigned cum = 0u, dsel = 0u, below = 0u; bool found = false;
#pragma unroll
            for (int dgt = 15; dgt >= 0; --dgt) { const unsigned c = hist[dgt]; if (!found) { if (cum + c >= need_k) { dsel = (unsigned)dgt; below = cum; found = true; } else cum += c; } }
            prefix |= dsel << shift; need_k -= below;
        }
        const unsigned Tk = prefix;
        unsigned ngt = 0u, neq = 0u;
#pragma unroll
        for (int i = 0; i < 8; ++i) { ngt += key[i] > Tk; neq += key[i] == Tk; }
        unsigned sg = ngt, se = neq;
#pragma unroll
        for (int o = 1; o < 64; o <<= 1) { const unsigned tg = __shfl_up(sg, o), te = __shfl_up(se, o); if (lane >= o) { sg += tg; se += te; } }
        __syncthreads();
        if (lane == 63) { sc[w] = sg; sc[8 + w] = se; }
        __syncthreads();
        unsigned og = 0u, oe = 0u, totg = 0u;
#pragma unroll
        for (int i = 0; i < 8; ++i) { const unsigned g = sc[i], q = sc[8 + i]; if (i < w) { og += g; oe += q; } totg += g; }
        unsigned pg = og + sg - ngt, pe = oe + se - neq;
        const unsigned need = (unsigned)CAP - totg;
        unsigned iv[4] = {0u, 0u, 0u, 0u};
#pragma unroll
        for (int i = 0; i < 8; ++i) {
            const bool gt = key[i] > Tk, eq = key[i] == Tk; const int s = 8 * tid + i;
            const bool sel = gt || (eq && pe < need);
            const unsigned slot = pg + (pe < need ? pe : need);
            if (sel) { p.ROWL[(size_t)e * ME + b * CAP + slot] = b * S + s; p.WTS[(size_t)e * ME + b * CAP + slot] = __uint_as_float(key[i]); }
            iv[i >> 1] |= (sel ? (slot & 0xffffu) : 0xffffu) << (16 * (i & 1));
            pg += gt; pe += eq;
        }
        *(GAS u32x4*)(p.INV + (size_t)be * S + 8 * tid) = (u32x4){iv[0], iv[1], iv[2], iv[3]};
    }
    __syncthreads();
}

__device__ __forceinline__ void phase_final(const Ctx& X0, const P& p) {
    Ctx X = X0; X.tid = (int)threadIdx.x; asm volatile("" : "+v"(X.tid)); X.lane = X.tid & 63;
    const int lane = X.lane, RPW = T / X.G, base = X.vcu * RPW, b = base >> 12;
    f32x4 g2v[4], fgv[4];
#pragma unroll
    for (int j = 0; j < 4; ++j) { g2v[j] = *(const f32x4*)(p.MOD + (size_t)b * NMOD * D + 5 * D + 4 * lane + 256 * j) * (YB_F8 ? 1.f / epi::YB_SC : 1.f); fgv[j] = *(const f32x4*)(p.final_g + 4 * lane + 256 * j); }
    for (int i = X.wave; i < RPW; i += NWAVES) {
        const int m = base + i; float* hr = p.out + (size_t)m * D;
        f32x4 v[4];
#if H_DELTA
#pragma unroll
        for (int j = 0; j < 4; ++j) { const u32x2 dw = *(const GAS u32x2*)(p.DELTA + (size_t)m * D + 4 * lane + 256 * j);
            v[j] = *(const GAS f32x4*)(p.x + (size_t)m * D + 4 * lane + 256 * j) + (f32x4){bf_lo(dw.x), bf_hi(dw.x), bf_lo(dw.y), bf_hi(dw.y)}; }
#else
#pragma unroll
        for (int j = 0; j < 4; ++j) v[j] = *(const GAS f32x4*)(hr + 4 * lane + 256 * j);
#endif
        const int myslot = (lane < E) ? (int)p.INV[((size_t)(b * E + lane)) * S + (m & (S - 1))] : -1;
        f32x4 y[4];
#pragma unroll
        for (int q = 0; q < 4; ++q) y[q] = (f32x4){0.f, 0.f, 0.f, 0.f};
#pragma unroll
        for (int e = 0; e < E; ++e) { const int slot = __builtin_amdgcn_readlane(myslot, e);
            if (slot >= 0) { const size_t yo = ((size_t)e * ME + b * CAP + slot) * D;
#pragma unroll
                for (int j = 0; j < 4; ++j) {
                    if (YB_F8) { const unsigned wv = *(const GAS unsigned*)((const unsigned char*)p.YB + yo + 4 * lane + 256 * j);
                        const f32x2 lo2 = __builtin_amdgcn_cvt_pk_f32_fp8((int)wv, false), hi2 = __builtin_amdgcn_cvt_pk_f32_fp8((int)wv, true); y[j] += (f32x4){lo2[0], lo2[1], hi2[0], hi2[1]}; }
                    else { const u32x2 wv = *(const GAS u32x2*)(p.YB + yo + 4 * lane + 256 * j); y[j] += (f32x4){bf_lo(wv.x), bf_hi(wv.x), bf_lo(wv.y), bf_hi(wv.y)}; } } } }
        float ss = 0.f;
#pragma unroll
        for (int j = 0; j < 4; ++j) { const f32x4 tt = v[j] + g2v[j] * y[j]; v[j] = tt; ss += (tt[0] * tt[0] + tt[1] * tt[1]) + (tt[2] * tt[2] + tt[3] * tt[3]); }
        const float rstd = 1.f / sqrtf(wave_sum(ss) * (1.f / D) + 1e-6f);
#pragma unroll
        for (int j = 0; j < 4; ++j) *(GAS f32x4*)(hr + 4 * lane + 256 * j) = v[j] * rstd * fgv[j];
    }
}

constexpr size_t MiB = 1u << 20;
constexpr size_t WS_CTL = 0, CTL_ZERO_BYTES = 1 * MiB;
constexpr size_t WS_MOD = 1 * MiB, WS_AFF = 2 * MiB, WS_ROWL = 4 * MiB, WS_WTS = WS_ROWL + 256 * 1024, WS_INV = WS_WTS + 256 * 1024;
constexpr size_t WS_W2F = 6 * MiB, WS_WIN = 10 * MiB, WS_WCONV = 18 * MiB, WS_WFOUR = 19 * MiB, WS_WOUT = 21 * MiB;
constexpr size_t WS_WGU = 24 * MiB, WS_WDOWN = 152 * MiB, WS_U = 216 * MiB, WS_R1 = 280 * MiB, WS_END = 536 * MiB;
constexpr size_t WS_GP = WS_R1, WS_D256 = 23 * MiB, WS_YCONV = WS_R1, WS_V = WS_R1 + 64 * MiB, WS_FT = WS_R1 + 96 * MiB, WS_YFOUR = WS_R1 + 64 * MiB;
constexpr size_t WS_YRI = WS_R1 + 128 * MiB, WS_MERGED = WS_R1 + 128 * MiB, WS_ACONV = WS_R1 + 192 * MiB, WS_ACT = WS_R1 + 128 * MiB  , WS_YB = WS_WGU, WS_DELTA = WS_R1  ;
static_assert(MOE_F8 || !H_DELTA, "the workspace map places the 128 MiB fp8 ACT beside DELTA; a bf16 ACT (256 MiB) needs H_DELTA = 0");
constexpr int LDS_BYTES = 147456, RING_BYTES = 131072, MISC_OFF = RING_BYTES + 320;


#ifndef BARRIER_KIND
#define BARRIER_KIND 2
#endif
#define RLX_AGENT __ATOMIC_RELAXED, __HIP_MEMORY_SCOPE_AGENT
#define XB_TMO      128
#define XB_XCNT(j)  (256  + 64 * (j))
#define XB_XSUB(j)  (1280 + 64 * (j))
#define XB_XGEN(j)  (2304 + 64 * (j))
#define XB_TOP      3328
#define XB_TOPGEN   3392
#define XCD_BAR_WORDS 3456
#define XB_SPIN_CAP (1u << 18)
__device__ __forceinline__ unsigned xb_ld(unsigned* p)              { return __hip_atomic_load(p, __ATOMIC_RELAXED, __HIP_MEMORY_SCOPE_AGENT); }
__device__ __forceinline__ unsigned xb_add(unsigned* p, unsigned v) { return __hip_atomic_fetch_add(p, v, __ATOMIC_RELAXED, __HIP_MEMORY_SCOPE_AGENT); }
__device__ __forceinline__ unsigned xb_xcc_id() { return (unsigned)__builtin_amdgcn_s_getreg((3 << 11) | 20) & 0xFu; }
#define XB_SPIN(cond, bar) do { unsigned _sp = 0; while (cond) { __builtin_amdgcn_s_sleep(1); \
    if ((++_sp & 255u) == 0u) { if (xb_ld(&(bar)[XB_TMO])) break; if (_sp > XB_SPIN_CAP) { atomicAdd(&(bar)[XB_TMO], 1u); break; } } } } while (0)
struct XcdBarrier { unsigned* bar; unsigned x; volatile LAS unsigned* st; };
__device__ __forceinline__ XcdBarrier xcd_barrier_post(unsigned* bar, volatile LAS unsigned* st) {
    XcdBarrier b; b.bar = bar; b.x = xb_xcc_id(); b.st = st;
    if (threadIdx.x == 0) (void)xb_add(&bar[XB_XCNT(b.x)], 1u);
    return b;
}
__device__ __forceinline__ void xcd_barrier_complete(unsigned* bar, unsigned x, unsigned& nloc, unsigned& nx) {
    const unsigned G = gridDim.x * gridDim.y * gridDim.z;
    unsigned sum, cnt, mine, sp = 0u;
    for (;;) {
        sum = 0u; cnt = 0u; mine = 0u;
#pragma unroll
        for (unsigned j = 0; j < 16; ++j) { const unsigned c = xb_ld(&bar[XB_XCNT(j)]); sum += c; cnt += (c > 0u) ? 1u : 0u; mine = (j == x) ? c : mine; }
        if (sum == G) break;
        __builtin_amdgcn_s_sleep(1);
        if ((++sp & 255u) == 0u) { if (xb_ld(&bar[XB_TMO])) break; if (sp > XB_SPIN_CAP) { atomicAdd(&bar[XB_TMO], 1u); break; } }
    }
    nloc = mine > 0u ? mine : 1u; nx = cnt > 0u ? cnt : 1u;
}
__device__ __forceinline__ void xcd_barrier(const XcdBarrier& b) {
    asm volatile("s_waitcnt vmcnt(0)" ::: "memory");
    __syncthreads();
    if (threadIdx.x == 0) {
        unsigned* bar = b.bar;
        __builtin_amdgcn_s_waitcnt(0);
        unsigned nloc = b.st[0], nx = b.st[1];
        if (nloc == 0u) { xcd_barrier_complete(bar, b.x, nloc, nx); b.st[0] = nloc; b.st[1] = nx; }
        const unsigned old = xb_add(&bar[XB_XSUB(b.x)], 1u);
        const unsigned gen = old / nloc;
        if (old + 1u == (gen + 1u) * nloc) {
            __builtin_amdgcn_fence(__ATOMIC_RELEASE, "agent");
            asm volatile("s_waitcnt vmcnt(0)" ::: "memory");
            const unsigned og = xb_add(&bar[XB_TOP], 1u);
            const unsigned tg = og / nx;
            if (og + 1u == (tg + 1u) * nx) xb_add(&bar[XB_TOPGEN], 1u);
            else XB_SPIN(xb_ld(&bar[XB_TOPGEN]) == tg, bar);
            __builtin_amdgcn_fence(__ATOMIC_ACQUIRE, "agent");
            xb_add(&bar[XB_XGEN(b.x)], 1u);
            asm volatile("s_waitcnt vmcnt(0)" ::: "memory");
        } else {
            XB_SPIN(xb_ld(&bar[XB_XGEN(b.x)]) == gen, bar);
            __builtin_amdgcn_fence(__ATOMIC_ACQUIRE, "agent");
            asm volatile("s_waitcnt vmcnt(0)" ::: "memory");
        }
    }
    __syncthreads();
}
constexpr int CW_BAR = 4096;

struct Args { P p; unsigned* ctl; int ph_lo, ph_hi; };

__global__ void __launch_bounds__(NTHR, 2) mk_fwd(Args args) {
    extern __shared__ __attribute__((aligned(16))) unsigned char lds_raw[];
    Ctx X; X.lds = (LAS unsigned char*)lds_raw; X.tid = threadIdx.x; X.lane = X.tid & 63; X.wave = __builtin_amdgcn_readfirstlane(X.tid >> 6);
    X.G = gridDim.x; { const int bx = blockIdx.x; X.vcu = (X.G % 8 == 0) ? (bx % 8) * (X.G / 8) + bx / 8 : bx; }
    const P& p = args.p; const int lo = args.ph_lo, hi = args.ph_hi;
    const int cid = (int)blockIdx.x;
#define IN(k) (lo <= (k) && (k) < hi)
    for (int u = X.tid; u < (LDS_BYTES - RING_BYTES) / 4; u += NTHR) ((LAS unsigned*)(X.lds + RING_BYTES))[u] = 0u;
    __syncthreads();
#if BARRIER_KIND == 1
    cooperative_groups::grid_group cgrid = cooperative_groups::this_grid();
#define GRID_BAR() do { if (hi - lo > 1) cgrid.sync(); } while (0)
#else
    XcdBarrier xbar = xcd_barrier_post(args.ctl + CW_BAR, (volatile LAS unsigned*)(X.lds + MISC_OFF));
#define GRID_BAR() do { if (hi - lo > 1) xcd_barrier(xbar); } while (0)
#endif
#ifdef PROBE_A
    volatile unsigned long long* ts = (volatile unsigned long long*)(args.ctl + 65536);
    int n_stamp = 0;
#define STAMP() do { if (blockIdx.x == 0 && X.tid == 0) ts[n_stamp] = __builtin_amdgcn_s_memrealtime(); ++n_stamp; } while (0)
#else
#define STAMP() do { } while (0)
#endif
    STAMP();
    if (IN(0)) { phase_p0a(X, p); GRID_BAR(); STAMP(); }
    if (IN(1)) { phase_p0b(X, p); GRID_BAR(); STAMP(); }
    if (IN(2)) {
        { pg8::SchedDense Sd; Sd.init(p.U, p.Wt_in, T, 2 * CW, D, X.G, cid); epi::EpiGlu Ep{p.V, p.b_in};
          pg8::gemm_phase<epi::EpiGlu, pg8::SchedDense, false>(X.lds, 2 * D, Sd, Ep); }
        { pg8::SchedDense Sd; Sd.init(p.Wt_in + (size_t)(2 * CW) * D, p.U, FW, T, D, X.G, cid); epi::EpiFT Ep{p.FT, p.b_in + 2 * CW};
          pg8::gemm_phase<epi::EpiFT, pg8::SchedDense, false>(X.lds, 2 * D, Sd, Ep); }
        GRID_BAR(); STAMP();
    }
    if (IN(3)) {
        phase_conv(X, p);
        phase_fftA(X, p);
        GRID_BAR(); STAMP();
        { pg8::SchedDense Sd; Sd.init(p.D256, p.GP, 512, Bn * 16 * FW, 512, X.G, cid); epi::EpiFFT Ep{p.YRI};
          pg8::gemm_phase<epi::EpiFFT, pg8::SchedDense, false>(X.lds, 2 * 512, Sd, Ep); }
        GRID_BAR(); STAMP();
    }
    if (IN(4)) {
        { pg8::SchedDense Sd; Sd.init(p.ACONV, p.Wt_conv, T, D, CW, X.G, cid); epi::EpiBias Ep{p.YCONV, D, p.cb_out};
          pg8::gemm_phase<epi::EpiBias, pg8::SchedDense, false>(X.lds, 2 * CW, Sd, Ep); }
        { pg8::SchedDense Sd; Sd.init(p.YRI, p.Wt_four, T, D, 2 * FW, X.G, cid); epi::EpiBias Ep{p.YFOUR, D, p.four_b};
          pg8::gemm_phase<epi::EpiBias, pg8::SchedDense, false>(X.lds, 4 * FW, Sd, Ep); }
        GRID_BAR(); STAMP();
    }
    if (IN(5)) {
        pg8::SchedDense Sd; Sd.init(p.U, p.Wt_in + (size_t)(2 * CW + FW) * D, T, 2 * D, D, X.G, cid); epi::EpiMerge Ep{p.MERGED, p.YCONV, p.YFOUR, p.b_in};
        pg8::gemm_phase<epi::EpiMerge, pg8::SchedDense, false>(X.lds, 2 * D, Sd, Ep);
        GRID_BAR(); STAMP();
    }
    if (IN(6)) {
        pg8::SchedDense Sd; Sd.init(p.MERGED, p.Wt_out, T, D, D, X.G, cid);
#if H_DELTA
        epi::EpiDelta Ep{p.DELTA, p.MOD + 2 * D, p.b_out};
        pg8::gemm_phase<epi::EpiDelta, pg8::SchedDense, false>(X.lds, 2 * D, Sd, Ep);
#else
        epi::EpiResid Ep{p.x, p.out, p.MOD + 2 * D, p.b_out};
        pg8::gemm_phase<epi::EpiResid, pg8::SchedDense, false>(X.lds, 2 * D, Sd, Ep);
#endif
        GRID_BAR(); STAMP();
    }
    if (IN(7)) { phase_router(X, p, H_DELTA ? p.x : p.out); GRID_BAR(); STAMP(); }
    if (IN(8)) { phase_topk(X, p); GRID_BAR(); STAMP(); }
    if (IN(9)) {
        constexpr int esz = MOE_F8 ? 1 : 2;
        pg8::SchedG1 Sd{(const char*)p.U, (const char*)p.Wt_gu, p.ROWL, X.G, cid, esz}; epi::EpiSwiglu<MOE_F8 != 0> Ep{p.ACT};
        pg8::gemm_phase<epi::EpiSwiglu<MOE_F8 != 0>, pg8::SchedG1, true, MOE_F8 != 0>(X.lds, D * esz, Sd, Ep, epi::MX_W, epi::MX_U);
        GRID_BAR(); STAMP();
    }
    if (IN(10)) {
        constexpr int esz = MOE_F8 ? 1 : 2;
        pg8::SchedG2 Sd{(const char*)p.ACT, (const char*)p.Wt_down, X.G, cid, esz}; epi::EpiScaleW Ep{p.YB, p.WTS};
        pg8::gemm_phase<epi::EpiScaleW, pg8::SchedG2, false, MOE_F8 != 0>(X.lds, F * esz, Sd, Ep, epi::MX_W, epi::MX_ACT);
        GRID_BAR(); STAMP();
    }
    if (IN(11)) { phase_final(X, p); }
#ifdef PROBE_A
    STAMP();
    if (blockIdx.x == 0 && X.tid == 0) { const unsigned long long dt = (ts[PROBE_B] - ts[PROBE_A]) * PROBE_AMP, t0 = __builtin_amdgcn_s_memrealtime();
        while (__builtin_amdgcn_s_memrealtime() - t0 < dt) __builtin_amdgcn_s_sleep(8); }
#endif
#undef IN
}

extern "C" void kernel_launch(void* const* d_in, const int* in_sizes, int n_in, void* d_out, int out_size, void* d_ws, size_t ws_size, hipStream_t stream) {
    static int grid = 0;
    if (grid == 0) {
        if (n_in != 23 || in_sizes[0] != T * D || out_size != T * D || ws_size < WS_END) { fprintf(stderr, "kernel_launch: unexpected shapes / workspace (%d inputs, ws %zu)\n", n_in, ws_size); grid = -1; return; }
        int dev = 0, cus = 0;
        if (hipGetDevice(&dev) != hipSuccess || hipDeviceGetAttribute(&cus, hipDeviceAttributeMultiprocessorCount, dev) != hipSuccess) { grid = -1; return; }
        if (hipFuncSetAttribute((const void*)mk_fwd, hipFuncAttributeMaxDynamicSharedMemorySize, LDS_BYTES) != hipSuccess) { fprintf(stderr, "kernel_launch: hipFuncSetAttribute failed\n"); grid = -1; return; }
        if (cus < 256) { fprintf(stderr, "kernel_launch: built for a 256-CU device (one workgroup per CU), found %d CUs\n", cus); grid = -1; return; }
        int per_cu = 0;
        if (hipOccupancyMaxActiveBlocksPerMultiprocessor(&per_cu, (const void*)mk_fwd, NTHR, LDS_BYTES) != hipSuccess || per_cu < 1) { fprintf(stderr, "kernel_launch: occupancy query reports %d workgroups per CU\n", per_cu); grid = -1; return; }
        grid = 256;
    }
    if (grid < 0) return;
    unsigned char* ws = (unsigned char*)d_ws;
    Args a{};
    P& p = a.p;
    p.x = (const float*)d_in[0]; p.c = (const float*)d_in[1]; p.ada_w = (const float*)d_in[2]; p.ada_b = (const float*)d_in[3]; p.norm1_g = (const float*)d_in[4];
    p.w_in = (const float*)d_in[5]; p.b_in = (const float*)d_in[6]; p.dw_w = (const float*)d_in[7]; p.dw_b = (const float*)d_in[8]; p.cln_g = (const float*)d_in[9]; p.cln_b = (const float*)d_in[10];
    p.cw_out = (const float*)d_in[11]; p.cb_out = (const float*)d_in[12]; p.four_w = (const float*)d_in[13]; p.four_b = (const float*)d_in[14]; p.w_out = (const float*)d_in[15]; p.b_out = (const float*)d_in[16];
    p.norm2_g = (const float*)d_in[17]; p.router_w = (const float*)d_in[18]; p.w_gate = (const float*)d_in[19]; p.w_up = (const float*)d_in[20]; p.w_down = (const float*)d_in[21]; p.final_g = (const float*)d_in[22];
    p.out = (float*)d_out;
    p.MOD = (float*)(ws + WS_MOD); p.W2F = (float*)(ws + WS_W2F); p.AFF = (float*)(ws + WS_AFF); p.ROWL = (int*)(ws + WS_ROWL); p.WTS = (float*)(ws + WS_WTS); p.INV = (short*)(ws + WS_INV);
    p.Wt_in = (bf16_t*)(ws + WS_WIN); p.Wt_conv = (bf16_t*)(ws + WS_WCONV); p.Wt_four = (bf16_t*)(ws + WS_WFOUR); p.Wt_out = (bf16_t*)(ws + WS_WOUT);
    p.D256 = (bf16_t*)(ws + WS_D256); p.GP = (bf16_t*)(ws + WS_GP); p.Wt_gu = (bf16_t*)(ws + WS_WGU); p.Wt_down = (bf16_t*)(ws + WS_WDOWN);
    p.U = (bf16_t*)(ws + WS_U); p.V = (bf16_t*)(ws + WS_V); p.FT = (bf16_t*)(ws + WS_FT); p.ACONV = (bf16_t*)(ws + WS_ACONV); p.YRI = (bf16_t*)(ws + WS_YRI);
    p.YCONV = (bf16_t*)(ws + WS_YCONV); p.YFOUR = (bf16_t*)(ws + WS_YFOUR); p.MERGED = (bf16_t*)(ws + WS_MERGED); p.ACT = (bf16_t*)(ws + WS_ACT); p.YB = (bf16_t*)(ws + WS_YB); p.DELTA = (bf16_t*)(ws + WS_DELTA);
    (void)hipMemsetAsync(ws + WS_CTL, 0, CTL_ZERO_BYTES, stream);
    a.ctl = (unsigned*)(ws + WS_CTL);
    a.ph_lo = 0; a.ph_hi = 12;
#ifndef PLAIN_LAUNCH
#define PLAIN_LAUNCH 0
#endif
#if PLAIN_LAUNCH
    hipLaunchKernelGGL(mk_fwd, dim3(grid), dim3(NTHR), LDS_BYTES, stream, a);
#else
    { void* kargs[] = {&a}; hipError_t le = hipLaunchCooperativeKernel((const void*)mk_fwd, dim3(grid), dim3(NTHR), kargs, LDS_BYTES, stream);
      if (le != hipSuccess) fprintf(stderr, "kernel_launch: cooperative launch failed: %s\n", hipGetErrorString(le)); }
#endif
}
```

```cpp
#include <hip/hip_runtime.h>
#include <hip/hip_cooperative_groups.h>
#include <cstdio>
#include <cstdint>

#define LAS __attribute__((address_space(3)))
#define GAS __attribute__((address_space(1)))
typedef unsigned short bf16_t;
typedef short bf16x8 __attribute__((ext_vector_type(8)));
typedef float f32x4 __attribute__((ext_vector_type(4)));
typedef float f32x2 __attribute__((ext_vector_type(2)));
typedef unsigned u32x4 __attribute__((ext_vector_type(4)));
typedef unsigned u32x2 __attribute__((ext_vector_type(2)));
typedef int i32x8 __attribute__((ext_vector_type(8)));

constexpr int Bn = 8, S = 4096, D = 1024, T = Bn * S;
constexpr int CW = 512, CK = 31, FW = 512, FG = 4, FGD = 128;
constexpr int INC = 2 * CW + FW + 2 * D;
constexpr int E = 16, CAP = 2 * S / E;
constexpr int F = 2 * D;
constexpr int NMOD = 6;
constexpr int ME = Bn * CAP;
constexpr int NWAVES = 8, NTHR = 512;

__device__ __forceinline__ float sigmoidf_(float x) { return __builtin_amdgcn_rcpf(1.f + __expf(-x)); }
__device__ __forceinline__ float siluf_(float x) { return x * __builtin_amdgcn_rcpf(1.f + __expf(-x)); }
__device__ __forceinline__ unsigned f2bf(float f) { unsigned u = __builtin_bit_cast(unsigned, f); return (u + 0x7fffu + ((u >> 16) & 1u)) >> 16; }
__device__ __forceinline__ unsigned pk2(float lo, float hi) { return f2bf(lo) | (f2bf(hi) << 16); }
__device__ __forceinline__ unsigned cvt_pk_bf16(float lo, float hi) { unsigned r; asm volatile("v_cvt_pk_bf16_f32 %0, %1, %2" : "=v"(r) : "v"(lo), "v"(hi)); return r; }
__device__ __forceinline__ float bf_lo(unsigned w) { return __builtin_bit_cast(float, w << 16); }
__device__ __forceinline__ float bf_hi(unsigned w) { return __builtin_bit_cast(float, w & 0xffff0000u); }
__device__ __forceinline__ float wave_sum(float v) {
#pragma unroll
    for (int o = 1; o < 64; o <<= 1) v += __shfl_xor(v, o);
    return v;
}
__device__ __forceinline__ u32x2 pack8_f8(const f32x4 v0, const f32x4 v1, const float sc) {
    unsigned a = 0u, b = 0u;
    a = __builtin_amdgcn_cvt_pk_fp8_f32(v0[0] * sc, v0[1] * sc, a, false); a = __builtin_amdgcn_cvt_pk_fp8_f32(v0[2] * sc, v0[3] * sc, a, true);
    b = __builtin_amdgcn_cvt_pk_fp8_f32(v1[0] * sc, v1[1] * sc, b, false); b = __builtin_amdgcn_cvt_pk_fp8_f32(v1[2] * sc, v1[3] * sc, b, true);
    return (u32x2){a, b};
}
#define LDS_WAIT() asm volatile("s_waitcnt lgkmcnt(0)" ::: "memory")
#define VM_WAIT() asm volatile("s_waitcnt vmcnt(0)" ::: "memory")

namespace pg8 {
constexpr int BM = 256, BK = 64, HALF = 128, HTB = HALF * BK * 2  , STAGE_BYTES = 8 * HTB, NXCD = 8, WGM = 8;
__host__ __device__ __forceinline__ int lds_byte(int r, int c) { const int st = (r >> 4) * 2 + (c >> 5), rr = r & 15, cc = c & 31, ob = rr * 64 + cc * 2; return st * 1024 + (ob ^ (((ob >> 9) & 1) << 5)); }
__host__ __device__ __forceinline__ void stage_rc(int b, int& R, int& C) { const int st = b / 1024, sb = b % 1024, swz = sb ^ (((sb >> 9) & 1) << 5); R = (st >> 1) * 16 + swz / 64; C = (st & 1) * 32 + (swz % 64) / 2; }
__host__ __device__ __forceinline__ int f8_off(int r, int fq) { const int rr = r & 15; return ((r >> 4) * 2 + (fq >> 1)) * 1024 + ((rr * 64 + 32 * (fq & 1)) ^ ((rr >> 3) << 5)); }
__host__ __device__ __forceinline__ int perm32(int rho) { const int n = rho >> 4, i = rho & 15; return 8 * (i >> 2) + 4 * n + (i & 3); }

struct Unit { const char* a; const char* b; const int* rows; int pm, pn, e; };

template <class Epi, class Sched, bool GATHER, bool F8 = false>
__device__ __forceinline__ void gemm_phase(LAS unsigned char* lds, const int KB, const Sched& S, const Epi& E, const int sw = 0x7f7f7f7f, const int sx = 0x7f7f7f7f) {
    int tid_ = threadIdx.x; asm volatile("" : "+v"(tid_));
    const int tid = tid_, wid = __builtin_amdgcn_readfirstlane(tid >> 6), lane = tid & 63, wr = wid >> 2, wc = wid & 3, fr = lane & 15, fq = lane >> 4;
    const int nt = KB / (BK * 2);
    int swv = sw, sxv = sx; if constexpr (F8) { asm volatile("" : "+v"(swv), "+v"(sxv)); }
    unsigned voffA[2], voffB[2]; int R0, C0;
#pragma unroll
    for (int i = 0; i < 2; ++i) { int R, C; stage_rc(tid * 16 + i * 8192, R, C); const int Rb = Epi::PERM ? ((R & ~31) + perm32(R & 31)) : R;
        voffA[i] = (unsigned)(R * KB + C * 2); voffB[i] = (unsigned)(Rb * KB + C * 2); if (i == 0) { R0 = R; C0 = C; } }
    const size_t kstep = (size_t)(BK * 2);
    const size_t hstep = (size_t)HALF * KB;
    const unsigned ldsw = (unsigned)wid * 1024u;
    const int aoff = lds_byte(wr * 64 + fr, fq * 8), boff = lds_byte(wc * 32 + fr, fq * 8);
#define PG8_SA(b, h) (((b) * 2 + (h)) * HTB)
#define PG8_SB(b, h) ((4 + (b) * 2 + (h)) * HTB)
#define PG8_STAGE(bufoff, gbase, voff) do { _Pragma("unroll") for (int _i = 0; _i < 2; ++_i) \
        __builtin_amdgcn_global_load_lds((const unsigned*)((const char*)(gbase) + (voff)[_i]), (LAS unsigned*)(lds + (bufoff) + ldsw + _i * 8192), 16, 0, 0); } while (0)
#define PG8_STGA(bufoff, p, h, v) do { if constexpr (GATHER) { PG8_STAGE(bufoff, p, (v) + 2 * (h)); } else { PG8_STAGE(bufoff, (p) + (h) * hstep, voffA); } } while (0)
#define PG8_LD8(p) __builtin_bit_cast(i32x8, __builtin_shufflevector(*(const LAS u32x4*)(p), *(const LAS u32x4*)((p) + 1024), 0, 1, 2, 3, 4, 5, 6, 7))
#define PG8_LDA(dst, b, h) do { if constexpr (F8) { _Pragma("unroll") for (int m = 0; m < 4; ++m) dst##8[m] = PG8_LD8(lds + PG8_SA(b, h) + aoff + m * 2048); } \
      else { _Pragma("unroll") for (int m = 0; m < 4; ++m) _Pragma("unroll") for (int k = 0; k < 2; ++k) dst[m][k] = *(const LAS bf16x8*)(lds + PG8_SA(b, h) + aoff + m * 2048 + k * 1024); } } while (0)
#define PG8_LDB(dst, b, h) do { if constexpr (F8) { _Pragma("unroll") for (int n = 0; n < 2; ++n) dst##8[n] = PG8_LD8(lds + PG8_SB(b, h) + boff + n * 2048); } \
      else { _Pragma("unroll") for (int n = 0; n < 2; ++n) _Pragma("unroll") for (int k = 0; k < 2; ++k) dst[n][k] = *(const LAS bf16x8*)(lds + PG8_SB(b, h) + boff + n * 2048 + k * 1024); } } while (0)
#define PG8_MMA(ai, bj, At, Bt) do { __builtin_amdgcn_s_setprio(1); if constexpr (F8) { _Pragma("unroll") for (int m = 0; m < 4; ++m) _Pragma("unroll") for (int n = 0; n < 2; ++n) \
        asm volatile("v_mfma_scale_f32_16x16x128_f8f6f4 %0, %1, %2, %0, %3, %4 op_sel_hi:[0,0,0]" : "+v"(acc[ai][bj][m][n]) : "v"(Bt##8[n]), "v"(At##8[m]), "v"(swv), "v"(sxv)); } \
      else { _Pragma("unroll") for (int m = 0; m < 4; ++m) _Pragma("unroll") for (int n = 0; n < 2; ++n) _Pragma("unroll") for (int k = 0; k < 2; ++k) \
        acc[ai][bj][m][n] = __builtin_amdgcn_mfma_f32_16x16x32_bf16(Bt[n][k], At[m][k], acc[ai][bj][m][n], 0, 0, 0); } __builtin_amdgcn_s_setprio(0); } while (0)
#define PG8_WAIT_V(n) asm volatile("s_waitcnt vmcnt(" #n ")" ::: "memory")
#define PG8_WAIT_L(n) asm volatile("s_waitcnt lgkmcnt(" #n ")" ::: "memory")
#define PG8_BAR __builtin_amdgcn_s_barrier()
#define PG8_SCHED __builtin_amdgcn_sched_barrier(0)
#define PG8_ROWS(u, v) do { if constexpr (GATHER) { _Pragma("unroll") for (int _h = 0; _h < 2; ++_h) _Pragma("unroll") for (int _i = 0; _i < 2; ++_i) \
        v[_h * 2 + _i] = (unsigned)((u).rows[_h * 128 + R0 + 64 * _i] * KB + C0 * 2); } } while (0)
    Unit cur, nxt; int ui = 0;
    if (!S.next(0, cur)) return;
    f32x4 acc[2][2][4][2];
#pragma unroll
    for (int a = 0; a < 2; ++a)
#pragma unroll
        for (int b = 0; b < 2; ++b)
#pragma unroll
            for (int m = 0; m < 4; ++m)
#pragma unroll
                for (int n = 0; n < 2; ++n) acc[a][b][m][n] = (f32x4){0.f, 0.f, 0.f, 0.f};
    bf16x8 At[4][2], B0[2][2], B1[2][2]; i32x8 At8[4], B08[2], B18[2];
    unsigned vAc[4] = {0u, 0u, 0u, 0u}, vAn[4] = {0u, 0u, 0u, 0u}, vW[4] = {0u, 0u, 0u, 0u};
    PG8_ROWS(cur, vAc);
    const char* cA = cur.a; const char* cB = cur.b;
    PG8_STAGE(PG8_SB(0, 0), cB, voffB); PG8_STAGE(PG8_SB(0, 1), cB + hstep, voffB); PG8_STGA(PG8_SA(0, 0), cA, 0, vAc); PG8_STGA(PG8_SA(0, 1), cA, 1, vAc);
    if (wr == 1) PG8_BAR;
    PG8_WAIT_V(2); PG8_BAR;
    PG8_STAGE(PG8_SB(1, 0), cB + kstep, voffB); PG8_STGA(PG8_SA(1, 0), cA + kstep, 0, vAc); PG8_STAGE(PG8_SB(1, 1), cB + hstep + kstep, voffB);
    PG8_WAIT_V(6); PG8_BAR;
    for (;;) {
        const bool has_next = S.next(ui + 1, nxt);
        if (has_next) { PG8_ROWS(nxt, vAn); } else {
#pragma unroll
            for (int j = 0; j < 4; ++j) vAn[j] = vAc[j]; }
        const char* nA = has_next ? nxt.a : cA; const char* nB = has_next ? nxt.b : cB;
        for (int t = 0; t < nt; t += 2) {
            const bool last = (t == nt - 2);
            const char* a1 = cA + (size_t)(t + 1) * kstep;
            const char* a2 = last ? nA : cA + (size_t)(t + 2) * kstep; const char* b2 = last ? nB : cB + (size_t)(t + 2) * kstep;
            const char* a3 = a2 + kstep; const char* b3 = b2 + kstep;
            if constexpr (GATHER) {
                if (last) { asm volatile("" ::: "memory");
#pragma unroll
                    for (int j = 0; j < 4; ++j) vW[j] = vAn[j]; }
                else {
#pragma unroll
                    for (int j = 0; j < 4; ++j) vW[j] = vAc[j]; } }
            PG8_LDB(B0, 0, 0); PG8_LDB(B1, 0, 1); PG8_SCHED; PG8_LDA(At, 0, 0); PG8_STGA(PG8_SA(1, 1), a1, 1, vAc);
            PG8_WAIT_V(8); PG8_WAIT_L(0); PG8_BAR; PG8_MMA(0, 0, At, B0); PG8_MMA(0, 1, At, B1); PG8_BAR; PG8_SCHED;
            PG8_LDA(At, 0, 1); PG8_STAGE(PG8_SB(0, 0), b2, voffB); PG8_STAGE(PG8_SB(0, 1), b2 + hstep, voffB); PG8_STGA(PG8_SA(0, 0), a2, 0, vW);
            PG8_WAIT_V(8); PG8_WAIT_L(0); PG8_BAR; PG8_MMA(1, 0, At, B0); PG8_MMA(1, 1, At, B1); PG8_BAR; PG8_SCHED;
            PG8_LDB(B0, 1, 0); PG8_LDB(B1, 1, 1); PG8_SCHED; PG8_LDA(At, 1, 0); PG8_STGA(PG8_SA(0, 1), a2, 1, vW);
            PG8_WAIT_V(8); PG8_WAIT_L(0); PG8_BAR; PG8_MMA(0, 0, At, B0); PG8_MMA(0, 1, At, B1); PG8_BAR; PG8_SCHED;
            PG8_LDA(At, 1, 1); PG8_STAGE(PG8_SB(1, 0), b3, voffB); PG8_STAGE(PG8_SB(1, 1), b3 + hstep, voffB); PG8_STGA(PG8_SA(1, 0), a3, 0, vW);
            PG8_WAIT_V(8); PG8_WAIT_L(0); PG8_BAR; PG8_MMA(1, 0, At, B0); PG8_MMA(1, 1, At, B1); PG8_BAR; PG8_SCHED;
        }
        if (wr == 0) PG8_BAR;
        if constexpr (F8) { asm volatile("s_nop 15\n\ts_nop 15" ::: "memory"); }
        E(acc, cur, wr, wc, fr, fq);
        if (!has_next) break;
#pragma unroll
        for (int a = 0; a < 2; ++a)
#pragma unroll
            for (int b = 0; b < 2; ++b)
#pragma unroll
                for (int m = 0; m < 4; ++m)
#pragma unroll
                    for (int n = 0; n < 2; ++n) acc[a][b][m][n] = (f32x4){0.f, 0.f, 0.f, 0.f};
        cur = nxt; cA = nA; cB = nB; ++ui;
#pragma unroll
        for (int j = 0; j < 4; ++j) vAc[j] = vAn[j];
        if (wr == 1) PG8_BAR;
    }
    PG8_WAIT_V(0);
    PG8_BAR;
#undef PG8_SA
#undef PG8_SB
#undef PG8_STAGE
#undef PG8_STGA
#undef PG8_LDA
#undef PG8_LDB
#undef PG8_MMA
#undef PG8_LD8
#undef PG8_WAIT_V
#undef PG8_WAIT_L
#undef PG8_BAR
#undef PG8_SCHED
#undef PG8_ROWS
}

struct SchedDense {
    const char* A; const char* Bt; int nM, nN, nwg, G, c; size_t tstep;
    __device__ void init(const void* A_, const void* Bt_, int M, int N, int K, int G_, int c_) { A = (const char*)A_; Bt = (const char*)Bt_; nM = M / BM; nN = N / BM; nwg = nM * nN; G = G_; c = c_; tstep = (size_t)BM * K * 2; }
    __device__ bool next(int i, Unit& u) const {
        const long L = (long)i * G + c; if (L >= nwg) return false;
        int wgid = (int)L; { const int q = nwg / NXCD, r = nwg % NXCD, xcd = wgid % NXCD, off = wgid / NXCD; wgid = (xcd < r ? xcd * (q + 1) : r * (q + 1) + (xcd - r) * q) + off; }
        const int nig = WGM * nN, gid = wgid / nig, fm = gid * WGM, gsz = (nM - fm) < WGM ? (nM - fm) : WGM;
        u.pm = fm + ((wgid % nig) % gsz); u.pn = (wgid % nig) / gsz; u.e = 0; u.rows = nullptr;
        u.a = A + (size_t)u.pm * tstep; u.b = Bt + (size_t)u.pn * tstep; return true;
    }
};
}

#ifndef H_DELTA
#define H_DELTA 1
#endif
#ifndef YB_F8
#define YB_F8 1
#endif
#ifndef MOE_F8
#define MOE_F8 1
#endif

namespace epi {
using pg8::Unit;
#define EPI_ROWS(ai, m) (128 * (ai) + 64 * wr + 16 * (m) + fr)
__device__ __forceinline__ u32x4 pack8(const f32x4 v0, const f32x4 v1) { u32x4 w; w.x = cvt_pk_bf16(v0[0], v0[1]); w.y = cvt_pk_bf16(v0[2], v0[3]); w.z = cvt_pk_bf16(v1[0], v1[1]); w.w = cvt_pk_bf16(v1[2], v1[3]); return w; }
__device__ __forceinline__ f32x4 sig4(const f32x4 v) { return (f32x4){sigmoidf_(v[0]), sigmoidf_(v[1]), sigmoidf_(v[2]), sigmoidf_(v[3])}; }
__device__ __forceinline__ f32x4 silu4(const f32x4 v) { return (f32x4){siluf_(v[0]), siluf_(v[1]), siluf_(v[2]), siluf_(v[3])}; }
__device__ __forceinline__ void unpack8(const u32x4 w, f32x4& v0, f32x4& v1) { v0 = (f32x4){bf_lo(w.x), bf_hi(w.x), bf_lo(w.y), bf_hi(w.y)}; v1 = (f32x4){bf_lo(w.z), bf_hi(w.z), bf_lo(w.w), bf_hi(w.w)}; }

struct EpiGlu {
    static constexpr bool PERM = true;
    bf16_t* V; const float* bias;
    __device__ __forceinline__ void operator()(const f32x4 (&acc)[2][2][4][2], const Unit& u, int wr, int wc, int fr, int fq) const {
        const int ch = u.pn * 128 + wc * 32 + 8 * fq;
        f32x4 ba[2], bg[2];
#pragma unroll
        for (int n = 0; n < 2; ++n) { ba[n] = *(const f32x4*)(bias + ch + 4 * n); bg[n] = *(const f32x4*)(bias + CW + ch + 4 * n); }
#pragma unroll
        for (int ai = 0; ai < 2; ++ai)
#pragma unroll
            for (int m = 0; m < 4; ++m) { const size_t row = (size_t)u.pm * 256 + EPI_ROWS(ai, m);
                const f32x4 v0 = (acc[ai][0][m][0] + ba[0]) * sig4(acc[ai][1][m][0] + bg[0]), v1 = (acc[ai][0][m][1] + ba[1]) * sig4(acc[ai][1][m][1] + bg[1]);
                *(u32x4*)(V + row * CW + ch) = pack8(v0, v1); }
    }
};
struct EpiFT {
    static constexpr bool PERM = true;
    bf16_t* FT; const float* bias;
    __device__ __forceinline__ void operator()(const f32x4 (&acc)[2][2][4][2], const Unit& u, int wr, int wc, int fr, int fq) const {
#pragma unroll
        for (int ai = 0; ai < 2; ++ai)
#pragma unroll
            for (int m = 0; m < 4; ++m) { const int ch = u.pm * 256 + EPI_ROWS(ai, m); const float bv = bias[ch];
#pragma unroll
                for (int bj = 0; bj < 2; ++bj) { const int tok = u.pn * 256 + bj * 128 + wc * 32 + 8 * fq; const int b = tok >> 12, s = tok & (S - 1);
                    *(u32x4*)(FT + ((size_t)(b * FW + ch) * S + s)) = pack8(acc[ai][bj][m][0] + bv, acc[ai][bj][m][1] + bv); } }
    }
};
struct EpiFFT {
    static constexpr bool PERM = true;
    bf16_t* YRI;
    __device__ __forceinline__ void operator()(const f32x4 (&acc)[2][2][4][2], const Unit& u, int wr, int wc, int fr, int fq) const {
        const int part = u.pm, chb = u.pn & 1, k2 = (u.pn >> 1) & 15, b = u.pn >> 5;
#pragma unroll
        for (int ai = 0; ai < 2; ++ai)
#pragma unroll
            for (int m = 0; m < 4; ++m) { const int k1 = EPI_ROWS(ai, m);
                bf16_t* rowp = YRI + ((size_t)(b * S + 16 * k1 + k2) * (2 * FW) + part * FW + chb * 256 + wc * 32 + 8 * fq);
#pragma unroll
                for (int bj = 0; bj < 2; ++bj) *(u32x4*)(rowp + bj * 128) = pack8(acc[ai][bj][m][0], acc[ai][bj][m][1]); }
    }
};
struct EpiBias {
    static constexpr bool PERM = true;
    bf16_t* O; int ldc; const float* bias;
    __device__ __forceinline__ void operator()(const f32x4 (&acc)[2][2][4][2], const Unit& u, int wr, int wc, int fr, int fq) const {
        const int col0 = u.pn * 256 + wc * 32 + 8 * fq;
        f32x4 bv[2][2];
#pragma unroll
        for (int bj = 0; bj < 2; ++bj)
#pragma unroll
            for (int n = 0; n < 2; ++n) bv[bj][n] = *(const f32x4*)(bias + col0 + bj * 128 + 4 * n);
#pragma unroll
        for (int ai = 0; ai < 2; ++ai)
#pragma unroll
            for (int m = 0; m < 4; ++m) { bf16_t* rowp = O + ((size_t)u.pm * 256 + EPI_ROWS(ai, m)) * ldc + col0;
#pragma unroll
                for (int bj = 0; bj < 2; ++bj) *(u32x4*)(rowp + bj * 128) = pack8(acc[ai][bj][m][0] + bv[bj][0], acc[ai][bj][m][1] + bv[bj][1]); }
    }
};
struct EpiMerge {
    static constexpr bool PERM = true;
    bf16_t* MG; const bf16_t* YC; const bf16_t* YF; const float* bias;
    __device__ __forceinline__ void operator()(const f32x4 (&acc)[2][2][4][2], const Unit& u, int wr, int wc, int fr, int fq) const {
        const int nn = u.pn * 128 + wc * 32 + 8 * fq;
        f32x4 b0[2], b1[2];
#pragma unroll
        for (int n = 0; n < 2; ++n) { b0[n] = *(const f32x4*)(bias + 2 * CW + FW + nn + 4 * n); b1[n] = *(const f32x4*)(bias + 2 * CW + FW + D + nn + 4 * n); }
#pragma unroll
        for (int ai = 0; ai < 2; ++ai)
#pragma unroll
            for (int m = 0; m < 4; ++m) { const size_t off = ((size_t)u.pm * 256 + EPI_ROWS(ai, m)) * D + nn;
                const u32x4 wc_ = *(const u32x4*)(YC + off), wf_ = *(const u32x4*)(YF + off);
                f32x4 c0, c1, f0, f1; unpack8(wc_, c0, c1); unpack8(wf_, f0, f1);
                const f32x4 v0 = sig4(acc[ai][0][m][0] + b0[0]) * c0 + sig4(acc[ai][1][m][0] + b1[0]) * f0;
                const f32x4 v1 = sig4(acc[ai][0][m][1] + b0[1]) * c1 + sig4(acc[ai][1][m][1] + b1[1]) * f1;
                *(u32x4*)(MG + off) = pack8(v0, v1); }
    }
};
struct EpiResid {
    static constexpr bool PERM = false;
    const float* X; float* H; const float* gate; const float* bias;
    __device__ __forceinline__ void operator()(const f32x4 (&acc)[2][2][4][2], const Unit& u, int wr, int wc, int fr, int fq) const {
        const int col0 = u.pn * 256 + wc * 32 + 4 * fq; const int b = (u.pm * 256) >> 12;
        const float* gp = gate + (size_t)b * NMOD * D + col0; const float* bp = bias + col0;
#pragma unroll
        for (int ai = 0; ai < 2; ++ai) {
            f32x4 xv[4][2][2];
#pragma unroll
            for (int m = 0; m < 4; ++m) { const size_t off = ((size_t)u.pm * 256 + EPI_ROWS(ai, m)) * D + col0;
#pragma unroll
                for (int bj = 0; bj < 2; ++bj)
#pragma unroll
                    for (int n = 0; n < 2; ++n) xv[m][bj][n] = *(const f32x4*)(X + off + bj * 128 + n * 16); }
#pragma unroll
            for (int bj = 0; bj < 2; ++bj)
#pragma unroll
                for (int n = 0; n < 2; ++n) { const f32x4 gv = *(const f32x4*)(gp + bj * 128 + n * 16), bv = *(const f32x4*)(bp + bj * 128 + n * 16);
#pragma unroll
                    for (int m = 0; m < 4; ++m) { const size_t off = ((size_t)u.pm * 256 + EPI_ROWS(ai, m)) * D + col0;
                        *(f32x4*)(H + off + bj * 128 + n * 16) = xv[m][bj][n] + gv * (acc[ai][bj][m][n] + bv); } }
            asm volatile("" ::: "memory");
        }
    }
};
struct EpiDelta {
    static constexpr bool PERM = true;
    bf16_t* DL; const float* gate; const float* bias;
    __device__ __forceinline__ void operator()(const f32x4 (&acc)[2][2][4][2], const Unit& u, int wr, int wc, int fr, int fq) const {
        const int col0 = u.pn * 256 + wc * 32 + 8 * fq; const int b = (u.pm * 256) >> 12;
        f32x4 bv[2][2], gv[2][2];
#pragma unroll
        for (int bj = 0; bj < 2; ++bj)
#pragma unroll
            for (int n = 0; n < 2; ++n) { bv[bj][n] = *(const f32x4*)(bias + col0 + bj * 128 + 4 * n); gv[bj][n] = *(const f32x4*)(gate + (size_t)b * NMOD * D + col0 + bj * 128 + 4 * n); }
#pragma unroll
        for (int ai = 0; ai < 2; ++ai)
#pragma unroll
            for (int m = 0; m < 4; ++m) { bf16_t* rowp = DL + ((size_t)u.pm * 256 + EPI_ROWS(ai, m)) * D + col0;
#pragma unroll
                for (int bj = 0; bj < 2; ++bj) *(u32x4*)(rowp + bj * 128) = pack8(gv[bj][0] * (acc[ai][bj][m][0] + bv[bj][0]), gv[bj][1] * (acc[ai][bj][m][1] + bv[bj][1])); }
    }
};
constexpr float ACT_SC = 2.f, U_SC = 4.f, W_SC = 64.f;
constexpr int MX_U = 0x7d7d7d7d, MX_ACT = 0x7e7e7e7e, MX_W = 0x79797979;
template <bool F8> struct EpiSwiglu {
    static constexpr bool PERM = true;
    void* ACT;
    __device__ __forceinline__ void operator()(const f32x4 (&acc)[2][2][4][2], const Unit& u, int wr, int wc, int fr, int fq) const {
        const int col = u.pn * 128 + wc * 32 + 8 * fq;
#pragma unroll
        for (int ai = 0; ai < 2; ++ai)
#pragma unroll
            for (int m = 0; m < 4; ++m) { const size_t row = (size_t)u.e * ME + u.pm * 256 + EPI_ROWS(ai, m);
                const f32x4 v0 = silu4(acc[ai][0][m][0]) * acc[ai][1][m][0], v1 = silu4(acc[ai][0][m][1]) * acc[ai][1][m][1];
                if constexpr (F8) *(u32x2*)((unsigned char*)ACT + row * F + col) = pack8_f8(v0, v1, ACT_SC);
                else *(u32x4*)((bf16_t*)ACT + row * F + col) = pack8(v0, v1); }
    }
};
constexpr float YB_SC = 32.f;
struct EpiScaleW {
    static constexpr bool PERM = true;
    void* YB; const float* W;
    __device__ __forceinline__ void operator()(const f32x4 (&acc)[2][2][4][2], const Unit& u, int wr, int wc, int fr, int fq) const {
        const int col0 = u.pn * 256 + wc * 32 + 8 * fq;
#pragma unroll
        for (int ai = 0; ai < 2; ++ai)
#pragma unroll
            for (int m = 0; m < 4; ++m) { const size_t row = (size_t)u.e * ME + u.pm * 256 + EPI_ROWS(ai, m); const float w = W[row];
#pragma unroll
                for (int bj = 0; bj < 2; ++bj) {
                    if (YB_F8) *(u32x2*)((unsigned char*)YB + row * D + col0 + bj * 128) = pack8_f8(acc[ai][bj][m][0], acc[ai][bj][m][1], w * YB_SC);
                    else *(u32x4*)((bf16_t*)YB + row * D + col0 + bj * 128) = pack8(acc[ai][bj][m][0] * w, acc[ai][bj][m][1] * w); } }
    }
};
#undef EPI_ROWS
}

namespace pg8 {
struct SchedG1 {
    const char* U; const char* W; const int* rowl; int G, c, esz;
    __device__ bool next(int i, Unit& u) const {
        int e;
        if (G == 256) { if (i >= 16) return false; const int xcd = c & 7, j = c >> 3, ri = i & 7; e = 2 * xcd + (i >> 3); u.pm = (ri & 1) * 8 + (j & 7); u.pn = (ri >> 1) * 4 + (j >> 3); }
        else { const int L = i * G + c; if (L >= E * 256) return false; e = L >> 8; const int l = L & 255; u.pm = l & 15; u.pn = l >> 4; }
        u.e = e; u.a = U; u.rows = rowl + e * ME + u.pm * 256; u.b = W + ((size_t)e * 2 * F + (size_t)u.pn * 256) * D * esz; return true;
    }
};
struct SchedG2 {
    const char* ACT; const char* W; int G, c, esz;
    __device__ bool next(int i, Unit& u) const {
        int e;
        if (G == 256) { if (i >= 4) return false; const int xcd = c & 7, j = c >> 3; e = 2 * xcd + (i >> 1); u.pm = (i & 1) * 8 + (j & 7); u.pn = j >> 3; }
        else { const int L = i * G + c; if (L >= E * 64) return false; e = L >> 6; const int l = L & 63; u.pm = l & 15; u.pn = l >> 4; }
        u.e = e; u.rows = nullptr;
        u.a = ACT + ((size_t)e * ME + (size_t)u.pm * 256) * F * esz; u.b = W + ((size_t)e * D + (size_t)u.pn * 256) * F * esz; return true;
    }
};
}

struct Ctx {
    LAS unsigned char* lds; int tid, lane, wave, vcu, G;
};

__device__ __forceinline__ void transpose_item(const float* W, int ldw, int k0, int n0, bf16_t* WT, int ldt, int dst_row0, LAS float* scr, int lane) {
#pragma unroll 8
    for (int i = 0; i < 32; ++i) { const int kk = 2 * i + (lane >> 5); scr[kk * 33 + (lane & 31)] = W[(size_t)(k0 + kk) * ldw + n0 + (lane & 31)]; }
    LDS_WAIT(); asm volatile("" ::: "memory");
    const int c = lane & 7;
#pragma unroll
    for (int j = 0; j < 4; ++j) { const int n = (lane >> 3) + 8 * j; const LAS float* s = scr + (8 * c) * 33 + n;
        u32x4 o; o.x = pk2(s[0 * 33], s[1 * 33]); o.y = pk2(s[2 * 33], s[3 * 33]); o.z = pk2(s[4 * 33], s[5 * 33]); o.w = pk2(s[6 * 33], s[7 * 33]);
        *(GAS u32x4*)(WT + (size_t)(dst_row0 + n) * ldt + k0 + 8 * c) = o; }
    LDS_WAIT(); asm volatile("" ::: "memory");
}
struct TItem { const float* src; unsigned char* dst; int ldw, ldt; };
__device__ __forceinline__ void titem_load(const TItem& t, int lane, f32x4 (&v)[8]) {
#pragma unroll
    for (int i = 0; i < 8; ++i) v[i] = __builtin_nontemporal_load((const GAS f32x4*)(t.src + (size_t)(8 * i + (lane >> 3)) * t.ldw + (lane & 7) * 4));
}
__device__ __forceinline__ void titem_store_f8(const TItem& t, int lane, const f32x4 (&v)[8], LAS float* scr, float sc) {
#pragma unroll
    for (int i = 0; i < 8; ++i) { LAS float* d = scr + (8 * i + (lane >> 3)) * 33 + (lane & 7) * 4; d[0] = v[i][0]; d[1] = v[i][1]; d[2] = v[i][2]; d[3] = v[i][3]; }
    LDS_WAIT(); asm volatile("" ::: "memory");
#pragma unroll
    for (int j = 0; j < 2; ++j) { const int idx = lane + 64 * j, n = idx >> 2, c = idx & 3; const LAS float* s = scr + (16 * c) * 33 + n;
        unsigned w[4];
#pragma unroll
        for (int q = 0; q < 4; ++q) { unsigned tt = 0u; tt = __builtin_amdgcn_cvt_pk_fp8_f32(s[(4 * q + 0) * 33] * sc, s[(4 * q + 1) * 33] * sc, tt, false); tt = __builtin_amdgcn_cvt_pk_fp8_f32(s[(4 * q + 2) * 33] * sc, s[(4 * q + 3) * 33] * sc, tt, true); w[q] = tt; }
        *(GAS u32x4*)(t.dst + (size_t)n * t.ldt + 16 * c) = (u32x4){w[0], w[1], w[2], w[3]}; }
    LDS_WAIT(); asm volatile("" ::: "memory");
}
__device__ __forceinline__ int win_row(int n0) {
    if (n0 < 2 * CW) { const int half = n0 / CW, ch = n0 % CW; return 256 * (ch / 128) + 128 * half + (ch % 128); }
    if (n0 < 2 * CW + FW) return n0;
    const int cc = n0 - (2 * CW + FW), half = cc / D, c2 = cc % D; return 2 * CW + FW + 256 * (c2 / 128) + 128 * half + (c2 % 128);
}

struct P {
    const float *x, *c, *ada_w, *ada_b, *norm1_g, *w_in, *b_in, *dw_w, *dw_b, *cln_g, *cln_b, *cw_out, *cb_out, *four_w, *four_b, *w_out, *b_out, *norm2_g, *router_w, *w_gate, *w_up, *w_down, *final_g;
    float* out;
    float* MOD; float* W2F; float* AFF; int* ROWL; float* WTS; short* INV;
    bf16_t *Wt_in, *Wt_conv, *Wt_four, *Wt_out, *D256, *GP, *Wt_gu, *Wt_down;
    bf16_t *U, *V, *FT, *ACONV, *YRI, *YCONV, *YFOUR, *MERGED, *ACT, *YB, *DELTA;
};

__device__ __forceinline__ void titem_store_bf16(const TItem& t, int lane, const f32x4 (&v)[8], LAS float* scr) {
#pragma unroll
    for (int i = 0; i < 8; ++i) { LAS float* d = scr + (8 * i + (lane >> 3)) * 33 + (lane & 7) * 4; d[0] = v[i][0]; d[1] = v[i][1]; d[2] = v[i][2]; d[3] = v[i][3]; }
    LDS_WAIT(); asm volatile("" ::: "memory");
    const int c = lane & 7;
#pragma unroll
    for (int j = 0; j < 4; ++j) { const int n = (lane >> 3) + 8 * j; const LAS float* s = scr + (8 * c) * 33 + n;
        u32x4 o; o.x = pk2(s[0 * 33], s[1 * 33]); o.y = pk2(s[2 * 33], s[3 * 33]); o.z = pk2(s[4 * 33], s[5 * 33]); o.w = pk2(s[6 * 33], s[7 * 33]);
        *(GAS u32x4*)(t.dst + ((size_t)n * t.ldt + 8 * c) * 2) = o; }
    LDS_WAIT(); asm volatile("" ::: "memory");
}
__device__ __forceinline__ TItem small_item(const P& p, int r) {
    constexpr int I1 = (D / 64) * (INC / 32), I2 = (CW / 64) * (D / 32);
    TItem t;
    if (r < I1) { const int kb = r / (INC / 32), nb = r % (INC / 32); t.src = p.w_in + (size_t)(64 * kb) * INC + 32 * nb; t.ldw = INC; t.ldt = D; t.dst = (unsigned char*)(p.Wt_in + (size_t)win_row(32 * nb) * D + 64 * kb); return t; }
    r -= I1;
    if (r < I2) { const int kb = r / (D / 32), nb = r % (D / 32); t.src = p.cw_out + (size_t)(64 * kb) * D + 32 * nb; t.ldw = D; t.ldt = CW; t.dst = (unsigned char*)(p.Wt_conv + (size_t)(32 * nb) * CW + 64 * kb); return t; }
    r -= I2;
    { const int kb = r / (D / 32), nb = r % (D / 32); t.src = p.w_out + (size_t)(64 * kb) * D + 32 * nb; t.ldw = D; t.ldt = D; t.dst = (unsigned char*)(p.Wt_out + (size_t)(32 * nb) * D + 64 * kb); return t; }
}
__device__ __forceinline__ void phase_p0a(const Ctx& X0, const P& p) {
    Ctx X = X0; X.tid = (int)threadIdx.x; asm volatile("" : "+v"(X.tid)); X.lane = X.tid & 63;
    LAS float* scr = (LAS float*)(X.lds + X.wave * 16384);
    const int gw = X.vcu * NWAVES + X.wave, NGW = X.G * NWAVES;
    constexpr int I1 = (D / 64) * (INC / 32), I2 = (CW / 64) * (D / 32), I4 = (D / 64) * (D / 32);
    const bool do_mod = X.vcu < NMOD * D / 32; const int mcol = X.tid & 31, mks = X.tid >> 5, mj0 = X.vcu * 32;
    float mw[64];
    if (do_mod) {
#pragma unroll
        for (int k = 0; k < 64; ++k) mw[k] = __builtin_nontemporal_load(p.ada_w + (size_t)(mks * 64 + k) * (NMOD * D) + mj0 + mcol); }
    const int fg = X.vcu / (D / 16), fn0 = (X.vcu % (D / 16)) * 16;
    f32x4 ftile = (f32x4){0.f, 0.f, 0.f, 0.f};
    if (X.vcu < FG * (D / 16)) ftile = *(const GAS f32x4*)(p.four_w + (size_t)(fg * FGD + (X.tid >> 2)) * D + fn0 + (X.tid & 3) * 4);
    {   f32x4 va[8], vb[8]; TItem cur, nx; int it = gw;
        if (it < I1 + I2 + I4) { cur = small_item(p, it); titem_load(cur, X.lane, va); }
        while (it < I1 + I2 + I4) {
            const int nxt = it + NGW; if (nxt < I1 + I2 + I4) { nx = small_item(p, nxt); titem_load(nx, X.lane, vb); }
            titem_store_bf16(cur, X.lane, va, scr);
#pragma unroll
            for (int i = 0; i < 8; ++i) va[i] = vb[i];
            cur = nx; it = nxt;
        }
    }
    __syncthreads();
    LAS float* ct = (LAS float*)X.lds; LAS float* c128 = ct + S;
    for (int i = X.tid; i < S; i += NTHR) { float sv, cv; sincospif((float)i / (float)(S / 2), &sv, &cv); ct[i] = cv; }
    if (X.tid < FGD) { float sv, cv; sincospif((float)X.tid / 64.f, &sv, &cv); c128[X.tid] = cv; }
    __syncthreads();
    const int gt = X.vcu * NTHR + X.tid, NGT = X.G * NTHR;
    for (int it = gt; it < 512 * 64; it += NGT) { const int r = it >> 6, c0 = (it & 63) * 8; const int part = r >> 8, k1 = r & 255, pc = c0 >> 8, s10 = c0 & 255;
        const int ph = (part == pc) ? 0 : (part == 0 ? -(S / 4) : (S / 4));
        unsigned w[4];
#pragma unroll
        for (int j = 0; j < 4; ++j) { const float a = ct[(16 * k1 * (s10 + 2 * j) + ph) & (S - 1)], b = ct[(16 * k1 * (s10 + 2 * j + 1) + ph) & (S - 1)]; w[j] = pk2(a, b); }
        *(GAS u32x4*)(p.D256 + (size_t)r * 512 + c0) = (u32x4){w[0], w[1], w[2], w[3]}; }
    {
        LAS float* wt = c128 + FGD;
        for (int it = X.vcu; it < FG * (D / 16); it += X.G) { const int g = it / (D / 16), n0 = (it % (D / 16)) * 16;
            __syncthreads();
            if (it == X.vcu) *(LAS f32x4*)(wt + 4 * X.tid) = ftile;
            else for (int i = X.tid; i < FGD * 16; i += NTHR) wt[i] = p.four_w[(size_t)(g * FGD + (i >> 4)) * D + n0 + (i & 15)];
            __syncthreads();
            const int nq = X.tid & 3, c = X.tid >> 2; int idx = 0;
            f32x4 ac = (f32x4){0.f, 0.f, 0.f, 0.f}, as = (f32x4){0.f, 0.f, 0.f, 0.f};
#pragma unroll 8
            for (int j = 0; j < FGD; ++j) { const float tc = c128[idx], ts = c128[(idx + 96) & 127];
                const f32x4 wv = *(const LAS f32x4*)(wt + j * 16 + 4 * nq); ac += wv * tc; as += wv * ts; idx = (idx + c) & 127; }
            *(GAS f32x4*)(p.W2F + (size_t)(g * FGD + c) * D + n0 + 4 * nq) = ac * 0.0013810679320049757f;
            *(GAS f32x4*)(p.W2F + (size_t)(FW + g * FGD + c) * D + n0 + 4 * nq) = as * 0.0013810679320049757f;
        }
    }
    __syncthreads();
    if (do_mod) {
        LAS float* cs = (LAS float*)X.lds;
        LAS float* part = cs + Bn * D;
        for (int i = X.tid; i < Bn * D; i += NTHR) cs[i] = siluf_(p.c[i]);
        __syncthreads();
        const int col = X.tid & 31, ks = X.tid >> 5, j0 = X.vcu * 32;
        float acc[Bn];
#pragma unroll
        for (int b = 0; b < Bn; ++b) acc[b] = 0.f;
#pragma unroll
        for (int k = 0; k < 64; ++k)
#pragma unroll
            for (int b = 0; b < Bn; ++b) acc[b] += cs[b * D + ks * 64 + k] * mw[k];
#pragma unroll
        for (int b = 0; b < Bn; ++b) part[(ks * Bn + b) * 32 + col] = acc[b];
        __syncthreads();
        if (X.tid < Bn * 32) { const int b = X.tid >> 5, cc = X.tid & 31; float s = p.ada_b[j0 + cc];
#pragma unroll
            for (int k2 = 0; k2 < 16; ++k2) s += part[(k2 * Bn + b) * 32 + cc];
            p.MOD[b * NMOD * D + j0 + cc] = s; }
    }
}

__device__ __forceinline__ float row_load_rstd(const float* xr, int lane, f32x4 (&v)[4]) {
    float ss = 0.f;
#pragma unroll
    for (int j = 0; j < 2; ++j) { v[2 * j] = *(const GAS f32x4*)(xr + 8 * lane + 512 * j); v[2 * j + 1] = *(const GAS f32x4*)(xr + 8 * lane + 512 * j + 4); }
#pragma unroll
    for (int q = 0; q < 4; ++q) ss += (v[q][0] * v[q][0] + v[q][1] * v[q][1]) + (v[q][2] * v[q][2] + v[q][3] * v[q][3]);
    return 1.f / sqrtf(wave_sum(ss) * (1.f / D) + 1e-6f);
}
__device__ __forceinline__ void row_issue(const float* xr, int lane, f32x4 (&v)[4]) {
#pragma unroll
    for (int j = 0; j < 4; ++j) v[j] = __builtin_nontemporal_load((const GAS f32x4*)(xr + 4 * lane + 256 * j));
}
__device__ __forceinline__ float row_rstd(const f32x4 (&v)[4]) {
    float ss = 0.f;
#pragma unroll
    for (int q = 0; q < 4; ++q) ss += (v[q][0] * v[q][0] + v[q][1] * v[q][1]) + (v[q][2] * v[q][2] + v[q][3] * v[q][3]);
    return 1.f / sqrtf(wave_sum(ss) * (1.f / D) + 1e-6f);
}
__device__ __forceinline__ TItem moe_item(const P& p, int r) {
    constexpr int I5 = (D / 64) * (F / 32), I6 = (F / 64) * (D / 32);
    TItem t;
    if (r < E * 2 * I5) { const int eh = r / I5, q = r % I5, e = eh >> 1, half = eh & 1; const int kb = q / (F / 32), nb = q % (F / 32), n0 = 32 * nb;
        t.src = (half ? p.w_up : p.w_gate) + (size_t)e * D * F + (size_t)(64 * kb) * F + n0; t.ldw = F; t.ldt = D;
        t.dst = (unsigned char*)p.Wt_gu + (size_t)e * 2 * F * D + (size_t)(256 * (n0 / 128) + 128 * half + (n0 % 128)) * D + 64 * kb; }
    else { r -= E * 2 * I5; const int e = r / I6, q = r % I6; const int kb = q / (D / 32), nb = q % (D / 32);
        t.src = p.w_down + (size_t)e * F * D + (size_t)(64 * kb) * D + 32 * nb; t.ldw = D; t.ldt = F;
        t.dst = (unsigned char*)p.Wt_down + (size_t)e * D * F + (size_t)(32 * nb) * F + 64 * kb; }
    return t;
}
__device__ __forceinline__ void phase_p0b(const Ctx& X0, const P& p) {
    Ctx X = X0; X.tid = (int)threadIdx.x; asm volatile("" : "+v"(X.tid)); X.lane = X.tid & 63;
    const int gw = X.vcu * NWAVES + X.wave, NGW = X.G * NWAVES;
    {
        const int RPW = T / X.G, base = X.vcu * RPW; const float* md = p.MOD + (size_t)(base >> 12) * NMOD * D;
        f32x4 av[4], sv[4];
#pragma unroll
        for (int j = 0; j < 4; ++j) { const int c0 = 4 * X.lane + 256 * j; av[j] = *(const f32x4*)(p.norm1_g + c0) * (*(const f32x4*)(md + D + c0) + 1.f); sv[j] = *(const f32x4*)(md + c0); }
        f32x4 v[4], vn[4], vn2[4]; int i = X.wave; if (i < RPW) row_issue(p.x + (size_t)(base + i) * D, X.lane, v);
        if (i + NWAVES < RPW) row_issue(p.x + (size_t)(base + i + NWAVES) * D, X.lane, vn);
        for (; i < RPW; i += NWAVES) {
            const int m = base + i, in2 = i + 2 * NWAVES; if (in2 < RPW) row_issue(p.x + (size_t)(base + in2) * D, X.lane, vn2);
            const float rstd = row_rstd(v);
#pragma unroll
            for (int j = 0; j < 4; ++j) { const int c0 = 4 * X.lane + 256 * j; const f32x4 o = v[j] * rstd * av[j] + sv[j];
                *(GAS u32x2*)(p.U + (size_t)m * D + c0) = (u32x2){cvt_pk_bf16(o[0], o[1]), cvt_pk_bf16(o[2], o[3])}; }
#pragma unroll
            for (int q = 0; q < 4; ++q) { v[q] = vn[q]; vn[q] = vn2[q]; }
        }
    }
    LAS float* scr = (LAS float*)(X.lds + X.wave * 16384);
    constexpr int I3 = (D / 64) * (D / 32);
    for (int it = gw; it < I3; it += NGW) { const int kb = it / (D / 32), nb = it % (D / 32); transpose_item(p.W2F, D, 64 * kb, 32 * nb, p.Wt_four, D, 32 * nb, scr, X.lane); }
    constexpr int NIT = E * 2 * (D / 64) * (F / 32) + E * (F / 64) * (D / 32);
#if MOE_F8
    {   f32x4 va[8], vb[8], vc[8]; TItem cur, nx, nx2; int it = gw;
        if (it < NIT) { cur = moe_item(p, it); titem_load(cur, X.lane, va); }
        if (it + NGW < NIT) { nx = moe_item(p, it + NGW); titem_load(nx, X.lane, vb); }
        while (it < NIT) {
            const int n2 = it + 2 * NGW; if (n2 < NIT) { nx2 = moe_item(p, n2); titem_load(nx2, X.lane, vc); }
            titem_store_f8(cur, X.lane, va, scr, epi::W_SC);
#pragma unroll
            for (int i = 0; i < 8; ++i) { va[i] = vb[i]; vb[i] = vc[i]; }
            cur = nx; nx = nx2; it += NGW;
        }
    }
#else
    constexpr int I5 = (D / 64) * (F / 32), I6 = (F / 64) * (D / 32);
    for (int it = gw; it < NIT; it += NGW) { int r = it;
        if (r < E * 2 * I5) { const int eh = r / I5, q = r % I5, e = eh >> 1, half = eh & 1; const int kb = q / (F / 32), nb = q % (F / 32), n0 = 32 * nb;
            transpose_item((half ? p.w_up : p.w_gate) + (size_t)e * D * F, F, 64 * kb, n0, p.Wt_gu + (size_t)e * 2 * F * D, D, 256 * (n0 / 128) + 128 * half + (n0 % 128), scr, X.lane); continue; } r -= E * 2 * I5;
        { const int e = r / I6, q = r % I6; const int kb = q / (D / 32), nb = q % (D / 32);
            transpose_item(p.w_down + (size_t)e * F * D, D, 64 * kb, 32 * nb, p.Wt_down + (size_t)e * D * F, F, 32 * nb, scr, X.lane); } }
#endif
}

__device__ __forceinline__ void phase_conv(const Ctx& X0, const P& p) {
    Ctx X = X0; X.tid = (int)threadIdx.x; asm volatile("" : "+v"(X.tid)); X.lane = X.tid & 63;
    constexpr int CH = 32, ROWS = CH + CK - 1;
    LAS unsigned char* rows = X.lds;
    LAS float* wl = (LAS float*)(X.lds + ROWS * 1024);
    for (int i = X.tid; i < CK * CW; i += NTHR) { const int k = i / CW, ch = i % CW; const int ln = ch >> 3, q = (ch >> 2) & 1, r = ch & 3; wl[((k * 2 + q) * 64 + ln) * 4 + r] = p.dw_w[i]; }
    const int lane = X.lane, w = X.wave;
    f32x4 db[2], lg[2], lb[2];
#pragma unroll
    for (int h = 0; h < 2; ++h) { db[h] = *(const f32x4*)(p.dw_b + 8 * lane + 4 * h); lg[h] = *(const f32x4*)(p.cln_g + 8 * lane + 4 * h); lb[h] = *(const f32x4*)(p.cln_b + 8 * lane + 4 * h); }
    u32x4 pre[8];
#define CV_LOAD(chk) do { const int t0_ = (chk) * CH, b_ = t0_ >> 12, s0_ = t0_ & (S - 1); _Pragma("unroll") for (int q = 0; q < 8; ++q) { const int i = X.tid + q * NTHR, r = i >> 6, cseg = i & 63, s = s0_ + r - CK / 2; \
        pre[q] = (u32x4){0u, 0u, 0u, 0u}; if (i < ROWS * 64 && s >= 0 && s < S) pre[q] = *(const GAS u32x4*)(p.V + ((size_t)(b_ * S + s)) * CW + cseg * 8); } } while (0)
    if (X.vcu < T / CH) CV_LOAD(X.vcu);
    for (int chunk = X.vcu; chunk < T / CH; chunk += X.G) {
        const int t0 = chunk * CH;
        __syncthreads();
#pragma unroll
        for (int q = 0; q < 8; ++q) { const int i = X.tid + q * NTHR; if (i < ROWS * 64) *(LAS u32x4*)(rows + (i >> 6) * 1024 + (i & 63) * 16) = pre[q]; }
        if (chunk + X.G < T / CH) CV_LOAD(chunk + X.G);
        __syncthreads();
        f32x4 acc[4][2]; int zo = 0; asm volatile("" : "+v"(zo));
#pragma unroll
        for (int j = 0; j < 4; ++j) { acc[j][0] = db[0]; acc[j][1] = db[1]; }
#pragma unroll
        for (int rr = 0; rr < CK + 3; ++rr) {
            const u32x4 rv = *(const LAS u32x4*)(rows + (4 * w + rr) * 1024 + lane * 16); f32x4 a0, a1; epi::unpack8(rv, a0, a1);
#pragma unroll
            for (int j = 0; j < 4; ++j) { const int k = rr - j;
                if (k >= 0 && k < CK) { const f32x4 w0 = *(const LAS f32x4*)(wl + ((k * 2 + 0) * 64 + lane + zo) * 4), w1 = *(const LAS f32x4*)(wl + ((k * 2 + 1) * 64 + lane + zo) * 4);
                    acc[j][0] += a0 * w0; acc[j][1] += a1 * w1; } }
        }
#pragma unroll
        for (int j = 0; j < 4; ++j) {
            const f32x4 a0 = acc[j][0], a1 = acc[j][1];
            const float mu = wave_sum((a0[0] + a0[1]) + (a0[2] + a0[3]) + (a1[0] + a1[1]) + (a1[2] + a1[3])) * (1.f / CW);
            const f32x4 d0 = a0 - mu, d1 = a1 - mu;
            const float var = wave_sum((d0[0] * d0[0] + d0[1] * d0[1]) + (d0[2] * d0[2] + d0[3] * d0[3]) + (d1[0] * d1[0] + d1[1] * d1[1]) + (d1[2] * d1[2] + d1[3] * d1[3])) * (1.f / CW);
            const float rstd = 1.f / sqrtf(var + 1e-5f);
            const f32x4 z0 = d0 * rstd * lg[0] + lb[0], z1 = d1 * rstd * lg[1] + lb[1];
            *(GAS u32x4*)(p.ACONV + (size_t)(t0 + 4 * w + j) * CW + 8 * lane) = epi::pack8(epi::silu4(z0), epi::silu4(z1));
        }
    }
#undef CV_LOAD
    __syncthreads();
}


__device__ __forceinline__ void dft16_real(const float (&x)[16], float (&gr)[16], float (&gi)[16]) {
    constexpr float WR[10] = {1.f, 0.92387953251128674f, 0.70710678118654752f, 0.38268343236508977f, 0.f, -0.38268343236508977f, -0.70710678118654752f, -0.92387953251128674f, -1.f, -0.92387953251128674f};
    constexpr float WI[10] = {0.f, -0.38268343236508977f, -0.70710678118654752f, -0.92387953251128674f, -1.f, -0.92387953251128674f, -0.70710678118654752f, -0.38268343236508977f, 0.f, 0.38268343236508977f};
    float zr[4][4], zi[4][4];
#pragma unroll
    for (int b = 0; b < 4; ++b) { const float x0 = x[b], x1 = x[4 + b], x2 = x[8 + b], x3 = x[12 + b];
        const float s02 = x0 + x2, d02 = x0 - x2, s13 = x1 + x3, d13 = x1 - x3;
        const float yr[4] = {s02 + s13, d02, s02 - s13, d02}, yi[4] = {0.f, -d13, 0.f, d13};
#pragma unroll
        for (int c = 0; c < 4; ++c) { const float wr = WR[b * c], wi = WI[b * c]; zr[b][c] = yr[c] * wr - yi[c] * wi; zi[b][c] = yr[c] * wi + yi[c] * wr; } }
#pragma unroll
    for (int c = 0; c < 4; ++c) {
        const float ar = zr[0][c] + zr[2][c], ai = zi[0][c] + zi[2][c], br = zr[0][c] - zr[2][c], bi = zi[0][c] - zi[2][c];
        const float cr = zr[1][c] + zr[3][c], ci = zi[1][c] + zi[3][c], dr = zr[1][c] - zr[3][c], di = zi[1][c] - zi[3][c];
        gr[c] = ar + cr;      gi[c] = ai + ci;
        gr[c + 4] = br + di;  gi[c + 4] = bi - dr;
        gr[c + 8] = ar - cr;  gi[c + 8] = ai - ci;
        gr[c + 12] = br - di; gi[c + 12] = bi + dr;
    }
}
__device__ __forceinline__ void phase_fftA(const Ctx& X0, const P& p) {
    Ctx X = X0; X.tid = (int)threadIdx.x; asm volatile("" : "+v"(X.tid)); X.lane = X.tid & 63;
    LAS float* ct = (LAS float*)X.lds;
    for (int i = X.tid; i < S; i += NTHR) { float sv, cv; sincospif((float)i / (float)(S / 2), &sv, &cv); ct[i] = cv; }
    __syncthreads();
    constexpr float C16[16] = {1.f, 0.92387953251128674f, 0.70710678118654752f, 0.38268343236508977f, 0.f, -0.38268343236508977f, -0.70710678118654752f, -0.92387953251128674f,
                               -1.f, -0.92387953251128674f, -0.70710678118654752f, -0.38268343236508977f, 0.f, 0.38268343236508977f, 0.70710678118654752f, 0.92387953251128674f};
    const int chl = X.tid >> 7, sp = X.tid & 127;
    unsigned pre[16];
#define FA_LOAD(itm) do { const bf16_t* src_ = p.FT + ((size_t)(((itm) >> 7) * FW + ((itm) & 127) * 4 + chl) * S + 2 * sp); _Pragma("unroll") for (int s2 = 0; s2 < 16; ++s2) pre[s2] = *(const GAS unsigned*)(src_ + 256 * s2); } while (0)
    if (X.vcu < Bn * (FW / 4)) FA_LOAD(X.vcu);
    for (int it = X.vcu; it < Bn * (FW / 4); it += X.G) {
        const int b = it >> 7, ch = (it & 127) * 4 + chl;
        float xa[16], xb[16];
#pragma unroll
        for (int s2 = 0; s2 < 16; ++s2) { const unsigned w = pre[s2]; xa[s2] = bf_lo(w); xb[s2] = bf_hi(w); }
        if (it + X.G < Bn * (FW / 4)) FA_LOAD(it + X.G);
        float gar[16], gai[16], gbr[16], gbi[16];
        dft16_real(xa, gar, gai); dft16_real(xb, gbr, gbi);
#pragma unroll
        for (int k2 = 0; k2 < 16; ++k2) {
            const float ar = gar[k2], ai = gai[k2], br = gbr[k2], bi = gbi[k2];
            const int ia = (2 * sp * k2) & (S - 1), ib = ((2 * sp + 1) * k2) & (S - 1);
            const float tca = ct[ia], tsa = ct[(ia - S / 4) & (S - 1)], tcb = ct[ib], tsb = ct[(ib - S / 4) & (S - 1)];
            const float gra = ar * tca + ai * tsa, gia = ai * tca - ar * tsa, grb = br * tcb + bi * tsb, gib = bi * tcb - br * tsb;
            bf16_t* dst = p.GP + ((size_t)((b * 16 + k2) * FW + ch) * 512 + 2 * sp);
            *(GAS unsigned*)dst = cvt_pk_bf16(gra, grb); *(GAS unsigned*)(dst + 256) = cvt_pk_bf16(gia, gib);
        }
    }
    __syncthreads();
}

__device__ __forceinline__ void phase_router(const Ctx& X0, const P& p, const float* H) {
    Ctx X = X0; X.tid = (int)threadIdx.x; asm volatile("" : "+v"(X.tid)); X.lane = X.tid & 63;
    LAS float* GP = (LAS float*)X.lds;
    LAS float* SH = GP + D;
    LAS f32x4* ACCP = (LAS f32x4*)(SH + D);
    LAS float* SSP = (LAS float*)(ACCP + 2 * 8 * 64);
    LAS float* CE = SSP + 2 * 8 * 16;
    const int lane = X.lane, w = X.wave, r = lane & 15, kq = lane >> 4;
    constexpr int NG = T / 16, GPW = NG / 256;
    const int g0 = X.vcu * GPW, b = (g0 * 16) >> 12;
    const float* md = p.MOD + (size_t)b * NMOD * D;
    f32x4 a[4][2], vn[4][2];
    const int cbase = 128 * w + 8 * kq;
#if H_DELTA
#define RT_ISSUE(dst, grp) do { const size_t ro_ = ((size_t)(grp) * 16 + r) * D + cbase; const float* rp = H + ro_; const bf16_t* dp = p.DELTA + ro_; _Pragma("unroll") for (int s = 0; s < 4; ++s) { \
        const u32x4 dw_ = *(const GAS u32x4*)(dp + 32 * s); f32x4 d0_, d1_; epi::unpack8(dw_, d0_, d1_); dst[s][0] = __builtin_nontemporal_load((const GAS f32x4*)(rp + 32 * s)) + d0_; dst[s][1] = __builtin_nontemporal_load((const GAS f32x4*)(rp + 32 * s + 4)) + d1_; } } while (0)
#else
#define RT_ISSUE(dst, grp) do { const float* rp = H + ((size_t)(grp) * 16 + r) * D + cbase; _Pragma("unroll") for (int s = 0; s < 4; ++s) { dst[s][0] = *(const GAS f32x4*)(rp + 32 * s); dst[s][1] = *(const GAS f32x4*)(rp + 32 * s + 4); } } while (0)
#endif
    RT_ISSUE(a, g0);
    for (int i = X.tid; i < D; i += NTHR) { GP[i] = p.norm2_g[i] * (1.f + md[4 * D + i]); SH[i] = md[3 * D + i]; }
    bf16x8 bh[4], bl[4];
#pragma unroll
    for (int s = 0; s < 4; ++s) { unsigned hw[4], lw[4];
#pragma unroll
        for (int j = 0; j < 4; ++j) { const int d = 32 * (4 * w + s) + 8 * kq + 2 * j; const float x0 = p.router_w[(size_t)d * E + r], x1 = p.router_w[(size_t)(d + 1) * E + r];
            const unsigned h = cvt_pk_bf16(x0, x1); hw[j] = h; lw[j] = cvt_pk_bf16(x0 - bf_lo(h), x1 - bf_hi(h)); }
        bh[s] = __builtin_bit_cast(bf16x8, (u32x4){hw[0], hw[1], hw[2], hw[3]}); bl[s] = __builtin_bit_cast(bf16x8, (u32x4){lw[0], lw[1], lw[2], lw[3]}); }
    __syncthreads();
    if (w == 0) {
        float c[E];
#pragma unroll
        for (int e = 0; e < E; ++e) c[e] = 0.f;
        for (int d = lane; d < D; d += 64) { const float sv = SH[d]; const f32x4* wr_ = (const f32x4*)(p.router_w + (size_t)d * E);
#pragma unroll
            for (int q = 0; q < 4; ++q) { const f32x4 wv = wr_[q]; c[4 * q] += sv * wv[0]; c[4 * q + 1] += sv * wv[1]; c[4 * q + 2] += sv * wv[2]; c[4 * q + 3] += sv * wv[3]; } }
#pragma unroll
        for (int e = 0; e < E; ++e) { const float s = wave_sum(c[e]); if (lane == e) CE[e] = s; }
    }
    __syncthreads();
    for (int gi = 0; gi < GPW; ++gi) {
        const int g = g0 + gi, par = gi & 1;
        if (gi + 1 < GPW) RT_ISSUE(vn, g + 1);
        float ss = 0.f; f32x4 acc = (f32x4){0.f, 0.f, 0.f, 0.f};
#pragma unroll
        for (int s = 0; s < 4; ++s) {
            const f32x4 g0v = *(const LAS f32x4*)(GP + cbase + 32 * s), g1v = *(const LAS f32x4*)(GP + cbase + 32 * s + 4);
            const f32x4 v0 = a[s][0], v1 = a[s][1];
            ss += (v0[0] * v0[0] + v0[1] * v0[1]) + (v0[2] * v0[2] + v0[3] * v0[3]) + (v1[0] * v1[0] + v1[1] * v1[1]) + (v1[2] * v1[2] + v1[3] * v1[3]);
            const f32x4 x0 = v0 * g0v, x1 = v1 * g1v; a[s][0] = x0; a[s][1] = x1;
            unsigned hw[4], lw[4];
            hw[0] = cvt_pk_bf16(x0[0], x0[1]); hw[1] = cvt_pk_bf16(x0[2], x0[3]); hw[2] = cvt_pk_bf16(x1[0], x1[1]); hw[3] = cvt_pk_bf16(x1[2], x1[3]);
            lw[0] = cvt_pk_bf16(x0[0] - bf_lo(hw[0]), x0[1] - bf_hi(hw[0])); lw[1] = cvt_pk_bf16(x0[2] - bf_lo(hw[1]), x0[3] - bf_hi(hw[1]));
            lw[2] = cvt_pk_bf16(x1[0] - bf_lo(hw[2]), x1[1] - bf_hi(hw[2])); lw[3] = cvt_pk_bf16(x1[2] - bf_lo(hw[3]), x1[3] - bf_hi(hw[3]));
            const bf16x8 ah = __builtin_bit_cast(bf16x8, (u32x4){hw[0], hw[1], hw[2], hw[3]}), al = __builtin_bit_cast(bf16x8, (u32x4){lw[0], lw[1], lw[2], lw[3]});
            acc = __builtin_amdgcn_mfma_f32_16x16x32_bf16(ah, bh[s], acc, 0, 0, 0);
            acc = __builtin_amdgcn_mfma_f32_16x16x32_bf16(ah, bl[s], acc, 0, 0, 0);
            acc = __builtin_amdgcn_mfma_f32_16x16x32_bf16(al, bh[s], acc, 0, 0, 0);
        }
        ss += __shfl_xor(ss, 16); ss += __shfl_xor(ss, 32);
        ACCP[(par * 8 + w) * 64 + lane] = acc;
        if (lane < 16) SSP[(par * 8 + w) * 16 + lane] = ss;
        __syncthreads();
        float rss = 0.f;
#pragma unroll
        for (int q = 0; q < 8; ++q) rss += SSP[(par * 8 + q) * 16 + r];
        const float rstd = 1.f / sqrtf(rss * (1.f / D) + 1e-6f);
        if (w == (gi & 7)) {
            f32x4 lg = (f32x4){0.f, 0.f, 0.f, 0.f};
#pragma unroll
            for (int q = 0; q < 8; ++q) lg += ACCP[(par * 8 + q) * 64 + lane];
            const float ce = CE[r]; f32x4 o;
#pragma unroll
            for (int q = 0; q < 4; ++q) { const float rs = __shfl(rstd, 4 * kq + q); float z = lg[q] * rs + ce; float mx = z;
#pragma unroll
                for (int sft = 1; sft < 16; sft <<= 1) mx = fmaxf(mx, __shfl_xor(mx, sft));
                const float ex = expf(z - mx); float sm = ex;
#pragma unroll
                for (int sft = 1; sft < 16; sft <<= 1) sm += __shfl_xor(sm, sft);
                o[q] = ex / sm; }
            *(GAS f32x4*)(p.AFF + ((size_t)b * E + r) * S + ((g * 16) & (S - 1)) + 4 * kq) = o;
        }
#pragma unroll
        for (int s = 0; s < 4; ++s) {
            const f32x4 s0 = *(const LAS f32x4*)(SH + cbase + 32 * s), s1 = *(const LAS f32x4*)(SH + cbase + 32 * s + 4);
            const f32x4 u0 = a[s][0] * rstd + s0, u1 = a[s][1] * rstd + s1; const size_t off = ((size_t)g * 16 + r) * D + cbase + 32 * s;
            if (MOE_F8) *(GAS u32x2*)((unsigned char*)p.U + off) = pack8_f8(u0, u1, epi::U_SC);
            else *(GAS u32x4*)(p.U + off) = epi::pack8(u0, u1);
        }
#pragma unroll
        for (int s = 0; s < 4; ++s) { a[s][0] = vn[s][0]; a[s][1] = vn[s][1]; }
    }
#undef RT_ISSUE
    __syncthreads();
}

__device__ __forceinline__ void phase_topk(const Ctx& X0, const P& p) {
    Ctx X = X0; X.tid = (int)threadIdx.x; asm volatile("" : "+v"(X.tid)); X.lane = X.tid & 63;
    LAS unsigned* cnt = (LAS unsigned*)X.lds;
    LAS unsigned* sc = cnt + 48;
    const int lane = X.lane, w = X.wave, tid = X.tid;
    for (int be = X.vcu; be < Bn * E; be += X.G) {
        const int b = be / E, e = be % E;
        const float* src = p.AFF + (size_t)be * S + 8 * tid;
        const f32x4 a0 = *(const GAS f32x4*)src, a1 = *(const GAS f32x4*)(src + 4);
        unsigned key[8];
#pragma unroll
        for (int i = 0; i < 4; ++i) { const float f0 = a0[i], f1 = a1[i]; key[i] = __float_as_uint(f0); key[4 + i] = __float_as_uint(f1); }
        unsigned prefix = 0u, need_k = (unsigned)CAP;
        __syncthreads();
        if (tid < 48) cnt[tid] = 0u;
        __syncthreads();
#pragma unroll 1
        for (int pass = 0; pass < 8; ++pass) {
            const int shift = 28 - 4 * pass; LAS unsigned* hist = cnt + (pass % 3) * 16;
            if (tid < 16) cnt[((pass + 1) % 3) * 16 + tid] = 0u;
#pragma unroll
            for (int i = 0; i < 8; ++i) { const bool match = (pass == 0) || ((key[i] >> (shift + 4)) == (prefix >> (shift + 4)));
                if (match) __hip_atomic_fetch_add(hist + ((key[i] >> shift) & 15u), 1u, __ATOMIC_RELAXED, __HIP_MEMORY_SCOPE_WORKGROUP); }
            __syncthreads();
            unsigned cum = 0u, dsel = 0u, below = 0u; bool found = false;
#pragma unroll
            for (int dgt = 15; dgt >= 0; --dgt) { const unsigned c = hist[dgt]; if (!found) { if (cum + c >= need_k) { dsel = (unsigned)dgt; below = cum; found = true; } else cum += c; } }
            prefix |= dsel << shift; need_k -= below;
        }
        const unsigned Tk = prefix;
        unsigned ngt = 0u, neq = 0u;
#pragma unroll
        for (int i = 0; i < 8; ++i) { ngt += key[i] > Tk; neq += key[i] == Tk; }
        unsigned sg = ngt, se = neq;
#pragma unroll
        for (int o = 1; o < 64; o <<= 1) { const unsigned tg = __shfl_up(sg, o), te = __shfl_up(se, o); if (lane >= o) { sg += tg; se += te; } }
        __syncthreads();
        if (lane == 63) { sc[w] = sg; sc[8 + w] = se; }
        __syncthreads();
        unsigned og = 0u, oe = 0u, totg = 0u;
#pragma unroll
        for (int i = 0; i < 8; ++i) { const unsigned g = sc[i], q = sc[8 + i]; if (i < w) { og += g; oe += q; } totg += g; }
        unsigned pg = og + sg - ngt, pe = oe + se - neq;
        const unsigned need = (unsigned)CAP - totg;
        unsigned iv[4] = {0u, 0u, 0u, 0u};
#pragma unroll
        for (int i = 0; i < 8; ++i) {
            const bool gt = key[i] > Tk, eq = key[i] == Tk; const int s = 8 * tid + i;
            const bool sel = gt || (eq && pe < need);
            const unsigned slot = pg + (pe < need ? pe : need);
            if (sel) { p.ROWL[(size_t)e * ME + b * CAP + slot] = b * S + s; p.WTS[(size_t)e * ME + b * CAP + slot] = __uint_as_float(key[i]); }
            iv[i >> 1] |= (sel ? (slot & 0xffffu) : 0xffffu) << (16 * (i & 1));
            pg += gt; pe += eq;
        }
        *(GAS u32x4*)(p.INV + (size_t)be * S + 8 * tid) = (u32x4){iv[0], iv[1], iv[2], iv[3]};
    }
    __syncthreads();
}

__device__ __forceinline__ void phase_final(const Ctx& X0, const P& p) {
    Ctx X = X0; X.tid = (int)threadIdx.x; asm volatile("" : "+v"(X.tid)); X.lane = X.tid & 63;
    const int lane = X.lane, RPW = T / X.G, base = X.vcu * RPW, b = base >> 12;
    f32x4 g2v[4], fgv[4];
#pragma unroll
    for (int j = 0; j < 4; ++j) { g2v[j] = *(const f32x4*)(p.MOD + (size_t)b * NMOD * D + 5 * D + 4 * lane + 256 * j) * (YB_F8 ? 1.f / epi::YB_SC : 1.f); fgv[j] = *(const f32x4*)(p.final_g + 4 * lane + 256 * j); }
    for (int i = X.wave; i < RPW; i += NWAVES) {
        const int m = base + i; float* hr = p.out + (size_t)m * D;
        f32x4 v[4];
#if H_DELTA
#pragma unroll
        for (int j = 0; j < 4; ++j) { const u32x2 dw = __builtin_nontemporal_load((const GAS u32x2*)(p.DELTA + (size_t)m * D + 4 * lane + 256 * j));
            v[j] = __builtin_nontemporal_load((const GAS f32x4*)(p.x + (size_t)m * D + 4 * lane + 256 * j)) + (f32x4){bf_lo(dw.x), bf_hi(dw.x), bf_lo(dw.y), bf_hi(dw.y)}; }
#else
#pragma unroll
        for (int j = 0; j < 4; ++j) v[j] = *(const GAS f32x4*)(hr + 4 * lane + 256 * j);
#endif
        const int myslot = (lane < E) ? (int)p.INV[((size_t)(b * E + lane)) * S + (m & (S - 1))] : -1;
        f32x4 y[4];
#pragma unroll
        for (int q = 0; q < 4; ++q) y[q] = (f32x4){0.f, 0.f, 0.f, 0.f};
#pragma unroll
        for (int e = 0; e < E; ++e) { const int slot = __builtin_amdgcn_readlane(myslot, e);
            if (slot >= 0) { const size_t yo = ((size_t)e * ME + b * CAP + slot) * D;
#pragma unroll
                for (int j = 0; j < 4; ++j) {
                    if (YB_F8) { const unsigned wv = __builtin_nontemporal_load((const GAS unsigned*)((const unsigned char*)p.YB + yo + 4 * lane + 256 * j));
                        const f32x2 lo2 = __builtin_amdgcn_cvt_pk_f32_fp8((int)wv, false), hi2 = __builtin_amdgcn_cvt_pk_f32_fp8((int)wv, true); y[j] += (f32x4){lo2[0], lo2[1], hi2[0], hi2[1]}; }
                    else { const u32x2 wv = *(const GAS u32x2*)(p.YB + yo + 4 * lane + 256 * j); y[j] += (f32x4){bf_lo(wv.x), bf_hi(wv.x), bf_lo(wv.y), bf_hi(wv.y)}; } } } }
        float ss = 0.f;
#pragma unroll
        for (int j = 0; j < 4; ++j) { const f32x4 tt = v[j] + g2v[j] * y[j]; v[j] = tt; ss += (tt[0] * tt[0] + tt[1] * tt[1]) + (tt[2] * tt[2] + tt[3] * tt[3]); }
        const float rstd = 1.f / sqrtf(wave_sum(ss) * (1.f / D) + 1e-6f);
#pragma unroll
        for (int j = 0; j < 4; ++j) __builtin_nontemporal_store(v[j] * rstd * fgv[j], (GAS f32x4*)(hr + 4 * lane + 256 * j));
    }
}

constexpr size_t MiB = 1u << 20;
constexpr size_t WS_CTL = 0, CTL_ZERO_BYTES = 1 * MiB;
constexpr size_t WS_MOD = 1 * MiB, WS_AFF = 2 * MiB, WS_ROWL = 4 * MiB, WS_WTS = WS_ROWL + 256 * 1024, WS_INV = WS_WTS + 256 * 1024;
constexpr size_t WS_W2F = 6 * MiB, WS_WIN = 10 * MiB, WS_WCONV = 18 * MiB, WS_WFOUR = 19 * MiB, WS_WOUT = 21 * MiB;
constexpr size_t WS_WGU = 24 * MiB, WS_WDOWN = 152 * MiB, WS_U = 216 * MiB, WS_R1 = 280 * MiB, WS_END = 536 * MiB;
constexpr size_t WS_GP = WS_R1, WS_D256 = 23 * MiB, WS_YCONV = WS_R1, WS_V = WS_R1 + 64 * MiB, WS_FT = WS_R1 + 96 * MiB, WS_YFOUR = WS_R1 + 64 * MiB;
constexpr size_t WS_YRI = WS_R1 + 128 * MiB, WS_MERGED = WS_R1 + 128 * MiB, WS_ACONV = WS_R1 + 192 * MiB, WS_ACT = WS_R1 + 128 * MiB  , WS_YB = WS_WGU, WS_DELTA = WS_R1  ;
static_assert(MOE_F8 || !H_DELTA, "the workspace map places the 128 MiB fp8 ACT beside DELTA; a bf16 ACT (256 MiB) needs H_DELTA = 0");
constexpr int LDS_BYTES = 147456, RING_BYTES = 131072, MISC_OFF = RING_BYTES + 320;


#ifndef BARRIER_KIND
#define BARRIER_KIND 2
#endif
#define RLX_AGENT __ATOMIC_RELAXED, __HIP_MEMORY_SCOPE_AGENT
#define XB_TMO      128
#define XB_XCNT(j)  (256  + 64 * (j))
#define XB_XSUB(j)  (1280 + 64 * (j))
#define XB_XGEN(j)  (2304 + 64 * (j))
#define XB_TOP      3328
#define XB_TOPGEN   3392
#define XCD_BAR_WORDS 3456
#define XB_SPIN_CAP (1u << 18)
__device__ __forceinline__ unsigned xb_ld(unsigned* p)              { return __hip_atomic_load(p, __ATOMIC_RELAXED, __HIP_MEMORY_SCOPE_AGENT); }
__device__ __forceinline__ unsigned xb_add(unsigned* p, unsigned v) { return __hip_atomic_fetch_add(p, v, __ATOMIC_RELAXED, __HIP_MEMORY_SCOPE_AGENT); }
__device__ __forceinline__ unsigned xb_xcc_id() { return (unsigned)__builtin_amdgcn_s_getreg((3 << 11) | 20) & 0xFu; }
#define XB_SPIN(cond, bar) do { unsigned _sp = 0; while (cond) { __builtin_amdgcn_s_sleep(1); \
    if ((++_sp & 255u) == 0u) { if (xb_ld(&(bar)[XB_TMO])) break; if (_sp > XB_SPIN_CAP) { atomicAdd(&(bar)[XB_TMO], 1u); break; } } } } while (0)
struct XcdBarrier { unsigned* bar; unsigned x; volatile LAS unsigned* st; };
__device__ __forceinline__ XcdBarrier xcd_barrier_post(unsigned* bar, volatile LAS unsigned* st) {
    XcdBarrier b; b.bar = bar; b.x = xb_xcc_id(); b.st = st;
    if (threadIdx.x == 0) (void)xb_add(&bar[XB_XCNT(b.x)], 1u);
    return b;
}
__device__ __forceinline__ void xcd_barrier_complete(unsigned* bar, unsigned x, unsigned& nloc, unsigned& nx) {
    const unsigned G = gridDim.x * gridDim.y * gridDim.z;
    unsigned sum, cnt, mine, sp = 0u;
    for (;;) {
        sum = 0u; cnt = 0u; mine = 0u;
#pragma unroll
        for (unsigned j = 0; j < 16; ++j) { const unsigned c = xb_ld(&bar[XB_XCNT(j)]); sum += c; cnt += (c > 0u) ? 1u : 0u; mine = (j == x) ? c : mine; }
        if (sum == G) break;
        __builtin_amdgcn_s_sleep(1);
        if ((++sp & 255u) == 0u) { if (xb_ld(&bar[XB_TMO])) break; if (sp > XB_SPIN_CAP) { atomicAdd(&bar[XB_TMO], 1u); break; } }
    }
    nloc = mine > 0u ? mine : 1u; nx = cnt > 0u ? cnt : 1u;
}
__device__ __forceinline__ void xcd_barrier(const XcdBarrier& b) {
    asm volatile("s_waitcnt vmcnt(0)" ::: "memory");
    __syncthreads();
    if (threadIdx.x == 0) {
        unsigned* bar = b.bar;
        __builtin_amdgcn_s_waitcnt(0);
        unsigned nloc = b.st[0], nx = b.st[1];
        if (nloc == 0u) { xcd_barrier_complete(bar, b.x, nloc, nx); b.st[0] = nloc; b.st[1] = nx; }
        const unsigned old = xb_add(&bar[XB_XSUB(b.x)], 1u);
        const unsigned gen = old / nloc;
        if (old + 1u == (gen + 1u) * nloc) {
            __builtin_amdgcn_fence(__ATOMIC_RELEASE, "agent");
            asm volatile("s_waitcnt vmcnt(0)" ::: "memory");
            const unsigned og = xb_add(&bar[XB_TOP], 1u);
            const unsigned tg = og / nx;
            if (og + 1u == (tg + 1u) * nx) xb_add(&bar[XB_TOPGEN], 1u);
            else XB_SPIN(xb_ld(&bar[XB_TOPGEN]) == tg, bar);
            __builtin_amdgcn_fence(__ATOMIC_ACQUIRE, "agent");
            xb_add(&bar[XB_XGEN(b.x)], 1u);
            asm volatile("s_waitcnt vmcnt(0)" ::: "memory");
        } else {
            XB_SPIN(xb_ld(&bar[XB_XGEN(b.x)]) == gen, bar);
            __builtin_amdgcn_fence(__ATOMIC_ACQUIRE, "agent");
            asm volatile("s_waitcnt vmcnt(0)" ::: "memory");
        }
    }
    __syncthreads();
}
constexpr int CW_BAR = 4096;

struct Args { P p; unsigned* ctl; int ph_lo, ph_hi; };

__global__ void __launch_bounds__(NTHR, 2) mk_fwd(Args args) {
    extern __shared__ __attribute__((aligned(16))) unsigned char lds_raw[];
    Ctx X; X.lds = (LAS unsigned char*)lds_raw; X.tid = threadIdx.x; X.lane = X.tid & 63; X.wave = __builtin_amdgcn_readfirstlane(X.tid >> 6);
    X.G = gridDim.x; { const int bx = blockIdx.x; X.vcu = (X.G % 8 == 0) ? (bx % 8) * (X.G / 8) + bx / 8 : bx; }
    const P& p = args.p; const int lo = args.ph_lo, hi = args.ph_hi;
    const int cid = (int)blockIdx.x;
#define IN(k) (lo <= (k) && (k) < hi)
    for (int u = X.tid; u < (LDS_BYTES - RING_BYTES) / 4; u += NTHR) ((LAS unsigned*)(X.lds + RING_BYTES))[u] = 0u;
    __syncthreads();
#if BARRIER_KIND == 1
    cooperative_groups::grid_group cgrid = cooperative_groups::this_grid();
#define GRID_BAR() do { if (hi - lo > 1) cgrid.sync(); } while (0)
#else
    XcdBarrier xbar = xcd_barrier_post(args.ctl + CW_BAR, (volatile LAS unsigned*)(X.lds + MISC_OFF));
#define GRID_BAR() do { if (hi - lo > 1) xcd_barrier(xbar); } while (0)
#endif
#ifdef PROBE_A
    volatile unsigned long long* ts = (volatile unsigned long long*)(args.ctl + 65536);
    int n_stamp = 0;
#define STAMP() do { if (blockIdx.x == 0 && X.tid == 0) ts[n_stamp] = __builtin_amdgcn_s_memrealtime(); ++n_stamp; } while (0)
#else
#define STAMP() do { } while (0)
#endif
    STAMP();
    if (IN(0)) { phase_p0a(X, p); GRID_BAR(); STAMP(); }
    if (IN(1)) { phase_p0b(X, p); GRID_BAR(); STAMP(); }
    if (IN(2)) {
        { pg8::SchedDense Sd; Sd.init(p.U, p.Wt_in, T, 2 * CW, D, X.G, cid); epi::EpiGlu Ep{p.V, p.b_in};
          pg8::gemm_phase<epi::EpiGlu, pg8::SchedDense, false>(X.lds, 2 * D, Sd, Ep); }
        { pg8::SchedDense Sd; Sd.init(p.Wt_in + (size_t)(2 * CW) * D, p.U, FW, T, D, X.G, cid); epi::EpiFT Ep{p.FT, p.b_in + 2 * CW};
          pg8::gemm_phase<epi::EpiFT, pg8::SchedDense, false>(X.lds, 2 * D, Sd, Ep); }
        GRID_BAR(); STAMP();
    }
    if (IN(3)) {
        phase_conv(X, p);
        phase_fftA(X, p);
        GRID_BAR(); STAMP();
        { pg8::SchedDense Sd; Sd.init(p.D256, p.GP, 512, Bn * 16 * FW, 512, X.G, cid); epi::EpiFFT Ep{p.YRI};
          pg8::gemm_phase<epi::EpiFFT, pg8::SchedDense, false>(X.lds, 2 * 512, Sd, Ep); }
        GRID_BAR(); STAMP();
    }
    if (IN(4)) {
        { pg8::SchedDense Sd; Sd.init(p.ACONV, p.Wt_conv, T, D, CW, X.G, cid); epi::EpiBias Ep{p.YCONV, D, p.cb_out};
          pg8::gemm_phase<epi::EpiBias, pg8::SchedDense, false>(X.lds, 2 * CW, Sd, Ep); }
        { pg8::SchedDense Sd; Sd.init(p.YRI, p.Wt_four, T, D, 2 * FW, X.G, cid); epi::EpiBias Ep{p.YFOUR, D, p.four_b};
          pg8::gemm_phase<epi::EpiBias, pg8::SchedDense, false>(X.lds, 4 * FW, Sd, Ep); }
        GRID_BAR(); STAMP();
    }
    if (IN(5)) {
        pg8::SchedDense Sd; Sd.init(p.U, p.Wt_in + (size_t)(2 * CW + FW) * D, T, 2 * D, D, X.G, cid); epi::EpiMerge Ep{p.MERGED, p.YCONV, p.YFOUR, p.b_in};
        pg8::gemm_phase<epi::EpiMerge, pg8::SchedDense, false>(X.lds, 2 * D, Sd, Ep);
        GRID_BAR(); STAMP();
    }
    if (IN(6)) {
        pg8::SchedDense Sd; Sd.init(p.MERGED, p.Wt_out, T, D, D, X.G, cid);
#if H_DELTA
        epi::EpiDelta Ep{p.DELTA, p.MOD + 2 * D, p.b_out};
        pg8::gemm_phase<epi::EpiDelta, pg8::SchedDense, false>(X.lds, 2 * D, Sd, Ep);
#else
        epi::EpiResid Ep{p.x, p.out, p.MOD + 2 * D, p.b_out};
        pg8::gemm_phase<epi::EpiResid, pg8::SchedDense, false>(X.lds, 2 * D, Sd, Ep);
#endif
        GRID_BAR(); STAMP();
    }
    if (IN(7)) { phase_router(X, p, H_DELTA ? p.x : p.out); GRID_BAR(); STAMP(); }
    if (IN(8)) { phase_topk(X, p); GRID_BAR(); STAMP(); }
    if (IN(9)) {
        constexpr int esz = MOE_F8 ? 1 : 2;
        pg8::SchedG1 Sd{(const char*)p.U, (const char*)p.Wt_gu, p.ROWL, X.G, cid, esz}; epi::EpiSwiglu<MOE_F8 != 0> Ep{p.ACT};
        pg8::gemm_phase<epi::EpiSwiglu<MOE_F8 != 0>, pg8::SchedG1, true, MOE_F8 != 0>(X.lds, D * esz, Sd, Ep, epi::MX_W, epi::MX_U);
        GRID_BAR(); STAMP();
    }
    if (IN(10)) {
        constexpr int esz = MOE_F8 ? 1 : 2;
        pg8::SchedG2 Sd{(const char*)p.ACT, (const char*)p.Wt_down, X.G, cid, esz}; epi::EpiScaleW Ep{p.YB, p.WTS};
        pg8::gemm_phase<epi::EpiScaleW, pg8::SchedG2, false, MOE_F8 != 0>(X.lds, F * esz, Sd, Ep, epi::MX_W, epi::MX_ACT);
        GRID_BAR(); STAMP();
    }
    if (IN(11)) { phase_final(X, p); }
#ifdef PROBE_A
    STAMP();
    if (blockIdx.x == 0 && X.tid == 0) { const unsigned long long dt = (ts[PROBE_B] - ts[PROBE_A]) * PROBE_AMP, t0 = __builtin_amdgcn_s_memrealtime();
        while (__builtin_amdgcn_s_memrealtime() - t0 < dt) __builtin_amdgcn_s_sleep(8); }
#endif
#undef IN
}

extern "C" void kernel_launch(void* const* d_in, const int* in_sizes, int n_in, void* d_out, int out_size, void* d_ws, size_t ws_size, hipStream_t stream) {
    static int grid = 0;
    if (grid == 0) {
        if (n_in != 23 || in_sizes[0] != T * D || out_size != T * D || ws_size < WS_END) { fprintf(stderr, "kernel_launch: unexpected shapes / workspace (%d inputs, ws %zu)\n", n_in, ws_size); grid = -1; return; }
        int dev = 0, cus = 0;
        if (hipGetDevice(&dev) != hipSuccess || hipDeviceGetAttribute(&cus, hipDeviceAttributeMultiprocessorCount, dev) != hipSuccess) { grid = -1; return; }
        if (hipFuncSetAttribute((const void*)mk_fwd, hipFuncAttributeMaxDynamicSharedMemorySize, LDS_BYTES) != hipSuccess) { fprintf(stderr, "kernel_launch: hipFuncSetAttribute failed\n"); grid = -1; return; }
        if (cus < 256) { fprintf(stderr, "kernel_launch: built for a 256-CU device (one workgroup per CU), found %d CUs\n", cus); grid = -1; return; }
        int per_cu = 0;
        if (hipOccupancyMaxActiveBlocksPerMultiprocessor(&per_cu, (const void*)mk_fwd, NTHR, LDS_BYTES) != hipSuccess || per_cu < 1) { fprintf(stderr, "kernel_launch: occupancy query reports %d workgroups per CU\n", per_cu); grid = -1; return; }
        grid = 256;
    }
    if (grid < 0) return;
    unsigned char* ws = (unsigned char*)d_ws;
    Args a{};
    P& p = a.p;
    p.x = (const float*)d_in[0]; p.c = (const float*)d_in[1]; p.ada_w = (const float*)d_in[2]; p.ada_b = (const float*)d_in[3]; p.norm1_g = (const float*)d_in[4];
    p.w_in = (const float*)d_in[5]; p.b_in = (const float*)d_in[6]; p.dw_w = (const float*)d_in[7]; p.dw_b = (const float*)d_in[8]; p.cln_g = (const float*)d_in[9]; p.cln_b = (const float*)d_in[10];
    p.cw_out = (const float*)d_in[11]; p.cb_out = (const float*)d_in[12]; p.four_w = (const float*)d_in[13]; p.four_b = (const float*)d_in[14]; p.w_out = (const float*)d_in[15]; p.b_out = (const float*)d_in[16];
    p.norm2_g = (const float*)d_in[17]; p.router_w = (const float*)d_in[18]; p.w_gate = (const float*)d_in[19]; p.w_up = (const float*)d_in[20]; p.w_down = (const float*)d_in[21]; p.final_g = (const float*)d_in[22];
    p.out = (float*)d_out;
    p.MOD = (float*)(ws + WS_MOD); p.W2F = (float*)(ws + WS_W2F); p.AFF = (float*)(ws + WS_AFF); p.ROWL = (int*)(ws + WS_ROWL); p.WTS = (float*)(ws + WS_WTS); p.INV = (short*)(ws + WS_INV);
    p.Wt_in = (bf16_t*)(ws + WS_WIN); p.Wt_conv = (bf16_t*)(ws + WS_WCONV); p.Wt_four = (bf16_t*)(ws + WS_WFOUR); p.Wt_out = (bf16_t*)(ws + WS_WOUT);
    p.D256 = (bf16_t*)(ws + WS_D256); p.GP = (bf16_t*)(ws + WS_GP); p.Wt_gu = (bf16_t*)(ws + WS_WGU); p.Wt_down = (bf16_t*)(ws + WS_WDOWN);
    p.U = (bf16_t*)(ws + WS_U); p.V = (bf16_t*)(ws + WS_V); p.FT = (bf16_t*)(ws + WS_FT); p.ACONV = (bf16_t*)(ws + WS_ACONV); p.YRI = (bf16_t*)(ws + WS_YRI);
    p.YCONV = (bf16_t*)(ws + WS_YCONV); p.YFOUR = (bf16_t*)(ws + WS_YFOUR); p.MERGED = (bf16_t*)(ws + WS_MERGED); p.ACT = (bf16_t*)(ws + WS_ACT); p.YB = (bf16_t*)(ws + WS_YB); p.DELTA = (bf16_t*)(ws + WS_DELTA);
    (void)hipMemsetAsync(ws + WS_CTL, 0, CTL_ZERO_BYTES, stream);
    a.ctl = (unsigned*)(ws + WS_CTL);
    a.ph_lo = 0; a.ph_hi = 12;
#ifndef PLAIN_LAUNCH
#define PLAIN_LAUNCH 0
#endif
#if PLAIN_LAUNCH
    hipLaunchKernelGGL(mk_fwd, dim3(grid), dim3(NTHR), LDS_BYTES, stream, a);
#else
    { void* kargs[] = {&a}; hipError_t le = hipLaunchCooperativeKernel((const void*)mk_fwd, dim3(grid), dim3(NTHR), kargs, LDS_BYTES, stream);
      if (le != hipSuccess) fprintf(stderr, "kernel_launch: cooperative launch failed: %s\n", hipGetErrorString(le)); }
#endif
}
```

```cpp
#include <hip/hip_runtime.h>
#include <hip/hip_cooperative_groups.h>
#include <cstdio>
#include <cstdint>

#define LAS __attribute__((address_space(3)))
#define GAS __attribute__((address_space(1)))
typedef unsigned short bf16_t;
typedef short bf16x8 __attribute__((ext_vector_type(8)));
typedef float f32x4 __attribute__((ext_vector_type(4)));
typedef float f32x2 __attribute__((ext_vector_type(2)));
typedef unsigned u32x4 __attribute__((ext_vector_type(4)));
typedef unsigned u32x2 __attribute__((ext_vector_type(2)));
typedef int i32x8 __attribute__((ext_vector_type(8)));

constexpr int Bn = 8, S = 4096, D = 1024, T = Bn * S;
constexpr int CW = 512, CK = 31, FW = 512, FG = 4, FGD = 128;
constexpr int INC = 2 * CW + FW + 2 * D;
constexpr int E = 16, CAP = 2 * S / E;
constexpr int F = 2 * D;
constexpr int NMOD = 6;
constexpr int ME = Bn * CAP;
constexpr int NWAVES = 8, NTHR = 512;

__device__ __forceinline__ float sigmoidf_(float x) { return __builtin_amdgcn_rcpf(1.f + __expf(-x)); }
__device__ __forceinline__ float siluf_(float x) { return x * __builtin_amdgcn_rcpf(1.f + __expf(-x)); }
__device__ __forceinline__ unsigned f2bf(float f) { unsigned u = __builtin_bit_cast(unsigned, f); return (u + 0x7fffu + ((u >> 16) & 1u)) >> 16; }
__device__ __forceinline__ unsigned pk2(float lo, float hi) { return f2bf(lo) | (f2bf(hi) << 16); }
__device__ __forceinline__ unsigned cvt_pk_bf16(float lo, float hi) { unsigned r; asm volatile("v_cvt_pk_bf16_f32 %0, %1, %2" : "=v"(r) : "v"(lo), "v"(hi)); return r; }
__device__ __forceinline__ float bf_lo(unsigned w) { return __builtin_bit_cast(float, w << 16); }
__device__ __forceinline__ float bf_hi(unsigned w) { return __builtin_bit_cast(float, w & 0xffff0000u); }
__device__ __forceinline__ float wave_sum(float v) {
#pragma unroll
    for (int o = 1; o < 64; o <<= 1) v += __shfl_xor(v, o);
    return v;
}
__device__ __forceinline__ u32x2 pack8_f8(const f32x4 v0, const f32x4 v1, const float sc) {
    unsigned a = 0u, b = 0u;
    a = __builtin_amdgcn_cvt_pk_fp8_f32(v0[0] * sc, v0[1] * sc, a, false); a = __builtin_amdgcn_cvt_pk_fp8_f32(v0[2] * sc, v0[3] * sc, a, true);
    b = __builtin_amdgcn_cvt_pk_fp8_f32(v1[0] * sc, v1[1] * sc, b, false); b = __builtin_amdgcn_cvt_pk_fp8_f32(v1[2] * sc, v1[3] * sc, b, true);
    return (u32x2){a, b};
}
#define LDS_WAIT() asm volatile("s_waitcnt lgkmcnt(0)" ::: "memory")
#define VM_WAIT() asm volatile("s_waitcnt vmcnt(0)" ::: "memory")

namespace pg8 {
constexpr int BM = 256, BK = 64, HALF = 128, HTB = HALF * BK * 2  , STAGE_BYTES = 8 * HTB, NXCD = 8, WGM = 8;
__host__ __device__ __forceinline__ int lds_byte(int r, int c) { const int st = (r >> 4) * 2 + (c >> 5), rr = r & 15, cc = c & 31, ob = rr * 64 + cc * 2; return st * 1024 + (ob ^ (((ob >> 9) & 1) << 5)); }
__host__ __device__ __forceinline__ void stage_rc(int b, int& R, int& C) { const int st = b / 1024, sb = b % 1024, swz = sb ^ (((sb >> 9) & 1) << 5); R = (st >> 1) * 16 + swz / 64; C = (st & 1) * 32 + (swz % 64) / 2; }
__host__ __device__ __forceinline__ int f8_off(int r, int fq) { const int rr = r & 15; return ((r >> 4) * 2 + (fq >> 1)) * 1024 + ((rr * 64 + 32 * (fq & 1)) ^ ((rr >> 3) << 5)); }
__host__ __device__ __forceinline__ int perm32(int rho) { const int n = rho >> 4, i = rho & 15; return 8 * (i >> 2) + 4 * n + (i & 3); }

struct Unit { const char* a; const char* b; const int* rows; int pm, pn, e; };

template <class Epi, class Sched, bool GATHER, bool F8 = false>
__device__ __forceinline__ void gemm_phase(LAS unsigned char* lds, const int KB, const Sched& S, const Epi& E, const int sw = 0x7f7f7f7f, const int sx = 0x7f7f7f7f) {
    int tid_ = threadIdx.x; asm volatile("" : "+v"(tid_));
    const int tid = tid_, wid = __builtin_amdgcn_readfirstlane(tid >> 6), lane = tid & 63, wr = wid >> 2, wc = wid & 3, fr = lane & 15, fq = lane >> 4;
    const int nt = KB / (BK * 2);
    int swv = sw, sxv = sx; if constexpr (F8) { asm volatile("" : "+v"(swv), "+v"(sxv)); }
    unsigned voffA[2], voffB[2]; int R0, C0;
#pragma unroll
    for (int i = 0; i < 2; ++i) { int R, C; stage_rc(tid * 16 + i * 8192, R, C); const int Rb = Epi::PERM ? ((R & ~31) + perm32(R & 31)) : R;
        voffA[i] = (unsigned)(R * KB + C * 2); voffB[i] = (unsigned)(Rb * KB + C * 2); if (i == 0) { R0 = R; C0 = C; } }
    const size_t kstep = (size_t)(BK * 2);
    const size_t hstep = (size_t)HALF * KB;
    const unsigned ldsw = (unsigned)wid * 1024u;
    const int aoff = lds_byte(wr * 64 + fr, fq * 8), boff = lds_byte(wc * 32 + fr, fq * 8);
#define PG8_SA(b, h) (((b) * 2 + (h)) * HTB)
#define PG8_SB(b, h) ((4 + (b) * 2 + (h)) * HTB)
#define PG8_STAGE(bufoff, gbase, voff) do { _Pragma("unroll") for (int _i = 0; _i < 2; ++_i) \
        __builtin_amdgcn_global_load_lds((const unsigned*)((const char*)(gbase) + (voff)[_i]), (LAS unsigned*)(lds + (bufoff) + ldsw + _i * 8192), 16, 0, 0); } while (0)
#define PG8_STGA(bufoff, p, h, v) do { if constexpr (GATHER) { PG8_STAGE(bufoff, p, (v) + 2 * (h)); } else { PG8_STAGE(bufoff, (p) + (h) * hstep, voffA); } } while (0)
#define PG8_LD8(p) __builtin_bit_cast(i32x8, __builtin_shufflevector(*(const LAS u32x4*)(p), *(const LAS u32x4*)((p) + 1024), 0, 1, 2, 3, 4, 5, 6, 7))
#define PG8_LDA(dst, b, h) do { if constexpr (F8) { _Pragma("unroll") for (int m = 0; m < 4; ++m) dst##8[m] = PG8_LD8(lds + PG8_SA(b, h) + aoff + m * 2048); } \
      else { _Pragma("unroll") for (int m = 0; m < 4; ++m) _Pragma("unroll") for (int k = 0; k < 2; ++k) dst[m][k] = *(const LAS bf16x8*)(lds + PG8_SA(b, h) + aoff + m * 2048 + k * 1024); } } while (0)
#define PG8_LDB(dst, b, h) do { if constexpr (F8) { _Pragma("unroll") for (int n = 0; n < 2; ++n) dst##8[n] = PG8_LD8(lds + PG8_SB(b, h) + boff + n * 2048); } \
      else { _Pragma("unroll") for (int n = 0; n < 2; ++n) _Pragma("unroll") for (int k = 0; k < 2; ++k) dst[n][k] = *(const LAS bf16x8*)(lds + PG8_SB(b, h) + boff + n * 2048 + k * 1024); } } while (0)
#define PG8_MMA(ai, bj, At, Bt) do { __builtin_amdgcn_s_setprio(1); if constexpr (F8) { _Pragma("unroll") for (int m = 0; m < 4; ++m) _Pragma("unroll") for (int n = 0; n < 2; ++n) \
        asm volatile("v_mfma_scale_f32_16x16x128_f8f6f4 %0, %1, %2, %0, %3, %4 op_sel_hi:[0,0,0]" : "+v"(acc[ai][bj][m][n]) : "v"(Bt##8[n]), "v"(At##8[m]), "v"(swv), "v"(sxv)); } \
      else { _Pragma("unroll") for (int m = 0; m < 4; ++m) _Pragma("unroll") for (int n = 0; n < 2; ++n) _Pragma("unroll") for (int k = 0; k < 2; ++k) \
        acc[ai][bj][m][n] = __builtin_amdgcn_mfma_f32_16x16x32_bf16(Bt[n][k], At[m][k], acc[ai][bj][m][n], 0, 0, 0); } __builtin_amdgcn_s_setprio(0); } while (0)
#define PG8_WAIT_V(n) asm volatile("s_waitcnt vmcnt(" #n ")" ::: "memory")
#define PG8_WAIT_L(n) asm volatile("s_waitcnt lgkmcnt(" #n ")" ::: "memory")
#define PG8_BAR __builtin_amdgcn_s_barrier()
#define PG8_SCHED __builtin_amdgcn_sched_barrier(0)
#define PG8_ROWS(u, v) do { if constexpr (GATHER) { _Pragma("unroll") for (int _h = 0; _h < 2; ++_h) _Pragma("unroll") for (int _i = 0; _i < 2; ++_i) \
        v[_h * 2 + _i] = (unsigned)((u).rows[_h * 128 + R0 + 64 * _i] * KB + C0 * 2); } } while (0)
    Unit cur, nxt; int ui = 0;
    if (!S.next(0, cur)) return;
    f32x4 acc[2][2][4][2];
#pragma unroll
    for (int a = 0; a < 2; ++a)
#pragma unroll
        for (int b = 0; b < 2; ++b)
#pragma unroll
            for (int m = 0; m < 4; ++m)
#pragma unroll
                for (int n = 0; n < 2; ++n) acc[a][b][m][n] = (f32x4){0.f, 0.f, 0.f, 0.f};
    bf16x8 At[4][2], B0[2][2], B1[2][2]; i32x8 At8[4], B08[2], B18[2];
    unsigned vAc[4] = {0u, 0u, 0u, 0u}, vAn[4] = {0u, 0u, 0u, 0u}, vW[4] = {0u, 0u, 0u, 0u};
    PG8_ROWS(cur, vAc);
    const char* cA = cur.a; const char* cB = cur.b;
    PG8_STAGE(PG8_SB(0, 0), cB, voffB); PG8_STAGE(PG8_SB(0, 1), cB + hstep, voffB); PG8_STGA(PG8_SA(0, 0), cA, 0, vAc); PG8_STGA(PG8_SA(0, 1), cA, 1, vAc);
    if (wr == 1) PG8_BAR;
    PG8_WAIT_V(2); PG8_BAR;
    PG8_STAGE(PG8_SB(1, 0), cB + kstep, voffB); PG8_STGA(PG8_SA(1, 0), cA + kstep, 0, vAc); PG8_STAGE(PG8_SB(1, 1), cB + hstep + kstep, voffB);
    PG8_WAIT_V(6); PG8_BAR;
    for (;;) {
        const bool has_next = S.next(ui + 1, nxt);
        if (has_next) { PG8_ROWS(nxt, vAn); } else {
#pragma unroll
            for (int j = 0; j < 4; ++j) vAn[j] = vAc[j]; }
        const char* nA = has_next ? nxt.a : cA; const char* nB = has_next ? nxt.b : cB;
        for (int t = 0; t < nt; t += 2) {
            const bool last = (t == nt - 2);
            const char* a1 = cA + (size_t)(t + 1) * kstep;
            const char* a2 = last ? nA : cA + (size_t)(t + 2) * kstep; const char* b2 = last ? nB : cB + (size_t)(t + 2) * kstep;
            const char* a3 = a2 + kstep; const char* b3 = b2 + kstep;
            if constexpr (GATHER) {
                if (last) { asm volatile("" ::: "memory");
#pragma unroll
                    for (int j = 0; j < 4; ++j) vW[j] = vAn[j]; }
                else {
#pragma unroll
                    for (int j = 0; j < 4; ++j) vW[j] = vAc[j]; } }
            PG8_LDB(B0, 0, 0); PG8_LDB(B1, 0, 1); PG8_SCHED; PG8_LDA(At, 0, 0); PG8_STGA(PG8_SA(1, 1), a1, 1, vAc);
            PG8_WAIT_V(8); PG8_WAIT_L(0); PG8_BAR; PG8_MMA(0, 0, At, B0); PG8_MMA(0, 1, At, B1); PG8_BAR; PG8_SCHED;
            PG8_LDA(At, 0, 1); PG8_STAGE(PG8_SB(0, 0), b2, voffB); PG8_STAGE(PG8_SB(0, 1), b2 + hstep, voffB); PG8_STGA(PG8_SA(0, 0), a2, 0, vW);
            PG8_WAIT_V(8); PG8_WAIT_L(0); PG8_BAR; PG8_MMA(1, 0, At, B0); PG8_MMA(1, 1, At, B1); PG8_BAR; PG8_SCHED;
            PG8_LDB(B0, 1, 0); PG8_LDB(B1, 1, 1); PG8_SCHED; PG8_LDA(At, 1, 0); PG8_STGA(PG8_SA(0, 1), a2, 1, vW);
            PG8_WAIT_V(8); PG8_WAIT_L(0); PG8_BAR; PG8_MMA(0, 0, At, B0); PG8_MMA(0, 1, At, B1); PG8_BAR; PG8_SCHED;
            PG8_LDA(At, 1, 1); PG8_STAGE(PG8_SB(1, 0), b3, voffB); PG8_STAGE(PG8_SB(1, 1), b3 + hstep, voffB); PG8_STGA(PG8_SA(1, 0), a3, 0, vW);
            PG8_WAIT_V(8); PG8_WAIT_L(0); PG8_BAR; PG8_MMA(1, 0, At, B0); PG8_MMA(1, 1, At, B1); PG8_BAR; PG8_SCHED;
        }
        if (wr == 0) PG8_BAR;
        if constexpr (F8) { asm volatile("s_nop 15\n\ts_nop 15" ::: "memory"); }
        E(acc, cur, wr, wc, fr, fq);
        if (!has_next) break;
#pragma unroll
        for (int a = 0; a < 2; ++a)
#pragma unroll
            for (int b = 0; b < 2; ++b)
#pragma unroll
                for (int m = 0; m < 4; ++m)
#pragma unroll
                    for (int n = 0; n < 2; ++n) acc[a][b][m][n] = (f32x4){0.f, 0.f, 0.f, 0.f};
        cur = nxt; cA = nA; cB = nB; ++ui;
#pragma unroll
        for (int j = 0; j < 4; ++j) vAc[j] = vAn[j];
        if (wr == 1) PG8_BAR;
    }
    PG8_WAIT_V(0);
    PG8_BAR;
#undef PG8_SA
#undef PG8_SB
#undef PG8_STAGE
#undef PG8_STGA
#undef PG8_LDA
#undef PG8_LDB
#undef PG8_MMA
#undef PG8_LD8
#undef PG8_WAIT_V
#undef PG8_WAIT_L
#undef PG8_BAR
#undef PG8_SCHED
#undef PG8_ROWS
}

struct SchedDense {
    const char* A; const char* Bt; int nM, nN, nwg, G, c; size_t tstep;
    __device__ void init(const void* A_, const void* Bt_, int M, int N, int K, int G_, int c_) { A = (const char*)A_; Bt = (const char*)Bt_; nM = M / BM; nN = N / BM; nwg = nM * nN; G = G_; c = c_; tstep = (size_t)BM * K * 2; }
    __device__ bool next(int i, Unit& u) const {
        const long L = (long)i * G + c; if (L >= nwg) return false;
        int wgid = (int)L; { const int q = nwg / NXCD, r = nwg % NXCD, xcd = wgid % NXCD, off = wgid / NXCD; wgid = (xcd < r ? xcd * (q + 1) : r * (q + 1) + (xcd - r) * q) + off; }
        const int nig = WGM * nN, gid = wgid / nig, fm = gid * WGM, gsz = (nM - fm) < WGM ? (nM - fm) : WGM;
        u.pm = fm + ((wgid % nig) % gsz); u.pn = (wgid % nig) / gsz; u.e = 0; u.rows = nullptr;
        u.a = A + (size_t)u.pm * tstep; u.b = Bt + (size_t)u.pn * tstep; return true;
    }
};
}

#ifndef H_DELTA
#define H_DELTA 1
#endif
#ifndef YB_F8
#define YB_F8 1
#endif
#ifndef MOE_F8
#define MOE_F8 1
#endif

namespace epi {
using pg8::Unit;
#define EPI_ROWS(ai, m) (128 * (ai) + 64 * wr + 16 * (m) + fr)
__device__ __forceinline__ u32x4 pack8(const f32x4 v0, const f32x4 v1) { u32x4 w; w.x = cvt_pk_bf16(v0[0], v0[1]); w.y = cvt_pk_bf16(v0[2], v0[3]); w.z = cvt_pk_bf16(v1[0], v1[1]); w.w = cvt_pk_bf16(v1[2], v1[3]); return w; }
__device__ __forceinline__ f32x4 sig4(const f32x4 v) { return (f32x4){sigmoidf_(v[0]), sigmoidf_(v[1]), sigmoidf_(v[2]), sigmoidf_(v[3])}; }
__device__ __forceinline__ f32x4 silu4(const f32x4 v) { return (f32x4){siluf_(v[0]), siluf_(v[1]), siluf_(v[2]), siluf_(v[3])}; }
__device__ __forceinline__ void unpack8(const u32x4 w, f32x4& v0, f32x4& v1) { v0 = (f32x4){bf_lo(w.x), bf_hi(w.x), bf_lo(w.y), bf_hi(w.y)}; v1 = (f32x4){bf_lo(w.z), bf_hi(w.z), bf_lo(w.w), bf_hi(w.w)}; }

struct EpiGlu {
    static constexpr bool PERM = true;
    bf16_t* V; const float* bias;
    __device__ __forceinline__ void operator()(const f32x4 (&acc)[2][2][4][2], const Unit& u, int wr, int wc, int fr, int fq) const {
        const int ch = u.pn * 128 + wc * 32 + 8 * fq;
        f32x4 ba[2], bg[2];
#pragma unroll
        for (int n = 0; n < 2; ++n) { ba[n] = *(const f32x4*)(bias + ch + 4 * n); bg[n] = *(const f32x4*)(bias + CW + ch + 4 * n); }
#pragma unroll
        for (int ai = 0; ai < 2; ++ai)
#pragma unroll
            for (int m = 0; m < 4; ++m) { const size_t row = (size_t)u.pm * 256 + EPI_ROWS(ai, m);
                const f32x4 v0 = (acc[ai][0][m][0] + ba[0]) * sig4(acc[ai][1][m][0] + bg[0]), v1 = (acc[ai][0][m][1] + ba[1]) * sig4(acc[ai][1][m][1] + bg[1]);
                *(u32x4*)(V + row * CW + ch) = pack8(v0, v1); }
    }
};
struct EpiFT {
    static constexpr bool PERM = true;
    bf16_t* FT; const float* bias;
    __device__ __forceinline__ void operator()(const f32x4 (&acc)[2][2][4][2], const Unit& u, int wr, int wc, int fr, int fq) const {
#pragma unroll
        for (int ai = 0; ai < 2; ++ai)
#pragma unroll
            for (int m = 0; m < 4; ++m) { const int ch = u.pm * 256 + EPI_ROWS(ai, m); const float bv = bias[ch];
#pragma unroll
                for (int bj = 0; bj < 2; ++bj) { const int tok = u.pn * 256 + bj * 128 + wc * 32 + 8 * fq; const int b = tok >> 12, s = tok & (S - 1);
                    *(u32x4*)(FT + ((size_t)(b * FW + ch) * S + s)) = pack8(acc[ai][bj][m][0] + bv, acc[ai][bj][m][1] + bv); } }
    }
};
struct EpiFFT {
    static constexpr bool PERM = true;
    bf16_t* YRI;
    __device__ __forceinline__ void operator()(const f32x4 (&acc)[2][2][4][2], const Unit& u, int wr, int wc, int fr, int fq) const {
        const int part = u.pm, chb = u.pn & 1, k2 = (u.pn >> 1) & 15, b = u.pn >> 5;
#pragma unroll
        for (int ai = 0; ai < 2; ++ai)
#pragma unroll
            for (int m = 0; m < 4; ++m) { const int k1 = EPI_ROWS(ai, m);
                bf16_t* rowp = YRI + ((size_t)(b * S + 16 * k1 + k2) * (2 * FW) + part * FW + chb * 256 + wc * 32 + 8 * fq);
#pragma unroll
                for (int bj = 0; bj < 2; ++bj) *(u32x4*)(rowp + bj * 128) = pack8(acc[ai][bj][m][0], acc[ai][bj][m][1]); }
    }
};
struct EpiBias {
    static constexpr bool PERM = true;
    bf16_t* O; int ldc; const float* bias;
    __device__ __forceinline__ void operator()(const f32x4 (&acc)[2][2][4][2], const Unit& u, int wr, int wc, int fr, int fq) const {
        const int col0 = u.pn * 256 + wc * 32 + 8 * fq;
        f32x4 bv[2][2];
#pragma unroll
        for (int bj = 0; bj < 2; ++bj)
#pragma unroll
            for (int n = 0; n < 2; ++n) bv[bj][n] = *(const f32x4*)(bias + col0 + bj * 128 + 4 * n);
#pragma unroll
        for (int ai = 0; ai < 2; ++ai)
#pragma unroll
            for (int m = 0; m < 4; ++m) { bf16_t* rowp = O + ((size_t)u.pm * 256 + EPI_ROWS(ai, m)) * ldc + col0;
#pragma unroll
                for (int bj = 0; bj < 2; ++bj) *(u32x4*)(rowp + bj * 128) = pack8(acc[ai][bj][m][0] + bv[bj][0], acc[ai][bj][m][1] + bv[bj][1]); }
    }
};
struct EpiMerge {
    static constexpr bool PERM = true;
    bf16_t* MG; const bf16_t* YC; const bf16_t* YF; const float* bias;
    __device__ __forceinline__ void operator()(const f32x4 (&acc)[2][2][4][2], const Unit& u, int wr, int wc, int fr, int fq) const {
        const int nn = u.pn * 128 + wc * 32 + 8 * fq;
        f32x4 b0[2], b1[2];
#pragma unroll
        for (int n = 0; n < 2; ++n) { b0[n] = *(const f32x4*)(bias + 2 * CW + FW + nn + 4 * n); b1[n] = *(const f32x4*)(bias + 2 * CW + FW + D + nn + 4 * n); }
#pragma unroll
        for (int ai = 0; ai < 2; ++ai)
#pragma unroll
            for (int m = 0; m < 4; ++m) { const size_t off = ((size_t)u.pm * 256 + EPI_ROWS(ai, m)) * D + nn;
                const u32x4 wc_ = *(const u32x4*)(YC + off), wf_ = *(const u32x4*)(YF + off);
                f32x4 c0, c1, f0, f1; unpack8(wc_, c0, c1); unpack8(wf_, f0, f1);
                const f32x4 v0 = sig4(acc[ai][0][m][0] + b0[0]) * c0 + sig4(acc[ai][1][m][0] + b1[0]) * f0;
                const f32x4 v1 = sig4(acc[ai][0][m][1] + b0[1]) * c1 + sig4(acc[ai][1][m][1] + b1[1]) * f1;
                *(u32x4*)(MG + off) = pack8(v0, v1); }
    }
};
struct EpiResid {
    static constexpr bool PERM = false;
    const float* X; float* H; const float* gate; const float* bias;
    __device__ __forceinline__ void operator()(const f32x4 (&acc)[2][2][4][2], const Unit& u, int wr, int wc, int fr, int fq) const {
        const int col0 = u.pn * 256 + wc * 32 + 4 * fq; const int b = (u.pm * 256) >> 12;
        const float* gp = gate + (size_t)b * NMOD * D + col0; const float* bp = bias + col0;
#pragma unroll
        for (int ai = 0; ai < 2; ++ai) {
            f32x4 xv[4][2][2];
#pragma unroll
            for (int m = 0; m < 4; ++m) { const size_t off = ((size_t)u.pm * 256 + EPI_ROWS(ai, m)) * D + col0;
#pragma unroll
                for (int bj = 0; bj < 2; ++bj)
#pragma unroll
                    for (int n = 0; n < 2; ++n) xv[m][bj][n] = *(const f32x4*)(X + off + bj * 128 + n * 16); }
#pragma unroll
            for (int bj = 0; bj < 2; ++bj)
#pragma unroll
                for (int n = 0; n < 2; ++n) { const f32x4 gv = *(const f32x4*)(gp + bj * 128 + n * 16), bv = *(const f32x4*)(bp + bj * 128 + n * 16);
#pragma unroll
                    for (int m = 0; m < 4; ++m) { const size_t off = ((size_t)u.pm * 256 + EPI_ROWS(ai, m)) * D + col0;
                        *(f32x4*)(H + off + bj * 128 + n * 16) = xv[m][bj][n] + gv * (acc[ai][bj][m][n] + bv); } }
            asm volatile("" ::: "memory");
        }
    }
};
struct EpiDelta {
    static constexpr bool PERM = true;
    bf16_t* DL; const float* gate; const float* bias;
    __device__ __forceinline__ void operator()(const f32x4 (&acc)[2][2][4][2], const Unit& u, int wr, int wc, int fr, int fq) const {
        const int col0 = u.pn * 256 + wc * 32 + 8 * fq; const int b = (u.pm * 256) >> 12;
        f32x4 bv[2][2], gv[2][2];
#pragma unroll
        for (int bj = 0; bj < 2; ++bj)
#pragma unroll
            for (int n = 0; n < 2; ++n) { bv[bj][n] = *(const f32x4*)(bias + col0 + bj * 128 + 4 * n); gv[bj][n] = *(const f32x4*)(gate + (size_t)b * NMOD * D + col0 + bj * 128 + 4 * n); }
#pragma unroll
        for (int ai = 0; ai < 2; ++ai)
#pragma unroll
            for (int m = 0; m < 4; ++m) { bf16_t* rowp = DL + ((size_t)u.pm * 256 + EPI_ROWS(ai, m)) * D + col0;
#pragma unroll
                for (int bj = 0; bj < 2; ++bj) *(u32x4*)(rowp + bj * 128) = pack8(gv[bj][0] * (acc[ai][bj][m][0] + bv[bj][0]), gv[bj][1] * (acc[ai][bj][m][1] + bv[bj][1])); }
    }
};
constexpr float ACT_SC = 2.f, U_SC = 4.f, W_SC = 64.f;
constexpr int MX_U = 0x7d7d7d7d, MX_ACT = 0x7e7e7e7e, MX_W = 0x79797979;
template <bool F8> struct EpiSwiglu {
    static constexpr bool PERM = true;
    void* ACT;
    __device__ __forceinline__ void operator()(const f32x4 (&acc)[2][2][4][2], const Unit& u, int wr, int wc, int fr, int fq) const {
        const int col = u.pn * 128 + wc * 32 + 8 * fq;
#pragma unroll
        for (int ai = 0; ai < 2; ++ai)
#pragma unroll
            for (int m = 0; m < 4; ++m) { const size_t row = (size_t)u.e * ME + u.pm * 256 + EPI_ROWS(ai, m);
                const f32x4 v0 = silu4(acc[ai][0][m][0]) * acc[ai][1][m][0], v1 = silu4(acc[ai][0][m][1]) * acc[ai][1][m][1];
                if constexpr (F8) *(u32x2*)((unsigned char*)ACT + row * F + col) = pack8_f8(v0, v1, ACT_SC);
                else *(u32x4*)((bf16_t*)ACT + row * F + col) = pack8(v0, v1); }
    }
};
constexpr float YB_SC = 32.f;
struct EpiScaleW {
    static constexpr bool PERM = true;
    void* YB; const float* W;
    __device__ __forceinline__ void operator()(const f32x4 (&acc)[2][2][4][2], const Unit& u, int wr, int wc, int fr, int fq) const {
        const int col0 = u.pn * 256 + wc * 32 + 8 * fq;
#pragma unroll
        for (int ai = 0; ai < 2; ++ai)
#pragma unroll
            for (int m = 0; m < 4; ++m) { const size_t row = (size_t)u.e * ME + u.pm * 256 + EPI_ROWS(ai, m); const float w = W[row];
#pragma unroll
                for (int bj = 0; bj < 2; ++bj) {
                    if (YB_F8) *(u32x2*)((unsigned char*)YB + row * D + col0 + bj * 128) = pack8_f8(acc[ai][bj][m][0], acc[ai][bj][m][1], w * YB_SC);
                    else *(u32x4*)((bf16_t*)YB + row * D + col0 + bj * 128) = pack8(acc[ai][bj][m][0] * w, acc[ai][bj][m][1] * w); } }
    }
};
#undef EPI_ROWS
}

namespace pg8 {
struct SchedG1 {
    const char* U; const char* W; const int* rowl; int G, c, esz;
    __device__ bool next(int i, Unit& u) const {
        int e;
        if (G == 256) { if (i >= 16) return false; const int xcd = c & 7, j = c >> 3, ri = i & 7; e = 2 * xcd + (i >> 3); u.pm = (ri & 1) * 8 + (j & 7); u.pn = (ri >> 1) * 4 + (j >> 3); }
        else { const int L = i * G + c; if (L >= E * 256) return false; e = L >> 8; const int l = L & 255; u.pm = l & 15; u.pn = l >> 4; }
        u.e = e; u.a = U; u.rows = rowl + e * ME + u.pm * 256; u.b = W + ((size_t)e * 2 * F + (size_t)u.pn * 256) * D * esz; return true;
    }
};
struct SchedG2 {
    const char* ACT; const char* W; int G, c, esz;
    __device__ bool next(int i, Unit& u) const {
        int e;
        if (G == 256) { if (i >= 4) return false; const int xcd = c & 7, j = c >> 3; e = 2 * xcd + (i >> 1); u.pm = (i & 1) * 8 + (j & 7); u.pn = j >> 3; }
        else { const int L = i * G + c; if (L >= E * 64) return false; e = L >> 6; const int l = L & 63; u.pm = l & 15; u.pn = l >> 4; }
        u.e = e; u.rows = nullptr;
        u.a = ACT + ((size_t)e * ME + (size_t)u.pm * 256) * F * esz; u.b = W + ((size_t)e * D + (size_t)u.pn * 256) * F * esz; return true;
    }
};
}

struct Ctx {
    LAS unsigned char* lds; int tid, lane, wave, vcu, G;
};

__device__ __forceinline__ void transpose_item(const float* W, int ldw, int k0, int n0, bf16_t* WT, int ldt, int dst_row0, LAS float* scr, int lane) {
#pragma unroll 8
    for (int i = 0; i < 32; ++i) { const int kk = 2 * i + (lane >> 5); scr[kk * 33 + (lane & 31)] = W[(size_t)(k0 + kk) * ldw + n0 + (lane & 31)]; }
    LDS_WAIT(); asm volatile("" ::: "memory");
    const int c = lane & 7;
#pragma unroll
    for (int j = 0; j < 4; ++j) { const int n = (lane >> 3) + 8 * j; const LAS float* s = scr + (8 * c) * 33 + n;
        u32x4 o; o.x = pk2(s[0 * 33], s[1 * 33]); o.y = pk2(s[2 * 33], s[3 * 33]); o.z = pk2(s[4 * 33], s[5 * 33]); o.w = pk2(s[6 * 33], s[7 * 33]);
        *(GAS u32x4*)(WT + (size_t)(dst_row0 + n) * ldt + k0 + 8 * c) = o; }
    LDS_WAIT(); asm volatile("" ::: "memory");
}
struct TItem { const float* src; unsigned char* dst; int ldw, ldt; };
__device__ __forceinline__ void titem_load(const TItem& t, int lane, f32x4 (&v)[8]) {
#pragma unroll
    for (int i = 0; i < 8; ++i) v[i] = __builtin_nontemporal_load((const GAS f32x4*)(t.src + (size_t)(8 * i + (lane >> 3)) * t.ldw + (lane & 7) * 4));
}
__device__ __forceinline__ void titem_store_f8(const TItem& t, int lane, const f32x4 (&v)[8], LAS float* scr, float sc) {
#pragma unroll
    for (int i = 0; i < 8; ++i) { LAS float* d = scr + (8 * i + (lane >> 3)) * 33 + (lane & 7) * 4; d[0] = v[i][0]; d[1] = v[i][1]; d[2] = v[i][2]; d[3] = v[i][3]; }
    LDS_WAIT(); asm volatile("" ::: "memory");
#pragma unroll
    for (int j = 0; j < 2; ++j) { const int idx = lane + 64 * j, n = idx >> 2, c = idx & 3; const LAS float* s = scr + (16 * c) * 33 + n;
        unsigned w[4];
#pragma unroll
        for (int q = 0; q < 4; ++q) { unsigned tt = 0u; tt = __builtin_amdgcn_cvt_pk_fp8_f32(s[(4 * q + 0) * 33] * sc, s[(4 * q + 1) * 33] * sc, tt, false); tt = __builtin_amdgcn_cvt_pk_fp8_f32(s[(4 * q + 2) * 33] * sc, s[(4 * q + 3) * 33] * sc, tt, true); w[q] = tt; }
        *(GAS u32x4*)(t.dst + (size_t)n * t.ldt + 16 * c) = (u32x4){w[0], w[1], w[2], w[3]}; }
    LDS_WAIT(); asm volatile("" ::: "memory");
}
__device__ __forceinline__ int win_row(int n0) {
    if (n0 < 2 * CW) { const int half = n0 / CW, ch = n0 % CW; return 256 * (ch / 128) + 128 * half + (ch % 128); }
    if (n0 < 2 * CW + FW) return n0;
    const int cc = n0 - (2 * CW + FW), half = cc / D, c2 = cc % D; return 2 * CW + FW + 256 * (c2 / 128) + 128 * half + (c2 % 128);
}

struct P {
    const float *x, *c, *ada_w, *ada_b, *norm1_g, *w_in, *b_in, *dw_w, *dw_b, *cln_g, *cln_b, *cw_out, *cb_out, *four_w, *four_b, *w_out, *b_out, *norm2_g, *router_w, *w_gate, *w_up, *w_down, *final_g;
    float* out;
    float* MOD; float* W2F; float* AFF; int* ROWL; float* WTS; short* INV;
    bf16_t *Wt_in, *Wt_conv, *Wt_four, *Wt_out, *D256, *GP, *Wt_gu, *Wt_down;
    bf16_t *U, *V, *FT, *ACONV, *YRI, *YCONV, *YFOUR, *MERGED, *ACT, *YB, *DELTA;
};

__device__ __forceinline__ void titem_store_bf16(const TItem& t, int lane, const f32x4 (&v)[8], LAS float* scr) {
#pragma unroll
    for (int i = 0; i < 8; ++i) { LAS float* d = scr + (8 * i + (lane >> 3)) * 33 + (lane & 7) * 4; d[0] = v[i][0]; d[1] = v[i][1]; d[2] = v[i][2]; d[3] = v[i][3]; }
    LDS_WAIT(); asm volatile("" ::: "memory");
    const int c = lane & 7;
#pragma unroll
    for (int j = 0; j < 4; ++j) { const int n = (lane >> 3) + 8 * j; const LAS float* s = scr + (8 * c) * 33 + n;
        u32x4 o; o.x = pk2(s[0 * 33], s[1 * 33]); o.y = pk2(s[2 * 33], s[3 * 33]); o.z = pk2(s[4 * 33], s[5 * 33]); o.w = pk2(s[6 * 33], s[7 * 33]);
        *(GAS u32x4*)(t.dst + ((size_t)n * t.ldt + 8 * c) * 2) = o; }
    LDS_WAIT(); asm volatile("" ::: "memory");
}
__device__ __forceinline__ TItem small_item(const P& p, int r) {
    constexpr int I1 = (D / 64) * (INC / 32), I2 = (CW / 64) * (D / 32);
    TItem t;
    if (r < I1) { const int kb = r / (INC / 32), nb = r % (INC / 32); t.src = p.w_in + (size_t)(64 * kb) * INC + 32 * nb; t.ldw = INC; t.ldt = D; t.dst = (unsigned char*)(p.Wt_in + (size_t)win_row(32 * nb) * D + 64 * kb); return t; }
    r -= I1;
    if (r < I2) { const int kb = r / (D / 32), nb = r % (D / 32); t.src = p.cw_out + (size_t)(64 * kb) * D + 32 * nb; t.ldw = D; t.ldt = CW; t.dst = (unsigned char*)(p.Wt_conv + (size_t)(32 * nb) * CW + 64 * kb); return t; }
    r -= I2;
    { const int kb = r / (D / 32), nb = r % (D / 32); t.src = p.w_out + (size_t)(64 * kb) * D + 32 * nb; t.ldw = D; t.ldt = D; t.dst = (unsigned char*)(p.Wt_out + (size_t)(32 * nb) * D + 64 * kb); return t; }
}
__device__ __forceinline__ void phase_p0a(const Ctx& X0, const P& p) {
    Ctx X = X0; X.tid = (int)threadIdx.x; asm volatile("" : "+v"(X.tid)); X.lane = X.tid & 63;
    LAS float* scr = (LAS float*)(X.lds + X.wave * 16384);
    const int gw = X.vcu * NWAVES + X.wave, NGW = X.G * NWAVES;
    constexpr int I1 = (D / 64) * (INC / 32), I2 = (CW / 64) * (D / 32), I4 = (D / 64) * (D / 32);
    const bool do_mod = X.vcu < NMOD * D / 32; const int mcol = X.tid & 31, mks = X.tid >> 5, mj0 = X.vcu * 32;
    float mw[64];
    if (do_mod) {
#pragma unroll
        for (int k = 0; k < 64; ++k) mw[k] = __builtin_nontemporal_load(p.ada_w + (size_t)(mks * 64 + k) * (NMOD * D) + mj0 + mcol); }
    const int fg = X.vcu / (D / 16), fn0 = (X.vcu % (D / 16)) * 16;
    f32x4 ftile = (f32x4){0.f, 0.f, 0.f, 0.f};
    if (X.vcu < FG * (D / 16)) ftile = *(const GAS f32x4*)(p.four_w + (size_t)(fg * FGD + (X.tid >> 2)) * D + fn0 + (X.tid & 3) * 4);
    {   f32x4 va[8], vb[8]; TItem cur, nx; int it = gw;
        if (it < I1 + I2 + I4) { cur = small_item(p, it); titem_load(cur, X.lane, va); }
        while (it < I1 + I2 + I4) {
            const int nxt = it + NGW; if (nxt < I1 + I2 + I4) { nx = small_item(p, nxt); titem_load(nx, X.lane, vb); }
            titem_store_bf16(cur, X.lane, va, scr);
#pragma unroll
            for (int i = 0; i < 8; ++i) va[i] = vb[i];
            cur = nx; it = nxt;
        }
    }
    __syncthreads();
    LAS float* ct = (LAS float*)X.lds; LAS float* c128 = ct + S;
    for (int i = X.tid; i < S; i += NTHR) { float sv, cv; sincospif((float)i / (float)(S / 2), &sv, &cv); ct[i] = cv; }
    if (X.tid < FGD) { float sv, cv; sincospif((float)X.tid / 64.f, &sv, &cv); c128[X.tid] = cv; }
    __syncthreads();
    const int gt = X.vcu * NTHR + X.tid, NGT = X.G * NTHR;
    for (int it = gt; it < 512 * 64; it += NGT) { const int r = it >> 6, c0 = (it & 63) * 8; const int part = r >> 8, k1 = r & 255, pc = c0 >> 8, s10 = c0 & 255;
        const int ph = (part == pc) ? 0 : (part == 0 ? -(S / 4) : (S / 4));
        unsigned w[4];
#pragma unroll
        for (int j = 0; j < 4; ++j) { const float a = ct[(16 * k1 * (s10 + 2 * j) + ph) & (S - 1)], b = ct[(16 * k1 * (s10 + 2 * j + 1) + ph) & (S - 1)]; w[j] = pk2(a, b); }
        *(GAS u32x4*)(p.D256 + (size_t)r * 512 + c0) = (u32x4){w[0], w[1], w[2], w[3]}; }
    {
        LAS float* wt = c128 + FGD;
        for (int it = X.vcu; it < FG * (D / 16); it += X.G) { const int g = it / (D / 16), n0 = (it % (D / 16)) * 16;
            __syncthreads();
            if (it == X.vcu) *(LAS f32x4*)(wt + 4 * X.tid) = ftile;
            else for (int i = X.tid; i < FGD * 16; i += NTHR) wt[i] = p.four_w[(size_t)(g * FGD + (i >> 4)) * D + n0 + (i & 15)];
            __syncthreads();
            const int nq = X.tid & 3, c = X.tid >> 2; int idx = 0;
            f32x4 ac = (f32x4){0.f, 0.f, 0.f, 0.f}, as = (f32x4){0.f, 0.f, 0.f, 0.f};
#pragma unroll 8
            for (int j = 0; j < FGD; ++j) { const float tc = c128[idx], ts = c128[(idx + 96) & 127];
                const f32x4 wv = *(const LAS f32x4*)(wt + j * 16 + 4 * nq); ac += wv * tc; as += wv * ts; idx = (idx + c) & 127; }
            *(GAS f32x4*)(p.W2F + (size_t)(g * FGD + c) * D + n0 + 4 * nq) = ac * 0.0013810679320049757f;
            *(GAS f32x4*)(p.W2F + (size_t)(FW + g * FGD + c) * D + n0 + 4 * nq) = as * 0.0013810679320049757f;
        }
    }
    __syncthreads();
    if (do_mod) {
        LAS float* cs = (LAS float*)X.lds;
        LAS float* part = cs + Bn * D;
        for (int i = X.tid; i < Bn * D; i += NTHR) cs[i] = siluf_(p.c[i]);
        __syncthreads();
        const int col = X.tid & 31, ks = X.tid >> 5, j0 = X.vcu * 32;
        float acc[Bn];
#pragma unroll
        for (int b = 0; b < Bn; ++b) acc[b] = 0.f;
#pragma unroll
        for (int k = 0; k < 64; ++k)
#pragma unroll
            for (int b = 0; b < Bn; ++b) acc[b] += cs[b * D + ks * 64 + k] * mw[k];
#pragma unroll
        for (int b = 0; b < Bn; ++b) part[(ks * Bn + b) * 32 + col] = acc[b];
        __syncthreads();
        if (X.tid < Bn * 32) { const int b = X.tid >> 5, cc = X.tid & 31; float s = p.ada_b[j0 + cc];
#pragma unroll
            for (int k2 = 0; k2 < 16; ++k2) s += part[(k2 * Bn + b) * 32 + cc];
            p.MOD[b * NMOD * D + j0 + cc] = s; }
    }
}

__device__ __forceinline__ float row_load_rstd(const float* xr, int lane, f32x4 (&v)[4]) {
    float ss = 0.f;
#pragma unroll
    for (int j = 0; j < 2; ++j) { v[2 * j] = *(const GAS f32x4*)(xr + 8 * lane + 512 * j); v[2 * j + 1] = *(const GAS f32x4*)(xr + 8 * lane + 512 * j + 4); }
#pragma unroll
    for (int q = 0; q < 4; ++q) ss += (v[q][0] * v[q][0] + v[q][1] * v[q][1]) + (v[q][2] * v[q][2] + v[q][3] * v[q][3]);
    return 1.f / sqrtf(wave_sum(ss) * (1.f / D) + 1e-6f);
}
__device__ __forceinline__ void row_issue(const float* xr, int lane, f32x4 (&v)[4]) {
#pragma unroll
    for (int j = 0; j < 4; ++j) v[j] = __builtin_nontemporal_load((const GAS f32x4*)(xr + 4 * lane + 256 * j));
}
__device__ __forceinline__ float row_rstd(const f32x4 (&v)[4]) {
    float ss = 0.f;
#pragma unroll
    for (int q = 0; q < 4; ++q) ss += (v[q][0] * v[q][0] + v[q][1] * v[q][1]) + (v[q][2] * v[q][2] + v[q][3] * v[q][3]);
    return 1.f / sqrtf(wave_sum(ss) * (1.f / D) + 1e-6f);
}
__device__ __forceinline__ TItem moe_item(const P& p, int r) {
    constexpr int I5 = (D / 64) * (F / 32), I6 = (F / 64) * (D / 32);
    TItem t;
    if (r < E * 2 * I5) { const int eh = r / I5, q = r % I5, e = eh >> 1, half = eh & 1; const int kb = q / (F / 32), nb = q % (F / 32), n0 = 32 * nb;
        t.src = (half ? p.w_up : p.w_gate) + (size_t)e * D * F + (size_t)(64 * kb) * F + n0; t.ldw = F; t.ldt = D;
        t.dst = (unsigned char*)p.Wt_gu + (size_t)e * 2 * F * D + (size_t)(256 * (n0 / 128) + 128 * half + (n0 % 128)) * D + 64 * kb; }
    else { r -= E * 2 * I5; const int e = r / I6, q = r % I6; const int kb = q / (D / 32), nb = q % (D / 32);
        t.src = p.w_down + (size_t)e * F * D + (size_t)(64 * kb) * D + 32 * nb; t.ldw = D; t.ldt = F;
        t.dst = (unsigned char*)p.Wt_down + (size_t)e * D * F + (size_t)(32 * nb) * F + 64 * kb; }
    return t;
}
__device__ __forceinline__ void phase_p0b(const Ctx& X0, const P& p) {
    Ctx X = X0; X.tid = (int)threadIdx.x; asm volatile("" : "+v"(X.tid)); X.lane = X.tid & 63;
    const int gw = X.vcu * NWAVES + X.wave, NGW = X.G * NWAVES;
    {
        const int RPW = T / X.G, base = X.vcu * RPW; const float* md = p.MOD + (size_t)(base >> 12) * NMOD * D;
        f32x4 av[4], sv[4];
#pragma unroll
        for (int j = 0; j < 4; ++j) { const int c0 = 4 * X.lane + 256 * j; av[j] = *(const f32x4*)(p.norm1_g + c0) * (*(const f32x4*)(md + D + c0) + 1.f); sv[j] = *(const f32x4*)(md + c0); }
        f32x4 v[4], vn[4], vn2[4]; int i = X.wave; if (i < RPW) row_issue(p.x + (size_t)(base + i) * D, X.lane, v);
        if (i + NWAVES < RPW) row_issue(p.x + (size_t)(base + i + NWAVES) * D, X.lane, vn);
        for (; i < RPW; i += NWAVES) {
            const int m = base + i, in2 = i + 2 * NWAVES; if (in2 < RPW) row_issue(p.x + (size_t)(base + in2) * D, X.lane, vn2);
            const float rstd = row_rstd(v);
#pragma unroll
            for (int j = 0; j < 4; ++j) { const int c0 = 4 * X.lane + 256 * j; const f32x4 o = v[j] * rstd * av[j] + sv[j];
                *(GAS u32x2*)(p.U + (size_t)m * D + c0) = (u32x2){cvt_pk_bf16(o[0], o[1]), cvt_pk_bf16(o[2], o[3])}; }
#pragma unroll
            for (int q = 0; q < 4; ++q) { v[q] = vn[q]; vn[q] = vn2[q]; }
        }
    }
    LAS float* scr = (LAS float*)(X.lds + X.wave * 16384);
    constexpr int I3 = (D / 64) * (D / 32);
    for (int it = gw; it < I3; it += NGW) { const int kb = it / (D / 32), nb = it % (D / 32); transpose_item(p.W2F, D, 64 * kb, 32 * nb, p.Wt_four, D, 32 * nb, scr, X.lane); }
    constexpr int NIT = E * 2 * (D / 64) * (F / 32) + E * (F / 64) * (D / 32);
#if MOE_F8
    {   f32x4 va[8], vb[8], vc[8]; TItem cur, nx, nx2; int it = gw;
        if (it < NIT) { cur = moe_item(p, it); titem_load(cur, X.lane, va); }
        if (it + NGW < NIT) { nx = moe_item(p, it + NGW); titem_load(nx, X.lane, vb); }
        while (it < NIT) {
            const int n2 = it + 2 * NGW; if (n2 < NIT) { nx2 = moe_item(p, n2); titem_load(nx2, X.lane, vc); }
            titem_store_f8(cur, X.lane, va, scr, epi::W_SC);
#pragma unroll
            for (int i = 0; i < 8; ++i) { va[i] = vb[i]; vb[i] = vc[i]; }
            cur = nx; nx = nx2; it += NGW;
        }
    }
#else
    constexpr int I5 = (D / 64) * (F / 32), I6 = (F / 64) * (D / 32);
    for (int it = gw; it < NIT; it += NGW) { int r = it;
        if (r < E * 2 * I5) { const int eh = r / I5, q = r % I5, e = eh >> 1, half = eh & 1; const int kb = q / (F / 32), nb = q % (F / 32), n0 = 32 * nb;
            transpose_item((half ? p.w_up : p.w_gate) + (size_t)e * D * F, F, 64 * kb, n0, p.Wt_gu + (size_t)e * 2 * F * D, D, 256 * (n0 / 128) + 128 * half + (n0 % 128), scr, X.lane); continue; } r -= E * 2 * I5;
        { const int e = r / I6, q = r % I6; const int kb = q / (D / 32), nb = q % (D / 32);
            transpose_item(p.w_down + (size_t)e * F * D, D, 64 * kb, 32 * nb, p.Wt_down + (size_t)e * D * F, F, 32 * nb, scr, X.lane); } }
#endif
}

__device__ __forceinline__ void phase_conv(const Ctx& X0, const P& p) {
    Ctx X = X0; X.tid = (int)threadIdx.x; asm volatile("" : "+v"(X.tid)); X.lane = X.tid & 63;
    constexpr int CH = 32, ROWS = CH + CK - 1;
    LAS unsigned char* rows = X.lds;
    LAS float* wl = (LAS float*)(X.lds + ROWS * 1024);
    for (int i = X.tid; i < CK * CW; i += NTHR) { const int k = i / CW, ch = i % CW; const int ln = ch >> 3, q = (ch >> 2) & 1, r = ch & 3; wl[((k * 2 + q) * 64 + ln) * 4 + r] = p.dw_w[i]; }
    const int lane = X.lane, w = X.wave;
    f32x4 db[2], lg[2], lb[2];
#pragma unroll
    for (int h = 0; h < 2; ++h) { db[h] = *(const f32x4*)(p.dw_b + 8 * lane + 4 * h); lg[h] = *(const f32x4*)(p.cln_g + 8 * lane + 4 * h); lb[h] = *(const f32x4*)(p.cln_b + 8 * lane + 4 * h); }
    u32x4 pre[8];
#define CV_LOAD(chk) do { const int t0_ = (chk) * CH, b_ = t0_ >> 12, s0_ = t0_ & (S - 1); _Pragma("unroll") for (int q = 0; q < 8; ++q) { const int i = X.tid + q * NTHR, r = i >> 6, cseg = i & 63, s = s0_ + r - CK / 2; \
        pre[q] = (u32x4){0u, 0u, 0u, 0u}; if (i < ROWS * 64 && s >= 0 && s < S) pre[q] = *(const GAS u32x4*)(p.V + ((size_t)(b_ * S + s)) * CW + cseg * 8); } } while (0)
    if (X.vcu < T / CH) CV_LOAD(X.vcu);
    for (int chunk = X.vcu; chunk < T / CH; chunk += X.G) {
        const int t0 = chunk * CH;
        __syncthreads();
#pragma unroll
        for (int q = 0; q < 8; ++q) { const int i = X.tid + q * NTHR; if (i < ROWS * 64) *(LAS u32x4*)(rows + (i >> 6) * 1024 + (i & 63) * 16) = pre[q]; }
        if (chunk + X.G < T / CH) CV_LOAD(chunk + X.G);
        __syncthreads();
        f32x4 acc[4][2]; int zo = 0; asm volatile("" : "+v"(zo));
#pragma unroll
        for (int j = 0; j < 4; ++j) { acc[j][0] = db[0]; acc[j][1] = db[1]; }
#pragma unroll
        for (int rr = 0; rr < CK + 3; ++rr) {
            const u32x4 rv = *(const LAS u32x4*)(rows + (4 * w + rr) * 1024 + lane * 16); f32x4 a0, a1; epi::unpack8(rv, a0, a1);
#pragma unroll
            for (int j = 0; j < 4; ++j) { const int k = rr - j;
                if (k >= 0 && k < CK) { const f32x4 w0 = *(const LAS f32x4*)(wl + ((k * 2 + 0) * 64 + lane + zo) * 4), w1 = *(const LAS f32x4*)(wl + ((k * 2 + 1) * 64 + lane + zo) * 4);
                    acc[j][0] += a0 * w0; acc[j][1] += a1 * w1; } }
        }
#pragma unroll
        for (int j = 0; j < 4; ++j) {
            const f32x4 a0 = acc[j][0], a1 = acc[j][1];
            const float mu = wave_sum((a0[0] + a0[1]) + (a0[2] + a0[3]) + (a1[0] + a1[1]) + (a1[2] + a1[3])) * (1.f / CW);
            const f32x4 d0 = a0 - mu, d1 = a1 - mu;
            const float var = wave_sum((d0[0] * d0[0] + d0[1] * d0[1]) + (d0[2] * d0[2] + d0[3] * d0[3]) + (d1[0] * d1[0] + d1[1] * d1[1]) + (d1[2] * d1[2] + d1[3] * d1[3])) * (1.f / CW);
            const float rstd = 1.f / sqrtf(var + 1e-5f);
            const f32x4 z0 = d0 * rstd * lg[0] + lb[0], z1 = d1 * rstd * lg[1] + lb[1];
            *(GAS u32x4*)(p.ACONV + (size_t)(t0 + 4 * w + j) * CW + 8 * lane) = epi::pack8(epi::silu4(z0), epi::silu4(z1));
        }
    }
#undef CV_LOAD
    __syncthreads();
}


__device__ __forceinline__ void dft16_real(const float (&x)[16], float (&gr)[16], float (&gi)[16]) {
    constexpr float WR[10] = {1.f, 0.92387953251128674f, 0.70710678118654752f, 0.38268343236508977f, 0.f, -0.38268343236508977f, -0.70710678118654752f, -0.92387953251128674f, -1.f, -0.92387953251128674f};
    constexpr float WI[10] = {0.f, -0.38268343236508977f, -0.70710678118654752f, -0.92387953251128674f, -1.f, -0.92387953251128674f, -0.70710678118654752f, -0.38268343236508977f, 0.f, 0.38268343236508977f};
    float zr[4][4], zi[4][4];
#pragma unroll
    for (int b = 0; b < 4; ++b) { const float x0 = x[b], x1 = x[4 + b], x2 = x[8 + b], x3 = x[12 + b];
        const float s02 = x0 + x2, d02 = x0 - x2, s13 = x1 + x3, d13 = x1 - x3;
        const float yr[4] = {s02 + s13, d02, s02 - s13, d02}, yi[4] = {0.f, -d13, 0.f, d13};
#pragma unroll
        for (int c = 0; c < 4; ++c) { const float wr = WR[b * c], wi = WI[b * c]; zr[b][c] = yr[c] * wr - yi[c] * wi; zi[b][c] = yr[c] * wi + yi[c] * wr; } }
#pragma unroll
    for (int c = 0; c < 4; ++c) {
        const float ar = zr[0][c] + zr[2][c], ai = zi[0][c] + zi[2][c], br = zr[0][c] - zr[2][c], bi = zi[0][c] - zi[2][c];
        const float cr = zr[1][c] + zr[3][c], ci = zi[1][c] + zi[3][c], dr = zr[1][c] - zr[3][c], di = zi[1][c] - zi[3][c];
        gr[c] = ar + cr;      gi[c] = ai + ci;
        gr[c + 4] = br + di;  gi[c + 4] = bi - dr;
        gr[c + 8] = ar - cr;  gi[c + 8] = ai - ci;
        gr[c + 12] = br - di; gi[c + 12] = bi + dr;
    }
}
__device__ __forceinline__ void phase_fftA(const Ctx& X0, const P& p) {
    Ctx X = X0; X.tid = (int)threadIdx.x; asm volatile("" : "+v"(X.tid)); X.lane = X.tid & 63;
    LAS float* ct = (LAS float*)X.lds;
    for (int i = X.tid; i < S; i += NTHR) { float sv, cv; sincospif((float)i / (float)(S / 2), &sv, &cv); ct[i] = cv; }
    __syncthreads();
    constexpr float C16[16] = {1.f, 0.92387953251128674f, 0.70710678118654752f, 0.38268343236508977f, 0.f, -0.38268343236508977f, -0.70710678118654752f, -0.92387953251128674f,
                               -1.f, -0.92387953251128674f, -0.70710678118654752f, -0.38268343236508977f, 0.f, 0.38268343236508977f, 0.70710678118654752f, 0.92387953251128674f};
    const int chl = X.tid >> 7, sp = X.tid & 127;
    unsigned pre[16];
#define FA_LOAD(itm) do { const bf16_t* src_ = p.FT + ((size_t)(((itm) >> 7) * FW + ((itm) & 127) * 4 + chl) * S + 2 * sp); _Pragma("unroll") for (int s2 = 0; s2 < 16; ++s2) pre[s2] = *(const GAS unsigned*)(src_ + 256 * s2); } while (0)
    if (X.vcu < Bn * (FW / 4)) FA_LOAD(X.vcu);
    for (int it = X.vcu; it < Bn * (FW / 4); it += X.G) {
        const int b = it >> 7, ch = (it & 127) * 4 + chl;
        float xa[16], xb[16];
#pragma unroll
        for (int s2 = 0; s2 < 16; ++s2) { const unsigned w = pre[s2]; xa[s2] = bf_lo(w); xb[s2] = bf_hi(w); }
        if (it + X.G < Bn * (FW / 4)) FA_LOAD(it + X.G);
        float gar[16], gai[16], gbr[16], gbi[16];
        dft16_real(xa, gar, gai); dft16_real(xb, gbr, gbi);
#pragma unroll
        for (int k2 = 0; k2 < 16; ++k2) {
            const float ar = gar[k2], ai = gai[k2], br = gbr[k2], bi = gbi[k2];
            const int ia = (2 * sp * k2) & (S - 1), ib = ((2 * sp + 1) * k2) & (S - 1);
            const float tca = ct[ia], tsa = ct[(ia - S / 4) & (S - 1)], tcb = ct[ib], tsb = ct[(ib - S / 4) & (S - 1)];
            const float gra = ar * tca + ai * tsa, gia = ai * tca - ar * tsa, grb = br * tcb + bi * tsb, gib = bi * tcb - br * tsb;
            bf16_t* dst = p.GP + ((size_t)((b * 16 + k2) * FW + ch) * 512 + 2 * sp);
            *(GAS unsigned*)dst = cvt_pk_bf16(gra, grb); *(GAS unsigned*)(dst + 256) = cvt_pk_bf16(gia, gib);
        }
    }
    __syncthreads();
}

__device__ __forceinline__ void phase_router(const Ctx& X0, const P& p, const float* H) {
    Ctx X = X0; X.tid = (int)threadIdx.x; asm volatile("" : "+v"(X.tid)); X.lane = X.tid & 63;
    LAS float* GP = (LAS float*)X.lds;
    LAS float* SH = GP + D;
    LAS f32x4* ACCP = (LAS f32x4*)(SH + D);
    LAS float* SSP = (LAS float*)(ACCP + 2 * 8 * 64);
    LAS float* CE = SSP + 2 * 8 * 16;
    const int lane = X.lane, w = X.wave, r = lane & 15, kq = lane >> 4;
    constexpr int NG = T / 16, GPW = NG / 256;
    const int g0 = X.vcu * GPW, b = (g0 * 16) >> 12;
    const float* md = p.MOD + (size_t)b * NMOD * D;
    f32x4 a[4][2], vn[4][2];
    const int cbase = 128 * w + 8 * kq;
#if H_DELTA
#define RT_ISSUE(dst, grp) do { const size_t ro_ = ((size_t)(grp) * 16 + r) * D + cbase; const float* rp = H + ro_; const bf16_t* dp = p.DELTA + ro_; _Pragma("unroll") for (int s = 0; s < 4; ++s) { \
        const u32x4 dw_ = *(const GAS u32x4*)(dp + 32 * s); f32x4 d0_, d1_; epi::unpack8(dw_, d0_, d1_); dst[s][0] = *(const GAS f32x4*)(rp + 32 * s) + d0_; dst[s][1] = *(const GAS f32x4*)(rp + 32 * s + 4) + d1_; } } while (0)
#else
#define RT_ISSUE(dst, grp) do { const float* rp = H + ((size_t)(grp) * 16 + r) * D + cbase; _Pragma("unroll") for (int s = 0; s < 4; ++s) { dst[s][0] = *(const GAS f32x4*)(rp + 32 * s); dst[s][1] = *(const GAS f32x4*)(rp + 32 * s + 4); } } while (0)
#endif
    RT_ISSUE(a, g0);
    for (int i = X.tid; i < D; i += NTHR) { GP[i] = p.norm2_g[i] * (1.f + md[4 * D + i]); SH[i] = md[3 * D + i]; }
    bf16x8 bh[4], bl[4];
#pragma unroll
    for (int s = 0; s < 4; ++s) { unsigned hw[4], lw[4];
#pragma unroll
        for (int j = 0; j < 4; ++j) { const int d = 32 * (4 * w + s) + 8 * kq + 2 * j; const float x0 = p.router_w[(size_t)d * E + r], x1 = p.router_w[(size_t)(d + 1) * E + r];
            const unsigned h = cvt_pk_bf16(x0, x1); hw[j] = h; lw[j] = cvt_pk_bf16(x0 - bf_lo(h), x1 - bf_hi(h)); }
        bh[s] = __builtin_bit_cast(bf16x8, (u32x4){hw[0], hw[1], hw[2], hw[3]}); bl[s] = __builtin_bit_cast(bf16x8, (u32x4){lw[0], lw[1], lw[2], lw[3]}); }
    __syncthreads();
    if (w == 0) {
        float c[E];
#pragma unroll
        for (int e = 0; e < E; ++e) c[e] = 0.f;
        for (int d = lane; d < D; d += 64) { const float sv = SH[d]; const f32x4* wr_ = (const f32x4*)(p.router_w + (size_t)d * E);
#pragma unroll
            for (int q = 0; q < 4; ++q) { const f32x4 wv = wr_[q]; c[4 * q] += sv * wv[0]; c[4 * q + 1] += sv * wv[1]; c[4 * q + 2] += sv * wv[2]; c[4 * q + 3] += sv * wv[3]; } }
#pragma unroll
        for (int e = 0; e < E; ++e) { const float s = wave_sum(c[e]); if (lane == e) CE[e] = s; }
    }
    __syncthreads();
    for (int gi = 0; gi < GPW; ++gi) {
        const int g = g0 + gi, par = gi & 1;
        if (gi + 1 < GPW) RT_ISSUE(vn, g + 1);
        float ss = 0.f; f32x4 acc = (f32x4){0.f, 0.f, 0.f, 0.f};
#pragma unroll
        for (int s = 0; s < 4; ++s) {
            const f32x4 g0v = *(const LAS f32x4*)(GP + cbase + 32 * s), g1v = *(const LAS f32x4*)(GP + cbase + 32 * s + 4);
            const f32x4 v0 = a[s][0], v1 = a[s][1];
            ss += (v0[0] * v0[0] + v0[1] * v0[1]) + (v0[2] * v0[2] + v0[3] * v0[3]) + (v1[0] * v1[0] + v1[1] * v1[1]) + (v1[2] * v1[2] + v1[3] * v1[3]);
            const f32x4 x0 = v0 * g0v, x1 = v1 * g1v; a[s][0] = x0; a[s][1] = x1;
            unsigned hw[4], lw[4];
            hw[0] = cvt_pk_bf16(x0[0], x0[1]); hw[1] = cvt_pk_bf16(x0[2], x0[3]); hw[2] = cvt_pk_bf16(x1[0], x1[1]); hw[3] = cvt_pk_bf16(x1[2], x1[3]);
            lw[0] = cvt_pk_bf16(x0[0] - bf_lo(hw[0]), x0[1] - bf_hi(hw[0])); lw[1] = cvt_pk_bf16(x0[2] - bf_lo(hw[1]), x0[3] - bf_hi(hw[1]));
            lw[2] = cvt_pk_bf16(x1[0] - bf_lo(hw[2]), x1[1] - bf_hi(hw[2])); lw[3] = cvt_pk_bf16(x1[2] - bf_lo(hw[3]), x1[3] - bf_hi(hw[3]));
            const bf16x8 ah = __builtin_bit_cast(bf16x8, (u32x4){hw[0], hw[1], hw[2], hw[3]}), al = __builtin_bit_cast(bf16x8, (u32x4){lw[0], lw[1], lw[2], lw[3]});
            acc = __builtin_amdgcn_mfma_f32_16x16x32_bf16(ah, bh[s], acc, 0, 0, 0);
            acc = __builtin_amdgcn_mfma_f32_16x16x32_bf16(ah, bl[s], acc, 0, 0, 0);
            acc = __builtin_amdgcn_mfma_f32_16x16x32_bf16(al, bh[s], acc, 0, 0, 0);
        }
        ss += __shfl_xor(ss, 16); ss += __shfl_xor(ss, 32);
        ACCP[(par * 8 + w) * 64 + lane] = acc;
        if (lane < 16) SSP[(par * 8 + w) * 16 + lane] = ss;
        __syncthreads();
        float rss = 0.f;
#pragma unroll
        for (int q = 0; q < 8; ++q) rss += SSP[(par * 8 + q) * 16 + r];
        const float rstd = 1.f / sqrtf(rss * (1.f / D) + 1e-6f);
        if (w == (gi & 7)) {
            f32x4 lg = (f32x4){0.f, 0.f, 0.f, 0.f};
#pragma unroll
            for (int q = 0; q < 8; ++q) lg += ACCP[(par * 8 + q) * 64 + lane];
            const float ce = CE[r]; f32x4 o;
#pragma unroll
            for (int q = 0; q < 4; ++q) { const float rs = __shfl(rstd, 4 * kq + q); float z = lg[q] * rs + ce; float mx = z;
#pragma unroll
                for (int sft = 1; sft < 16; sft <<= 1) mx = fmaxf(mx, __shfl_xor(mx, sft));
                const float ex = expf(z - mx); float sm = ex;
#pragma unroll
                for (int sft = 1; sft < 16; sft <<= 1) sm += __shfl_xor(sm, sft);
                o[q] = ex / sm; }
            *(GAS f32x4*)(p.AFF + ((size_t)b * E + r) * S + ((g * 16) & (S - 1)) + 4 * kq) = o;
        }
#pragma unroll
        for (int s = 0; s < 4; ++s) {
            const f32x4 s0 = *(const LAS f32x4*)(SH + cbase + 32 * s), s1 = *(const LAS f32x4*)(SH + cbase + 32 * s + 4);
            const f32x4 u0 = a[s][0] * rstd + s0, u1 = a[s][1] * rstd + s1; const size_t off = ((size_t)g * 16 + r) * D + cbase + 32 * s;
            if (MOE_F8) *(GAS u32x2*)((unsigned char*)p.U + off) = pack8_f8(u0, u1, epi::U_SC);
            else *(GAS u32x4*)(p.U + off) = epi::pack8(u0, u1);
        }
#pragma unroll
        for (int s = 0; s < 4; ++s) { a[s][0] = vn[s][0]; a[s][1] = vn[s][1]; }
    }
#undef RT_ISSUE
    __syncthreads();
}

__device__ __forceinline__ void phase_topk(const Ctx& X0, const P& p) {
    Ctx X = X0; X.tid = (int)threadIdx.x; asm volatile("" : "+v"(X.tid)); X.lane = X.tid & 63;
    LAS unsigned* cnt = (LAS unsigned*)X.lds;
    LAS unsigned* sc = cnt + 48;
    const int lane = X.lane, w = X.wave, tid = X.tid;
    for (int be = X.vcu; be < Bn * E; be += X.G) {
        const int b = be / E, e = be % E;
        const float* src = p.AFF + (size_t)be * S + 8 * tid;
        const f32x4 a0 = *(const GAS f32x4*)src, a1 = *(const GAS f32x4*)(src + 4);
        unsigned key[8];
#pragma unroll
        for (int i = 0; i < 4; ++i) { const float f0 = a0[i], f1 = a1[i]; key[i] = __float_as_uint(f0); key[4 + i] = __float_as_uint(f1); }
        unsigned prefix = 0u, need_k = (unsigned)CAP;
        __syncthreads();
        if (tid < 48) cnt[tid] = 0u;
        __syncthreads();
#pragma unroll 1
        for (int pass = 0; pass < 8; ++pass) {
            const int shift = 28 - 4 * pass; LAS unsigned* hist = cnt + (pass % 3) * 16;
            if (tid < 16) cnt[((pass + 1) % 3) * 16 + tid] = 0u;
#pragma unroll
            for (int i = 0; i < 8; ++i) { const bool match = (pass == 0) || ((key[i] >> (shift + 4)) == (prefix >> (shift + 4)));
                if (match) __hip_atomic_fetch_add(hist + ((key[i] >> shift) & 15u), 1u, __ATOMIC_RELAXED, __HIP_MEMORY_SCOPE_WORKGROUP); }
            __syncthreads();
            unsigned cum = 0u, dsel = 0u, below = 0u; bool found = false;
#pragma unroll
            for (int dgt = 15; dgt >= 0; --dgt) { const unsigned c = hist[dgt]; if (!found) { if (cum + c >= need_k) { dsel = (unsigned)dgt; below = cum; found = true; } else cum += c; } }
            prefix |= dsel << shift; need_k -= below;
        }
        const unsigned Tk = prefix;
        unsigned ngt = 0u, neq = 0u;
#pragma unroll
        for (int i = 0; i < 8; ++i) { ngt += key[i] > Tk; neq += key[i] == Tk; }
        unsigned sg = ngt, se = neq;
#pragma unroll
        for (int o = 1; o < 64; o <<= 1) { const unsigned tg = __shfl_up(sg, o), te = __shfl_up(se, o); if (lane >= o) { sg += tg; se += te; } }
        __syncthreads();
        if (lane == 63) { sc[w] = sg; sc[8 + w] = se; }
        __syncthreads();
        unsigned og = 0u, oe = 0u, totg = 0u;
#pragma unroll
        for (int i = 0; i < 8; ++i) { const unsigned g = sc[i], q = sc[8 + i]; if (i < w) { og += g; oe += q; } totg += g; }
        unsigned pg = og + sg - ngt, pe = oe + se - neq;
        const unsigned need = (unsigned)CAP - totg;
        unsigned iv[4] = {0u, 0u, 0u, 0u};
#pragma unroll
        for (int i = 0; i < 8; ++i) {
            const bool gt = key[i] > Tk, eq = key[i] == Tk; const int s = 8 * tid + i;
            const bool sel = gt || (eq && pe < need);
            const unsigned slot = pg + (pe < need ? pe : need);
            if (sel) { p.ROWL[(size_t)e * ME + b * CAP + slot] = b * S + s; p.WTS[(size_t)e * ME + b * CAP + slot] = __uint_as_float(key[i]); }
            iv[i >> 1] |= (sel ? (slot & 0xffffu) : 0xffffu) << (16 * (i & 1));
            pg += gt; pe += eq;
        }
        *(GAS u32x4*)(p.INV + (size_t)be * S + 8 * tid) = (u32x4){iv[0], iv[1], iv[2], iv[3]};
    }
    __syncthreads();
}

__device__ __forceinline__ void phase_final(const Ctx& X0, const P& p) {
    Ctx X = X0; X.tid = (int)threadIdx.x; asm volatile("" : "+v"(X.tid)); X.lane = X.tid & 63;
    const int lane = X.lane, RPW = T / X.G, base = X.vcu * RPW, b = base >> 12;
    f32x4 g2v[4], fgv[4];
#pragma unroll
    for (int j = 0; j < 4; ++j) { g2v[j] = *(const f32x4*)(p.MOD + (size_t)b * NMOD * D + 5 * D + 4 * lane + 256 * j) * (YB_F8 ? 1.f / epi::YB_SC : 1.f); fgv[j] = *(const f32x4*)(p.final_g + 4 * lane + 256 * j); }
    for (int i = X.wave; i < RPW; i += NWAVES) {
        const int m = base + i; float* hr = p.out + (size_t)m * D;
        f32x4 v[4];
#if H_DELTA
#pragma unroll
        for (int j = 0; j < 4; ++j) { const u32x2 dw = *(const GAS u32x2*)(p.DELTA + (size_t)m * D + 4 * lane + 256 * j);
            v[j] = *(const GAS f32x4*)(p.x + (size_t)m * D + 4 * lane + 256 * j) + (f32x4){bf_lo(dw.x), bf_hi(dw.x), bf_lo(dw.y), bf_hi(dw.y)}; }
#else
#pragma unroll
        for (int j = 0; j < 4; ++j) v[j] = *(const GAS f32x4*)(hr + 4 * lane + 256 * j);
#endif
        const int myslot = (lane < E) ? (int)p.INV[((size_t)(b * E + lane)) * S + (m & (S - 1))] : -1;
        f32x4 y[4];
#pragma unroll
        for (int q = 0; q < 4; ++q) y[q] = (f32x4){0.f, 0.f, 0.f, 0.f};
#pragma unroll
        for (int e = 0; e < E; ++e) { const int slot = __builtin_amdgcn_readlane(myslot, e);
            if (slot >= 0) { const size_t yo = ((size_t)e * ME + b * CAP + slot) * D;
#pragma unroll
                for (int j = 0; j < 4; ++j) {
                    if (YB_F8) { const unsigned wv = *(const GAS unsigned*)((const unsigned char*)p.YB + yo + 4 * lane + 256 * j);
                        const f32x2 lo2 = __builtin_amdgcn_cvt_pk_f32_fp8((int)wv, false), hi2 = __builtin_amdgcn_cvt_pk_f32_fp8((int)wv, true); y[j] += (f32x4){lo2[0], lo2[1], hi2[0], hi2[1]}; }
                    else { const u32x2 wv = *(const GAS u32x2*)(p.YB + yo + 4 * lane + 256 * j); y[j] += (f32x4){bf_lo(wv.x), bf_hi(wv.x), bf_lo(wv.y), bf_hi(wv.y)}; } } } }
        float ss = 0.f;
#pragma unroll
        for (int j = 0; j < 4; ++j) { const f32x4 tt = v[j] + g2v[j] * y[j]; v[j] = tt; ss += (tt[0] * tt[0] + tt[1] * tt[1]) + (tt[2] * tt[2] + tt[3] * tt[3]); }
        const float rstd = 1.f / sqrtf(wave_sum(ss) * (1.f / D) + 1e-6f);
#pragma unroll
        for (int j = 0; j < 4; ++j) *(GAS f32x4*)(hr + 4 * lane + 256 * j) = v[j] * rstd * fgv[j];
    }
}

constexpr size_t MiB = 1u << 20;
constexpr size_t WS_CTL = 0, CTL_ZERO_BYTES = 1 * MiB;
constexpr size_t WS_MOD = 1 * MiB, WS_AFF = 2 * MiB, WS_ROWL = 4 * MiB, WS_WTS = WS_ROWL + 256 * 1024, WS_INV = WS_WTS + 256 * 1024;
constexpr size_t WS_W2F = 6 * MiB, WS_WIN = 10 * MiB, WS_WCONV = 18 * MiB, WS_WFOUR = 19 * MiB, WS_WOUT = 21 * MiB;
constexpr size_t WS_WGU = 24 * MiB, WS_WDOWN = 152 * MiB, WS_U = 216 * MiB, WS_R1 = 280 * MiB, WS_END = 536 * MiB;
constexpr size_t WS_GP = WS_R1, WS_D256 = 23 * MiB, WS_YCONV = WS_R1, WS_V = WS_R1 + 64 * MiB, WS_FT = WS_R1 + 96 * MiB, WS_YFOUR = WS_R1 + 64 * MiB;
constexpr size_t WS_YRI = WS_R1 + 128 * MiB, WS_MERGED = WS_R1 + 128 * MiB, WS_ACONV = WS_R1 + 192 * MiB, WS_ACT = WS_R1 + 128 * MiB  , WS_YB = WS_WGU, WS_DELTA = WS_R1  ;
static_assert(MOE_F8 || !H_DELTA, "the workspace map places the 128 MiB fp8 ACT beside DELTA; a bf16 ACT (256 MiB) needs H_DELTA = 0");
constexpr int LDS_BYTES = 147456, RING_BYTES = 131072, MISC_OFF = RING_BYTES + 320;


#ifndef BARRIER_KIND
#define BARRIER_KIND 2
#endif
#define RLX_AGENT __ATOMIC_RELAXED, __HIP_MEMORY_SCOPE_AGENT
#define XB_TMO      128
#define XB_XCNT(j)  (256  + 64 * (j))
#define XB_XSUB(j)  (1280 + 64 * (j))
#define XB_XGEN(j)  (2304 + 64 * (j))
#define XB_TOP      3328
#define XB_TOPGEN   3392
#define XCD_BAR_WORDS 3456
#define XB_SPIN_CAP (1u << 18)
__device__ __forceinline__ unsigned xb_ld(unsigned* p)              { return __hip_atomic_load(p, __ATOMIC_RELAXED, __HIP_MEMORY_SCOPE_AGENT); }
__device__ __forceinline__ unsigned xb_add(unsigned* p, unsigned v) { return __hip_atomic_fetch_add(p, v, __ATOMIC_RELAXED, __HIP_MEMORY_SCOPE_AGENT); }
__device__ __forceinline__ unsigned xb_xcc_id() { return (unsigned)__builtin_amdgcn_s_getreg((3 << 11) | 20) & 0xFu; }
#define XB_SPIN(cond, bar) do { unsigned _sp = 0; while (cond) { __builtin_amdgcn_s_sleep(1); \
    if ((++_sp & 255u) == 0u) { if (xb_ld(&(bar)[XB_TMO])) break; if (_sp > XB_SPIN_CAP) { atomicAdd(&(bar)[XB_TMO], 1u); break; } } } } while (0)
struct XcdBarrier { unsigned* bar; unsigned x; volatile LAS unsigned* st; };
__device__ __forceinline__ XcdBarrier xcd_barrier_post(unsigned* bar, volatile LAS unsigned* st) {
    XcdBarrier b; b.bar = bar; b.x = xb_xcc_id(); b.st = st;
    if (threadIdx.x == 0) (void)xb_add(&bar[XB_XCNT(b.x)], 1u);
    return b;
}
__device__ __forceinline__ void xcd_barrier_complete(unsigned* bar, unsigned x, unsigned& nloc, unsigned& nx) {
    const unsigned G = gridDim.x * gridDim.y * gridDim.z;
    unsigned sum, cnt, mine, sp = 0u;
    for (;;) {
        sum = 0u; cnt = 0u; mine = 0u;
#pragma unroll
        for (unsigned j = 0; j < 16; ++j) { const unsigned c = xb_ld(&bar[XB_XCNT(j)]); sum += c; cnt += (c > 0u) ? 1u : 0u; mine = (j == x) ? c : mine; }
        if (sum == G) break;
        __builtin_amdgcn_s_sleep(1);
        if ((++sp & 255u) == 0u) { if (xb_ld(&bar[XB_TMO])) break; if (sp > XB_SPIN_CAP) { atomicAdd(&bar[XB_TMO], 1u); break; } }
    }
    nloc = mine > 0u ? mine : 1u; nx = cnt > 0u ? cnt : 1u;
}
__device__ __forceinline__ void xcd_barrier(const XcdBarrier& b) {
    asm volatile("s_waitcnt vmcnt(0)" ::: "memory");
    __syncthreads();
    if (threadIdx.x == 0) {
        unsigned* bar = b.bar;
        __builtin_amdgcn_s_waitcnt(0);
        unsigned nloc = b.st[0], nx = b.st[1];
        if (nloc == 0u) { xcd_barrier_complete(bar, b.x, nloc, nx); b.st[0] = nloc; b.st[1] = nx; }
        const unsigned old = xb_add(&bar[XB_XSUB(b.x)], 1u);
        const unsigned gen = old / nloc;
        if (old + 1u == (gen + 1u) * nloc) {
            __builtin_amdgcn_fence(__ATOMIC_RELEASE, "agent");
            asm volatile("s_waitcnt vmcnt(0)" ::: "memory");
            const unsigned og = xb_add(&bar[XB_TOP], 1u);
            const unsigned tg = og / nx;
            if (og + 1u == (tg + 1u) * nx) xb_add(&bar[XB_TOPGEN], 1u);
            else XB_SPIN(xb_ld(&bar[XB_TOPGEN]) == tg, bar);
            __builtin_amdgcn_fence(__ATOMIC_ACQUIRE, "agent");
            xb_add(&bar[XB_XGEN(b.x)], 1u);
            asm volatile("s_waitcnt vmcnt(0)" ::: "memory");
        } else {
            XB_SPIN(xb_ld(&bar[XB_XGEN(b.x)]) == gen, bar);
            __builtin_amdgcn_fence(__ATOMIC_ACQUIRE, "agent");
            asm volatile("s_waitcnt vmcnt(0)" ::: "memory");
        }
    }
    __syncthreads();
}
constexpr int CW_BAR = 4096;

struct Args { P p; unsigned* ctl; int ph_lo, ph_hi; };

__global__ void __launch_bounds__(NTHR, 2) mk_fwd(Args args) {
    extern __shared__ __attribute__((aligned(16))) unsigned char lds_raw[];
    Ctx X; X.lds = (LAS unsigned char*)lds_raw; X.tid = threadIdx.x; X.lane = X.tid & 63; X.wave = __builtin_amdgcn_readfirstlane(X.tid >> 6);
    X.G = gridDim.x; { const int bx = blockIdx.x; X.vcu = (X.G % 8 == 0) ? (bx % 8) * (X.G / 8) + bx / 8 : bx; }
    const P& p = args.p; const int lo = args.ph_lo, hi = args.ph_hi;
    const int cid = (int)blockIdx.x;
#define IN(k) (lo <= (k) && (k) < hi)
    for (int u = X.tid; u < (LDS_BYTES - RING_BYTES) / 4; u += NTHR) ((LAS unsigned*)(X.lds + RING_BYTES))[u] = 0u;
    __syncthreads();
#if BARRIER_KIND == 1
    cooperative_groups::grid_group cgrid = cooperative_groups::this_grid();
#define GRID_BAR() do { if (hi - lo > 1) cgrid.sync(); } while (0)
#else
    XcdBarrier xbar = xcd_barrier_post(args.ctl + CW_BAR, (volatile LAS unsigned*)(X.lds + MISC_OFF));
#define GRID_BAR() do { if (hi - lo > 1) xcd_barrier(xbar); } while (0)
#endif
#ifdef PROBE_A
    volatile unsigned long long* ts = (volatile unsigned long long*)(args.ctl + 65536);
    int n_stamp = 0;
#define STAMP() do { if (blockIdx.x == 0 && X.tid == 0) ts[n_stamp] = __builtin_amdgcn_s_memrealtime(); ++n_stamp; } while (0)
#else
#define STAMP() do { } while (0)
#endif
    STAMP();
    if (IN(0)) { phase_p0a(X, p); GRID_BAR(); STAMP(); }
    if (IN(1)) { phase_p0b(X, p); GRID_BAR(); STAMP(); }
    if (IN(2)) {
        { pg8::SchedDense Sd; Sd.init(p.U, p.Wt_in, T, 2 * CW, D, X.G, cid); epi::EpiGlu Ep{p.V, p.b_in};
          pg8::gemm_phase<epi::EpiGlu, pg8::SchedDense, false>(X.lds, 2 * D, Sd, Ep); }
        { pg8::SchedDense Sd; Sd.init(p.Wt_in + (size_t)(2 * CW) * D, p.U, FW, T, D, X.G, cid); epi::EpiFT Ep{p.FT, p.b_in + 2 * CW};
          pg8::gemm_phase<epi::EpiFT, pg8::SchedDense, false>(X.lds, 2 * D, Sd, Ep); }
        GRID_BAR(); STAMP();
    }
    if (IN(3)) {
        phase_conv(X, p);
        phase_fftA(X, p);
        GRID_BAR(); STAMP();
        { pg8::SchedDense Sd; Sd.init(p.D256, p.GP, 512, Bn * 16 * FW, 512, X.G, cid); epi::EpiFFT Ep{p.YRI};
          pg8::gemm_phase<epi::EpiFFT, pg8::SchedDense, false>(X.lds, 2 * 512, Sd, Ep); }
        GRID_BAR(); STAMP();
    }
    if (IN(4)) {
        { pg8::SchedDense Sd; Sd.init(p.ACONV, p.Wt_conv, T, D, CW, X.G, cid); epi::EpiBias Ep{p.YCONV, D, p.cb_out};
          pg8::gemm_phase<epi::EpiBias, pg8::SchedDense, false>(X.lds, 2 * CW, Sd, Ep); }
        { pg8::SchedDense Sd; Sd.init(p.YRI, p.Wt_four, T, D, 2 * FW, X.G, cid); epi::EpiBias Ep{p.YFOUR, D, p.four_b};
          pg8::gemm_phase<epi::EpiBias, pg8::SchedDense, false>(X.lds, 4 * FW, Sd, Ep); }
        GRID_BAR(); STAMP();
    }
    if (IN(5)) {
        pg8::SchedDense Sd; Sd.init(p.U, p.Wt_in + (size_t)(2 * CW + FW) * D, T, 2 * D, D, X.G, cid); epi::EpiMerge Ep{p.MERGED, p.YCONV, p.YFOUR, p.b_in};
        pg8::gemm_phase<epi::EpiMerge, pg8::SchedDense, false>(X.lds, 2 * D, Sd, Ep);
        GRID_BAR(); STAMP();
    }
    if (IN(6)) {
        pg8::SchedDense Sd; Sd.init(p.MERGED, p.Wt_out, T, D, D, X.G, cid);
#if H_DELTA
        epi::EpiDelta Ep{p.DELTA, p.MOD + 2 * D, p.b_out};
        pg8::gemm_phase<epi::EpiDelta, pg8::SchedDense, false>(X.lds, 2 * D, Sd, Ep);
#else
        epi::EpiResid Ep{p.x, p.out, p.MOD + 2 * D, p.b_out};
        pg8::gemm_phase<epi::EpiResid, pg8::SchedDense, false>(X.lds, 2 * D, Sd, Ep);
#endif
        GRID_BAR(); STAMP();
    }
    if (IN(7)) { phase_router(X, p, H_DELTA ? p.x : p.out); GRID_BAR(); STAMP(); }
    if (IN(8)) { phase_topk(X, p); GRID_BAR(); STAMP(); }
    if (IN(9)) {
        constexpr int esz = MOE_F8 ? 1 : 2;
        pg8::SchedG1 Sd{(const char*)p.U, (const char*)p.Wt_gu, p.ROWL, X.G, cid, esz}; epi::EpiSwiglu<MOE_F8 != 0> Ep{p.ACT};
        pg8::gemm_phase<epi::EpiSwiglu<MOE_F8 != 0>, pg8::SchedG1, true, MOE_F8 != 0>(X.lds, D * esz, Sd, Ep, epi::MX_W, epi::MX_U);
        GRID_BAR(); STAMP();
    }
    if (IN(10)) {
        constexpr int esz = MOE_F8 ? 1 : 2;
        pg8::SchedG2 Sd{(const char*)p.ACT, (const char*)p.Wt_down, X.G, cid, esz}; epi::EpiScaleW Ep{p.YB, p.WTS};
        pg8::gemm_phase<epi::EpiScaleW, pg8::SchedG2, false, MOE_F8 != 0>(X.lds, F * esz, Sd, Ep, epi::MX_W, epi::MX_ACT);
        GRID_BAR(); STAMP();
    }
    if (IN(11)) { phase_final(X, p); }
#ifdef PROBE_A
    STAMP();
    if (blockIdx.x == 0 && X.tid == 0) { const unsigned long long dt = (ts[PROBE_B] - ts[PROBE_A]) * PROBE_AMP, t0 = __builtin_amdgcn_s_memrealtime();
        while (__builtin_amdgcn_s_memrealtime() - t0 < dt) __builtin_amdgcn_s_sleep(8); }
#endif
#undef IN
}

extern "C" void kernel_launch(void* const* d_in, const int* in_sizes, int n_in, void* d_out, int out_size, void* d_ws, size_t ws_size, hipStream_t stream) {
    static int grid = 0;
    if (grid == 0) {
        if (n_in != 23 || in_sizes[0] != T * D || out_size != T * D || ws_size < WS_END) { fprintf(stderr, "kernel_launch: unexpected shapes / workspace (%d inputs, ws %zu)\n", n_in, ws_size); grid = -1; return; }
        int dev = 0, cus = 0;
        if (hipGetDevice(&dev) != hipSuccess || hipDeviceGetAttribute(&cus, hipDeviceAttributeMultiprocessorCount, dev) != hipSuccess) { grid = -1; return; }
        if (hipFuncSetAttribute((const void*)mk_fwd, hipFuncAttributeMaxDynamicSharedMemorySize, LDS_BYTES) != hipSuccess) { fprintf(stderr, "kernel_launch: hipFuncSetAttribute failed\n"); grid = -1; return; }
        if (cus < 256) { fprintf(stderr, "kernel_launch: built for a 256-CU device (one workgroup per CU), found %d CUs\n", cus); grid = -1; return; }
        int per_cu = 0;
        if (hipOccupancyMaxActiveBlocksPerMultiprocessor(&per_cu, (const void*)mk_fwd, NTHR, LDS_BYTES) != hipSuccess || per_cu < 1) { fprintf(stderr, "kernel_launch: occupancy query reports %d workgroups per CU\n", per_cu); grid = -1; return; }
        grid = 256;
    }
    if (grid < 0) return;
    unsigned char* ws = (unsigned char*)d_ws;
    Args a{};
    P& p = a.p;
    p.x = (const float*)d_in[0]; p.c = (const float*)d_in[1]; p.ada_w = (const float*)d_in[2]; p.ada_b = (const float*)d_in[3]; p.norm1_g = (const float*)d_in[4];
    p.w_in = (const float*)d_in[5]; p.b_in = (const float*)d_in[6]; p.dw_w = (const float*)d_in[7]; p.dw_b = (const float*)d_in[8]; p.cln_g = (const float*)d_in[9]; p.cln_b = (const float*)d_in[10];
    p.cw_out = (const float*)d_in[11]; p.cb_out = (const float*)d_in[12]; p.four_w = (const float*)d_in[13]; p.four_b = (const float*)d_in[14]; p.w_out = (const float*)d_in[15]; p.b_out = (const float*)d_in[16];
    p.norm2_g = (const float*)d_in[17]; p.router_w = (const float*)d_in[18]; p.w_gate = (const float*)d_in[19]; p.w_up = (const float*)d_in[20]; p.w_down = (const float*)d_in[21]; p.final_g = (const float*)d_in[22];
    p.out = (float*)d_out;
    p.MOD = (float*)(ws + WS_MOD); p.W2F = (float*)(ws + WS_W2F); p.AFF = (float*)(ws + WS_AFF); p.ROWL = (int*)(ws + WS_ROWL); p.WTS = (float*)(ws + WS_WTS); p.INV = (short*)(ws + WS_INV);
    p.Wt_in = (bf16_t*)(ws + WS_WIN); p.Wt_conv = (bf16_t*)(ws + WS_WCONV); p.Wt_four = (bf16_t*)(ws + WS_WFOUR); p.Wt_out = (bf16_t*)(ws + WS_WOUT);
    p.D256 = (bf16_t*)(ws + WS_D256); p.GP = (bf16_t*)(ws + WS_GP); p.Wt_gu = (bf16_t*)(ws + WS_WGU); p.Wt_down = (bf16_t*)(ws + WS_WDOWN);
    p.U = (bf16_t*)(ws + WS_U); p.V = (bf16_t*)(ws + WS_V); p.FT = (bf16_t*)(ws + WS_FT); p.ACONV = (bf16_t*)(ws + WS_ACONV); p.YRI = (bf16_t*)(ws + WS_YRI);
    p.YCONV = (bf16_t*)(ws + WS_YCONV); p.YFOUR = (bf16_t*)(ws + WS_YFOUR); p.MERGED = (bf16_t*)(ws + WS_MERGED); p.ACT = (bf16_t*)(ws + WS_ACT); p.YB = (bf16_t*)(ws + WS_YB); p.DELTA = (bf16_t*)(ws + WS_DELTA);
    (void)hipMemsetAsync(ws + WS_CTL, 0, CTL_ZERO_BYTES, stream);
    a.ctl = (unsigned*)(ws + WS_CTL);
    a.ph_lo = 0; a.ph_hi = 12;
#ifndef PLAIN_LAUNCH
#define PLAIN_LAUNCH 0
#endif
#if PLAIN_LAUNCH
    hipLaunchKernelGGL(mk_fwd, dim3(grid), dim3(NTHR), LDS_BYTES, stream, a);
#else
    { void* kargs[] = {&a}; hipError_t le = hipLaunchCooperativeKernel((const void*)mk_fwd, dim3(grid), dim3(NTHR), kargs, LDS_BYTES, stream);
      if (le != hipSuccess) fprintf(stderr, "kernel_launch: cooperative launch failed: %s\n", hipGetErrorString(le)); }
#endif
}
```

```cpp
#include <hip/hip_runtime.h>
#include <hip/hip_cooperative_groups.h>
#include <cstdio>
#include <cstdint>

#define LAS __attribute__((address_space(3)))
#define GAS __attribute__((address_space(1)))
typedef unsigned short bf16_t;
typedef short bf16x8 __attribute__((ext_vector_type(8)));
typedef float f32x4 __attribute__((ext_vector_type(4)));
typedef float f32x2 __attribute__((ext_vector_type(2)));
typedef unsigned u32x4 __attribute__((ext_vector_type(4)));
typedef unsigned u32x2 __attribute__((ext_vector_type(2)));
typedef int i32x8 __attribute__((ext_vector_type(8)));

constexpr int Bn = 8, S = 4096, D = 1024, T = Bn * S;
constexpr int CW = 512, CK = 31, FW = 512, FG = 4, FGD = 128;
constexpr int INC = 2 * CW + FW + 2 * D;
constexpr int E = 16, CAP = 2 * S / E;
constexpr int F = 2 * D;
constexpr int NMOD = 6;
constexpr int ME = Bn * CAP;
constexpr int NWAVES = 8, NTHR = 512;

__device__ __forceinline__ float sigmoidf_(float x) { return __builtin_amdgcn_rcpf(1.f + __expf(-x)); }
__device__ __forceinline__ float siluf_(float x) { return x * __builtin_amdgcn_rcpf(1.f + __expf(-x)); }
__device__ __forceinline__ unsigned f2bf(float f) { unsigned u = __builtin_bit_cast(unsigned, f); return (u + 0x7fffu + ((u >> 16) & 1u)) >> 16; }
__device__ __forceinline__ unsigned pk2(float lo, float hi) { return f2bf(lo) | (f2bf(hi) << 16); }
__device__ __forceinline__ unsigned cvt_pk_bf16(float lo, float hi) { unsigned r; asm volatile("v_cvt_pk_bf16_f32 %0, %1, %2" : "=v"(r) : "v"(lo), "v"(hi)); return r; }
__device__ __forceinline__ float bf_lo(unsigned w) { return __builtin_bit_cast(float, w << 16); }
__device__ __forceinline__ float bf_hi(unsigned w) { return __builtin_bit_cast(float, w & 0xffff0000u); }
__device__ __forceinline__ float wave_sum(float v) {
#pragma unroll
    for (int o = 1; o < 64; o <<= 1) v += __shfl_xor(v, o);
    return v;
}
__device__ __forceinline__ u32x2 pack8_f8(const f32x4 v0, const f32x4 v1, const float sc) {
    unsigned a = 0u, b = 0u;
    a = __builtin_amdgcn_cvt_pk_fp8_f32(v0[0] * sc, v0[1] * sc, a, false); a = __builtin_amdgcn_cvt_pk_fp8_f32(v0[2] * sc, v0[3] * sc, a, true);
    b = __builtin_amdgcn_cvt_pk_fp8_f32(v1[0] * sc, v1[1] * sc, b, false); b = __builtin_amdgcn_cvt_pk_fp8_f32(v1[2] * sc, v1[3] * sc, b, true);
    return (u32x2){a, b};
}
#define LDS_WAIT() asm volatile("s_waitcnt lgkmcnt(0)" ::: "memory")
#define VM_WAIT() asm volatile("s_waitcnt vmcnt(0)" ::: "memory")

namespace pg8 {
constexpr int BM = 256, BK = 64, HALF = 128, HTB = HALF * BK * 2  , STAGE_BYTES = 8 * HTB, NXCD = 8, WGM = 8;
__host__ __device__ __forceinline__ int lds_byte(int r, int c) { const int st = (r >> 4) * 2 + (c >> 5), rr = r & 15, cc = c & 31, ob = rr * 64 + cc * 2; return st * 1024 + (ob ^ (((ob >> 9) & 1) << 5)); }
__host__ __device__ __forceinline__ void stage_rc(int b, int& R, int& C) { const int st = b / 1024, sb = b % 1024, swz = sb ^ (((sb >> 9) & 1) << 5); R = (st >> 1) * 16 + swz / 64; C = (st & 1) * 32 + (swz % 64) / 2; }
__host__ __device__ __forceinline__ int f8_off(int r, int fq) { const int rr = r & 15; return ((r >> 4) * 2 + (fq >> 1)) * 1024 + ((rr * 64 + 32 * (fq & 1)) ^ ((rr >> 3) << 5)); }
__host__ __device__ __forceinline__ int perm32(int rho) { const int n = rho >> 4, i = rho & 15; return 8 * (i >> 2) + 4 * n + (i & 3); }

struct Unit { const char* a; const char* b; const int* rows; int pm, pn, e; };

template <class Epi, class Sched, bool GATHER, bool F8 = false>
__device__ __forceinline__ void gemm_phase(LAS unsigned char* lds, const int KB, const Sched& S, const Epi& E, const int sw = 0x7f7f7f7f, const int sx = 0x7f7f7f7f) {
    int tid_ = threadIdx.x; asm volatile("" : "+v"(tid_));
    const int tid = tid_, wid = __builtin_amdgcn_readfirstlane(tid >> 6), lane = tid & 63, wr = wid >> 2, wc = wid & 3, fr = lane & 15, fq = lane >> 4;
    const int nt = KB / (BK * 2);
    int swv = sw, sxv = sx; if constexpr (F8) { asm volatile("" : "+v"(swv), "+v"(sxv)); }
    unsigned voffA[2], voffB[2]; int R0, C0;
#pragma unroll
    for (int i = 0; i < 2; ++i) { int R, C; stage_rc(tid * 16 + i * 8192, R, C); const int Rb = Epi::PERM ? ((R & ~31) + perm32(R & 31)) : R;
        voffA[i] = (unsigned)(R * KB + C * 2); voffB[i] = (unsigned)(Rb * KB + C * 2); if (i == 0) { R0 = R; C0 = C; } }
    const size_t kstep = (size_t)(BK * 2);
    const size_t hstep = (size_t)HALF * KB;
    const unsigned ldsw = (unsigned)wid * 1024u;
    const int aoff = lds_byte(wr * 64 + fr, fq * 8), boff = lds_byte(wc * 32 + fr, fq * 8);
#define PG8_SA(b, h) (((b) * 2 + (h)) * HTB)
#define PG8_SB(b, h) ((4 + (b) * 2 + (h)) * HTB)
#define PG8_STAGE(bufoff, gbase, voff) do { _Pragma("unroll") for (int _i = 0; _i < 2; ++_i) \
        __builtin_amdgcn_global_load_lds((const unsigned*)((const char*)(gbase) + (voff)[_i]), (LAS unsigned*)(lds + (bufoff) + ldsw + _i * 8192), 16, 0, 0); } while (0)
#define PG8_STGA(bufoff, p, h, v) do { if constexpr (GATHER) { PG8_STAGE(bufoff, p, (v) + 2 * (h)); } else { PG8_STAGE(bufoff, (p) + (h) * hstep, voffA); } } while (0)
#define PG8_LD8(p) __builtin_bit_cast(i32x8, __builtin_shufflevector(*(const LAS u32x4*)(p), *(const LAS u32x4*)((p) + 1024), 0, 1, 2, 3, 4, 5, 6, 7))
#define PG8_LDA(dst, b, h) do { if constexpr (F8) { _Pragma("unroll") for (int m = 0; m < 4; ++m) dst##8[m] = PG8_LD8(lds + PG8_SA(b, h) + aoff + m * 2048); } \
      else { _Pragma("unroll") for (int m = 0; m < 4; ++m) _Pragma("unroll") for (int k = 0; k < 2; ++k) dst[m][k] = *(const LAS bf16x8*)(lds + PG8_SA(b, h) + aoff + m * 2048 + k * 1024); } } while (0)
#define PG8_LDB(dst, b, h) do { if constexpr (F8) { _Pragma("unroll") for (int n = 0; n < 2; ++n) dst##8[n] = PG8_LD8(lds + PG8_SB(b, h) + boff + n * 2048); } \
      else { _Pragma("unroll") for (int n = 0; n < 2; ++n) _Pragma("unroll") for (int k = 0; k < 2; ++k) dst[n][k] = *(const LAS bf16x8*)(lds + PG8_SB(b, h) + boff + n * 2048 + k * 1024); } } while (0)
#define PG8_MMA(ai, bj, At, Bt) do { __builtin_amdgcn_s_setprio(1); if constexpr (F8) { _Pragma("unroll") for (int m = 0; m < 4; ++m) _Pragma("unroll") for (int n = 0; n < 2; ++n) \
        asm volatile("v_mfma_scale_f32_16x16x128_f8f6f4 %0, %1, %2, %0, %3, %4 op_sel_hi:[0,0,0]" : "+v"(acc[ai][bj][m][n]) : "v"(Bt##8[n]), "v"(At##8[m]), "v"(swv), "v"(sxv)); } \
      else { _Pragma("unroll") for (int m = 0; m < 4; ++m) _Pragma("unroll") for (int n = 0; n < 2; ++n) _Pragma("unroll") for (int k = 0; k < 2; ++k) \
        acc[ai][bj][m][n] = __builtin_amdgcn_mfma_f32_16x16x32_bf16(Bt[n][k], At[m][k], acc[ai][bj][m][n], 0, 0, 0); } __builtin_amdgcn_s_setprio(0); } while (0)
#define PG8_WAIT_V(n) asm volatile("s_waitcnt vmcnt(" #n ")" ::: "memory")
#define PG8_WAIT_L(n) asm volatile("s_waitcnt lgkmcnt(" #n ")" ::: "memory")
#define PG8_BAR __builtin_amdgcn_s_barrier()
#define PG8_SCHED __builtin_amdgcn_sched_barrier(0)
#define PG8_ROWS(u, v) do { if constexpr (GATHER) { _Pragma("unroll") for (int _h = 0; _h < 2; ++_h) _Pragma("unroll") for (int _i = 0; _i < 2; ++_i) \
        v[_h * 2 + _i] = (unsigned)((u).rows[_h * 128 + R0 + 64 * _i] * KB + C0 * 2); } } while (0)
    Unit cur, nxt; int ui = 0;
    if (!S.next(0, cur)) return;
    f32x4 acc[2][2][4][2];
#pragma unroll
    for (int a = 0; a < 2; ++a)
#pragma unroll
        for (int b = 0; b < 2; ++b)
#pragma unroll
            for (int m = 0; m < 4; ++m)
#pragma unroll
                for (int n = 0; n < 2; ++n) acc[a][b][m][n] = (f32x4){0.f, 0.f, 0.f, 0.f};
    bf16x8 At[4][2], B0[2][2], B1[2][2]; i32x8 At8[4], B08[2], B18[2];
    unsigned vAc[4] = {0u, 0u, 0u, 0u}, vAn[4] = {0u, 0u, 0u, 0u}, vW[4] = {0u, 0u, 0u, 0u};
    PG8_ROWS(cur, vAc);
    const char* cA = cur.a; const char* cB = cur.b;
    PG8_STAGE(PG8_SB(0, 0), cB, voffB); PG8_STAGE(PG8_SB(0, 1), cB + hstep, voffB); PG8_STGA(PG8_SA(0, 0), cA, 0, vAc); PG8_STGA(PG8_SA(0, 1), cA, 1, vAc);
    if (wr == 1) PG8_BAR;
    PG8_WAIT_V(2); PG8_BAR;
    PG8_STAGE(PG8_SB(1, 0), cB + kstep, voffB); PG8_STGA(PG8_SA(1, 0), cA + kstep, 0, vAc); PG8_STAGE(PG8_SB(1, 1), cB + hstep + kstep, voffB);
    PG8_WAIT_V(6); PG8_BAR;
    for (;;) {
        const bool has_next = S.next(ui + 1, nxt);
        if (has_next) { PG8_ROWS(nxt, vAn); } else {
#pragma unroll
            for (int j = 0; j < 4; ++j) vAn[j] = vAc[j]; }
        const char* nA = has_next ? nxt.a : cA; const char* nB = has_next ? nxt.b : cB;
        for (int t = 0; t < nt; t += 2) {
            const bool last = (t == nt - 2);
            const char* a1 = cA + (size_t)(t + 1) * kstep;
            const char* a2 = last ? nA : cA + (size_t)(t + 2) * kstep; const char* b2 = last ? nB : cB + (size_t)(t + 2) * kstep;
            const char* a3 = a2 + kstep; const char* b3 = b2 + kstep;
            if constexpr (GATHER) {
                if (last) { asm volatile("" ::: "memory");
#pragma unroll
                    for (int j = 0; j < 4; ++j) vW[j] = vAn[j]; }
                else {
#pragma unroll
                    for (int j = 0; j < 4; ++j) vW[j] = vAc[j]; } }
            PG8_LDB(B0, 0, 0); PG8_LDB(B1, 0, 1); PG8_SCHED; PG8_LDA(At, 0, 0); PG8_STGA(PG8_SA(1, 1), a1, 1, vAc);
            PG8_WAIT_V(8); PG8_WAIT_L(0); PG8_BAR; PG8_MMA(0, 0, At, B0); PG8_MMA(0, 1, At, B1); PG8_BAR; PG8_SCHED;
            PG8_LDA(At, 0, 1); PG8_STAGE(PG8_SB(0, 0), b2, voffB); PG8_STAGE(PG8_SB(0, 1), b2 + hstep, voffB); PG8_STGA(PG8_SA(0, 0), a2, 0, vW);
            PG8_WAIT_V(8); PG8_WAIT_L(0); PG8_BAR; PG8_MMA(1, 0, At, B0); PG8_MMA(1, 1, At, B1); PG8_BAR; PG8_SCHED;
            PG8_LDB(B0, 1, 0); PG8_LDB(B1, 1, 1); PG8_SCHED; PG8_LDA(At, 1, 0); PG8_STGA(PG8_SA(0, 1), a2, 1, vW);
            PG8_WAIT_V(8); PG8_WAIT_L(0); PG8_BAR; PG8_MMA(0, 0, At, B0); PG8_MMA(0, 1, At, B1); PG8_BAR; PG8_SCHED;
            PG8_LDA(At, 1, 1); PG8_STAGE(PG8_SB(1, 0), b3, voffB); PG8_STAGE(PG8_SB(1, 1), b3 + hstep, voffB); PG8_STGA(PG8_SA(1, 0), a3, 0, vW);
            PG8_WAIT_V(8); PG8_WAIT_L(0); PG8_BAR; PG8_MMA(1, 0, At, B0); PG8_MMA(1, 1, At, B1); PG8_BAR; PG8_SCHED;
        }
        if (wr == 0) PG8_BAR;
        if constexpr (F8) { asm volatile("s_nop 15\n\ts_nop 15" ::: "memory"); }
        E(acc, cur, wr, wc, fr, fq);
        if (!has_next) break;
#pragma unroll
        for (int a = 0; a < 2; ++a)
#pragma unroll
            for (int b = 0; b < 2; ++b)
#pragma unroll
                for (int m = 0; m < 4; ++m)
#pragma unroll
                    for (int n = 0; n < 2; ++n) acc[a][b][m][n] = (f32x4){0.f, 0.f, 0.f, 0.f};
        cur = nxt; cA = nA; cB = nB; ++ui;
#pragma unroll
        for (int j = 0; j < 4; ++j) vAc[j] = vAn[j];
        if (wr == 1) PG8_BAR;
    }
    PG8_WAIT_V(0);
    PG8_BAR;
#undef PG8_SA
#undef PG8_SB
#undef PG8_STAGE
#undef PG8_STGA
#undef PG8_LDA
#undef PG8_LDB
#undef PG8_MMA
#undef PG8_LD8
#undef PG8_WAIT_V
#undef PG8_WAIT_L
#undef PG8_BAR
#undef PG8_SCHED
#undef PG8_ROWS
}

struct SchedDense {
    const char* A; const char* Bt; int nM, nN, nwg, G, c; size_t tstep;
    __device__ void init(const void* A_, const void* Bt_, int M, int N, int K, int G_, int c_) { A = (const char*)A_; Bt = (const char*)Bt_; nM = M / BM; nN = N / BM; nwg = nM * nN; G = G_; c = c_; tstep = (size_t)BM * K * 2; }
    __device__ bool next(int i, Unit& u) const {
        const long L = (long)i * G + c; if (L >= nwg) return false;
        int wgid = (int)L; { const int q = nwg / NXCD, r = nwg % NXCD, xcd = wgid % NXCD, off = wgid / NXCD; wgid = (xcd < r ? xcd * (q + 1) : r * (q + 1) + (xcd - r) * q) + off; }
        const int nig = WGM * nN, gid = wgid / nig, fm = gid * WGM, gsz = (nM - fm) < WGM ? (nM - fm) : WGM;
        u.pm = fm + ((wgid % nig) % gsz); u.pn = (wgid % nig) / gsz; u.e = 0; u.rows = nullptr;
        u.a = A + (size_t)u.pm * tstep; u.b = Bt + (size_t)u.pn * tstep; return true;
    }
};
}

#ifndef GATE_F8
#define GATE_F8 1
#endif
#ifndef H_DELTA
#define H_DELTA 1
#endif
#ifndef YB_F8
#define YB_F8 1
#endif
#ifndef MOE_F8
#define MOE_F8 1
#endif

namespace epi {
using pg8::Unit;
#define EPI_ROWS(ai, m) (128 * (ai) + 64 * wr + 16 * (m) + fr)
__device__ __forceinline__ u32x4 pack8(const f32x4 v0, const f32x4 v1) { u32x4 w; w.x = cvt_pk_bf16(v0[0], v0[1]); w.y = cvt_pk_bf16(v0[2], v0[3]); w.z = cvt_pk_bf16(v1[0], v1[1]); w.w = cvt_pk_bf16(v1[2], v1[3]); return w; }
__device__ __forceinline__ f32x4 sig4(const f32x4 v) { return (f32x4){sigmoidf_(v[0]), sigmoidf_(v[1]), sigmoidf_(v[2]), sigmoidf_(v[3])}; }
__device__ __forceinline__ f32x4 silu4(const f32x4 v) { return (f32x4){siluf_(v[0]), siluf_(v[1]), siluf_(v[2]), siluf_(v[3])}; }
__device__ __forceinline__ void unpack8(const u32x4 w, f32x4& v0, f32x4& v1) { v0 = (f32x4){bf_lo(w.x), bf_hi(w.x), bf_lo(w.y), bf_hi(w.y)}; v1 = (f32x4){bf_lo(w.z), bf_hi(w.z), bf_lo(w.w), bf_hi(w.w)}; }

struct EpiGlu {
    static constexpr bool PERM = true;
    bf16_t* V; const float* bias;
    __device__ __forceinline__ void operator()(const f32x4 (&acc)[2][2][4][2], const Unit& u, int wr, int wc, int fr, int fq) const {
        const int ch = u.pn * 128 + wc * 32 + 8 * fq;
        f32x4 ba[2], bg[2];
#pragma unroll
        for (int n = 0; n < 2; ++n) { ba[n] = *(const f32x4*)(bias + ch + 4 * n); bg[n] = *(const f32x4*)(bias + CW + ch + 4 * n); }
#pragma unroll
        for (int ai = 0; ai < 2; ++ai)
#pragma unroll
            for (int m = 0; m < 4; ++m) { const size_t row = (size_t)u.pm * 256 + EPI_ROWS(ai, m);
                const f32x4 v0 = (acc[ai][0][m][0] + ba[0]) * sig4(acc[ai][1][m][0] + bg[0]), v1 = (acc[ai][0][m][1] + ba[1]) * sig4(acc[ai][1][m][1] + bg[1]);
                *(u32x4*)(V + row * CW + ch) = pack8(v0, v1); }
    }
};
struct EpiFT {
    static constexpr bool PERM = true;
    bf16_t* FT; const float* bias;
    __device__ __forceinline__ void operator()(const f32x4 (&acc)[2][2][4][2], const Unit& u, int wr, int wc, int fr, int fq) const {
#pragma unroll
        for (int ai = 0; ai < 2; ++ai)
#pragma unroll
            for (int m = 0; m < 4; ++m) { const int ch = u.pm * 256 + EPI_ROWS(ai, m); const float bv = bias[ch];
#pragma unroll
                for (int bj = 0; bj < 2; ++bj) { const int tok = u.pn * 256 + bj * 128 + wc * 32 + 8 * fq; const int b = tok >> 12, s = tok & (S - 1);
                    *(u32x4*)(FT + ((size_t)(b * FW + ch) * S + s)) = pack8(acc[ai][bj][m][0] + bv, acc[ai][bj][m][1] + bv); } }
    }
};
struct EpiFFT {
    static constexpr bool PERM = true;
    bf16_t* YRI;
    __device__ __forceinline__ void operator()(const f32x4 (&acc)[2][2][4][2], const Unit& u, int wr, int wc, int fr, int fq) const {
        const int part = u.pm, chb = u.pn & 1, k2 = (u.pn >> 1) & 15, b = u.pn >> 5;
#pragma unroll
        for (int ai = 0; ai < 2; ++ai)
#pragma unroll
            for (int m = 0; m < 4; ++m) { const int k1 = EPI_ROWS(ai, m);
                bf16_t* rowp = YRI + ((size_t)(b * S + 16 * k1 + k2) * (2 * FW) + part * FW + chb * 256 + wc * 32 + 8 * fq);
#pragma unroll
                for (int bj = 0; bj < 2; ++bj) *(u32x4*)(rowp + bj * 128) = pack8(acc[ai][bj][m][0], acc[ai][bj][m][1]); }
    }
};
struct EpiBias {
    static constexpr bool PERM = true;
    bf16_t* O; int ldc; const float* bias;
    __device__ __forceinline__ void operator()(const f32x4 (&acc)[2][2][4][2], const Unit& u, int wr, int wc, int fr, int fq) const {
        const int col0 = u.pn * 256 + wc * 32 + 8 * fq;
        f32x4 bv[2][2];
#pragma unroll
        for (int bj = 0; bj < 2; ++bj)
#pragma unroll
            for (int n = 0; n < 2; ++n) bv[bj][n] = *(const f32x4*)(bias + col0 + bj * 128 + 4 * n);
#pragma unroll
        for (int ai = 0; ai < 2; ++ai)
#pragma unroll
            for (int m = 0; m < 4; ++m) { bf16_t* rowp = O + ((size_t)u.pm * 256 + EPI_ROWS(ai, m)) * ldc + col0;
#pragma unroll
                for (int bj = 0; bj < 2; ++bj) *(u32x4*)(rowp + bj * 128) = pack8(acc[ai][bj][m][0] + bv[bj][0], acc[ai][bj][m][1] + bv[bj][1]); }
    }
};
struct EpiMerge {
    static constexpr bool PERM = true;
    bf16_t* MG; const bf16_t* YC; const bf16_t* YF; const float* bias;
    __device__ __forceinline__ void operator()(const f32x4 (&acc)[2][2][4][2], const Unit& u, int wr, int wc, int fr, int fq) const {
        const int nn = u.pn * 128 + wc * 32 + 8 * fq;
        f32x4 b0[2], b1[2];
#pragma unroll
        for (int n = 0; n < 2; ++n) { b0[n] = *(const f32x4*)(bias + 2 * CW + FW + nn + 4 * n); b1[n] = *(const f32x4*)(bias + 2 * CW + FW + D + nn + 4 * n); }
#pragma unroll
        for (int ai = 0; ai < 2; ++ai)
#pragma unroll
            for (int m = 0; m < 4; ++m) { const size_t off = ((size_t)u.pm * 256 + EPI_ROWS(ai, m)) * D + nn;
                const u32x4 wc_ = *(const u32x4*)(YC + off), wf_ = *(const u32x4*)(YF + off);
                f32x4 c0, c1, f0, f1; unpack8(wc_, c0, c1); unpack8(wf_, f0, f1);
                const f32x4 v0 = sig4(acc[ai][0][m][0] + b0[0]) * c0 + sig4(acc[ai][1][m][0] + b1[0]) * f0;
                const f32x4 v1 = sig4(acc[ai][0][m][1] + b0[1]) * c1 + sig4(acc[ai][1][m][1] + b1[1]) * f1;
                *(u32x4*)(MG + off) = pack8(v0, v1); }
    }
};
struct EpiResid {
    static constexpr bool PERM = false;
    const float* X; float* H; const float* gate; const float* bias;
    __device__ __forceinline__ void operator()(const f32x4 (&acc)[2][2][4][2], const Unit& u, int wr, int wc, int fr, int fq) const {
        const int col0 = u.pn * 256 + wc * 32 + 4 * fq; const int b = (u.pm * 256) >> 12;
        const float* gp = gate + (size_t)b * NMOD * D + col0; const float* bp = bias + col0;
#pragma unroll
        for (int ai = 0; ai < 2; ++ai) {
            f32x4 xv[4][2][2];
#pragma unroll
            for (int m = 0; m < 4; ++m) { const size_t off = ((size_t)u.pm * 256 + EPI_ROWS(ai, m)) * D + col0;
#pragma unroll
                for (int bj = 0; bj < 2; ++bj)
#pragma unroll
                    for (int n = 0; n < 2; ++n) xv[m][bj][n] = *(const f32x4*)(X + off + bj * 128 + n * 16); }
#pragma unroll
            for (int bj = 0; bj < 2; ++bj)
#pragma unroll
                for (int n = 0; n < 2; ++n) { const f32x4 gv = *(const f32x4*)(gp + bj * 128 + n * 16), bv = *(const f32x4*)(bp + bj * 128 + n * 16);
#pragma unroll
                    for (int m = 0; m < 4; ++m) { const size_t off = ((size_t)u.pm * 256 + EPI_ROWS(ai, m)) * D + col0;
                        *(f32x4*)(H + off + bj * 128 + n * 16) = xv[m][bj][n] + gv * (acc[ai][bj][m][n] + bv); } }
            asm volatile("" ::: "memory");
        }
    }
};
struct EpiDelta {
    static constexpr bool PERM = true;
    bf16_t* DL; const float* gate; const float* bias;
    __device__ __forceinline__ void operator()(const f32x4 (&acc)[2][2][4][2], const Unit& u, int wr, int wc, int fr, int fq) const {
        const int col0 = u.pn * 256 + wc * 32 + 8 * fq; const int b = (u.pm * 256) >> 12;
        f32x4 bv[2][2], gv[2][2];
#pragma unroll
        for (int bj = 0; bj < 2; ++bj)
#pragma unroll
            for (int n = 0; n < 2; ++n) { bv[bj][n] = *(const f32x4*)(bias + col0 + bj * 128 + 4 * n); gv[bj][n] = *(const f32x4*)(gate + (size_t)b * NMOD * D + col0 + bj * 128 + 4 * n); }
#pragma unroll
        for (int ai = 0; ai < 2; ++ai)
#pragma unroll
            for (int m = 0; m < 4; ++m) { bf16_t* rowp = DL + ((size_t)u.pm * 256 + EPI_ROWS(ai, m)) * D + col0;
#pragma unroll
                for (int bj = 0; bj < 2; ++bj) *(u32x4*)(rowp + bj * 128) = pack8(gv[bj][0] * (acc[ai][bj][m][0] + bv[bj][0]), gv[bj][1] * (acc[ai][bj][m][1] + bv[bj][1])); }
    }
};
constexpr float ACT_SC = 2.f, U_SC = 4.f, W_SC = 64.f;
constexpr int MX_U = 0x7d7d7d7d, MX_ACT = 0x7e7e7e7e, MX_W = 0x79797979;
template <bool F8> struct EpiSwiglu {
    static constexpr bool PERM = true;
    void* ACT;
    __device__ __forceinline__ void operator()(const f32x4 (&acc)[2][2][4][2], const Unit& u, int wr, int wc, int fr, int fq) const {
        const int col = u.pn * 128 + wc * 32 + 8 * fq;
#pragma unroll
        for (int ai = 0; ai < 2; ++ai)
#pragma unroll
            for (int m = 0; m < 4; ++m) { const size_t row = (size_t)u.e * ME + u.pm * 256 + EPI_ROWS(ai, m);
                const f32x4 v0 = silu4(acc[ai][0][m][0]) * acc[ai][1][m][0], v1 = silu4(acc[ai][0][m][1]) * acc[ai][1][m][1];
                if constexpr (F8) *(u32x2*)((unsigned char*)ACT + row * F + col) = pack8_f8(v0, v1, ACT_SC);
                else *(u32x4*)((bf16_t*)ACT + row * F + col) = pack8(v0, v1); }
    }
};
constexpr float YB_SC = 32.f;
struct EpiScaleW {
    static constexpr bool PERM = true;
    void* YB; const float* W;
    __device__ __forceinline__ void operator()(const f32x4 (&acc)[2][2][4][2], const Unit& u, int wr, int wc, int fr, int fq) const {
        const int col0 = u.pn * 256 + wc * 32 + 8 * fq;
#pragma unroll
        for (int ai = 0; ai < 2; ++ai)
#pragma unroll
            for (int m = 0; m < 4; ++m) { const size_t row = (size_t)u.e * ME + u.pm * 256 + EPI_ROWS(ai, m); const float w = W[row];
#pragma unroll
                for (int bj = 0; bj < 2; ++bj) {
                    if (YB_F8) *(u32x2*)((unsigned char*)YB + row * D + col0 + bj * 128) = pack8_f8(acc[ai][bj][m][0], acc[ai][bj][m][1], w * YB_SC);
                    else *(u32x4*)((bf16_t*)YB + row * D + col0 + bj * 128) = pack8(acc[ai][bj][m][0] * w, acc[ai][bj][m][1] * w); } }
    }
};
#undef EPI_ROWS
}

namespace pg8 {
struct SchedG1 {
    const char* U; const char* W; const int* rowl; int G, c, esz;
    __device__ bool next(int i, Unit& u) const {
        int e;
        if (G == 256) { if (i >= 16) return false; const int xcd = c & 7, j = c >> 3, ri = i & 7; e = 2 * xcd + (i >> 3); u.pm = (ri & 1) * 8 + (j & 7); u.pn = (ri >> 1) * 4 + (j >> 3); }
        else { const int L = i * G + c; if (L >= E * 256) return false; e = L >> 8; const int l = L & 255; u.pm = l & 15; u.pn = l >> 4; }
        u.e = e; u.a = U; u.rows = rowl + e * ME + u.pm * 256; u.b = W + ((size_t)e * 2 * F + (size_t)u.pn * 256) * D * esz; return true;
    }
};
struct SchedG2 {
    const char* ACT; const char* W; int G, c, esz;
    __device__ bool next(int i, Unit& u) const {
        int e;
        if (G == 256) { if (i >= 4) return false; const int xcd = c & 7, j = c >> 3; e = 2 * xcd + (i >> 1); u.pm = (i & 1) * 8 + (j & 7); u.pn = j >> 3; }
        else { const int L = i * G + c; if (L >= E * 64) return false; e = L >> 6; const int l = L & 63; u.pm = l & 15; u.pn = l >> 4; }
        u.e = e; u.rows = nullptr;
        u.a = ACT + ((size_t)e * ME + (size_t)u.pm * 256) * F * esz; u.b = W + ((size_t)e * D + (size_t)u.pn * 256) * F * esz; return true;
    }
};
}

struct Ctx {
    LAS unsigned char* lds; int tid, lane, wave, vcu, G;
};

__device__ __forceinline__ void transpose_item(const float* W, int ldw, int k0, int n0, bf16_t* WT, int ldt, int dst_row0, LAS float* scr, int lane) {
#pragma unroll 8
    for (int i = 0; i < 32; ++i) { const int kk = 2 * i + (lane >> 5); scr[kk * 33 + (lane & 31)] = W[(size_t)(k0 + kk) * ldw + n0 + (lane & 31)]; }
    LDS_WAIT(); asm volatile("" ::: "memory");
    const int c = lane & 7;
#pragma unroll
    for (int j = 0; j < 4; ++j) { const int n = (lane >> 3) + 8 * j; const LAS float* s = scr + (8 * c) * 33 + n;
        u32x4 o; o.x = pk2(s[0 * 33], s[1 * 33]); o.y = pk2(s[2 * 33], s[3 * 33]); o.z = pk2(s[4 * 33], s[5 * 33]); o.w = pk2(s[6 * 33], s[7 * 33]);
        *(GAS u32x4*)(WT + (size_t)(dst_row0 + n) * ldt + k0 + 8 * c) = o; }
    LDS_WAIT(); asm volatile("" ::: "memory");
}
struct TItem { const float* src; unsigned char* dst; int ldw, ldt, f8; };
__device__ __forceinline__ void titem_load(const TItem& t, int lane, f32x4 (&v)[8]) {
#pragma unroll
    for (int i = 0; i < 8; ++i) v[i] = __builtin_nontemporal_load((const GAS f32x4*)(t.src + (size_t)(8 * i + (lane >> 3)) * t.ldw + (lane & 7) * 4));
}
__device__ __forceinline__ void titem_store_f8(const TItem& t, int lane, const f32x4 (&v)[8], LAS float* scr, float sc) {
#pragma unroll
    for (int i = 0; i < 8; ++i) { LAS float* d = scr + (8 * i + (lane >> 3)) * 33 + (lane & 7) * 4; d[0] = v[i][0]; d[1] = v[i][1]; d[2] = v[i][2]; d[3] = v[i][3]; }
    LDS_WAIT(); asm volatile("" ::: "memory");
#pragma unroll
    for (int j = 0; j < 2; ++j) { const int idx = lane + 64 * j, n = idx >> 2, c = idx & 3; const LAS float* s = scr + (16 * c) * 33 + n;
        unsigned w[4];
#pragma unroll
        for (int q = 0; q < 4; ++q) { unsigned tt = 0u; tt = __builtin_amdgcn_cvt_pk_fp8_f32(s[(4 * q + 0) * 33] * sc, s[(4 * q + 1) * 33] * sc, tt, false); tt = __builtin_amdgcn_cvt_pk_fp8_f32(s[(4 * q + 2) * 33] * sc, s[(4 * q + 3) * 33] * sc, tt, true); w[q] = tt; }
        *(GAS u32x4*)(t.dst + (size_t)n * t.ldt + 16 * c) = (u32x4){w[0], w[1], w[2], w[3]}; }
    LDS_WAIT(); asm volatile("" ::: "memory");
}
__device__ __forceinline__ int win_row(int n0) {
    if (n0 < 2 * CW) { const int half = n0 / CW, ch = n0 % CW; return 256 * (ch / 128) + 128 * half + (ch % 128); }
    if (n0 < 2 * CW + FW) return n0;
    const int cc = n0 - (2 * CW + FW), half = cc / D, c2 = cc % D; return 2 * CW + FW + 256 * (c2 / 128) + 128 * half + (c2 % 128);
}

struct P {
    const float *x, *c, *ada_w, *ada_b, *norm1_g, *w_in, *b_in, *dw_w, *dw_b, *cln_g, *cln_b, *cw_out, *cb_out, *four_w, *four_b, *w_out, *b_out, *norm2_g, *router_w, *w_gate, *w_up, *w_down, *final_g;
    float* out;
    float* MOD; float* W2F; float* AFF; int* ROWL; float* WTS; short* INV;
    bf16_t *Wt_in, *Wt_conv, *Wt_four, *Wt_out, *D256, *GP, *Wt_gu, *Wt_down;
    bf16_t *U, *V, *FT, *ACONV, *YRI, *YCONV, *YFOUR, *MERGED, *ACT, *YB, *DELTA; unsigned char *U8X, *Wt_g8;
};

__device__ __forceinline__ void titem_store_bf16(const TItem& t, int lane, const f32x4 (&v)[8], LAS float* scr) {
#pragma unroll
    for (int i = 0; i < 8; ++i) { LAS float* d = scr + (8 * i + (lane >> 3)) * 33 + (lane & 7) * 4; d[0] = v[i][0]; d[1] = v[i][1]; d[2] = v[i][2]; d[3] = v[i][3]; }
    LDS_WAIT(); asm volatile("" ::: "memory");
    const int c = lane & 7;
#pragma unroll
    for (int j = 0; j < 4; ++j) { const int n = (lane >> 3) + 8 * j; const LAS float* s = scr + (8 * c) * 33 + n;
        u32x4 o; o.x = pk2(s[0 * 33], s[1 * 33]); o.y = pk2(s[2 * 33], s[3 * 33]); o.z = pk2(s[4 * 33], s[5 * 33]); o.w = pk2(s[6 * 33], s[7 * 33]);
        *(GAS u32x4*)(t.dst + ((size_t)n * t.ldt + 8 * c) * 2) = o; }
    LDS_WAIT(); asm volatile("" ::: "memory");
}
__device__ __forceinline__ TItem small_item(const P& p, int r) {
    constexpr int I1 = (D / 64) * (INC / 32), I2 = (CW / 64) * (D / 32);
    TItem t;
    t.f8 = 0;
    if (r < I1) { const int kb = r / (INC / 32), nb = r % (INC / 32); t.src = p.w_in + (size_t)(64 * kb) * INC + 32 * nb; t.ldw = INC; t.ldt = D; t.dst = (unsigned char*)(p.Wt_in + (size_t)win_row(32 * nb) * D + 64 * kb);
        if (GATE_F8 && 32 * nb >= 2 * CW + FW) { t.f8 = 1; t.dst = p.Wt_g8 + (size_t)(win_row(32 * nb) - (2 * CW + FW)) * D + 64 * kb; }
        return t; }
    r -= I1;
    if (r < I2) { const int kb = r / (D / 32), nb = r % (D / 32); t.src = p.cw_out + (size_t)(64 * kb) * D + 32 * nb; t.ldw = D; t.ldt = CW; t.dst = (unsigned char*)(p.Wt_conv + (size_t)(32 * nb) * CW + 64 * kb); return t; }
    r -= I2;
    { const int kb = r / (D / 32), nb = r % (D / 32); t.src = p.w_out + (size_t)(64 * kb) * D + 32 * nb; t.ldw = D; t.ldt = D; t.dst = (unsigned char*)(p.Wt_out + (size_t)(32 * nb) * D + 64 * kb); return t; }
}
__device__ __forceinline__ void phase_p0a(const Ctx& X0, const P& p) {
    Ctx X = X0; X.tid = (int)threadIdx.x; asm volatile("" : "+v"(X.tid)); X.lane = X.tid & 63;
    LAS float* scr = (LAS float*)(X.lds + X.wave * 16384);
    const int gw = X.vcu * NWAVES + X.wave, NGW = X.G * NWAVES;
    constexpr int I1 = (D / 64) * (INC / 32), I2 = (CW / 64) * (D / 32), I4 = (D / 64) * (D / 32);
    const bool do_mod = X.vcu < NMOD * D / 32; const int mcol = X.tid & 31, mks = X.tid >> 5, mj0 = X.vcu * 32;
    float mw[64];
    if (do_mod) {
#pragma unroll
        for (int k = 0; k < 64; ++k) mw[k] = __builtin_nontemporal_load(p.ada_w + (size_t)(mks * 64 + k) * (NMOD * D) + mj0 + mcol); }
    const int fg = X.vcu / (D / 16), fn0 = (X.vcu % (D / 16)) * 16;
    f32x4 ftile = (f32x4){0.f, 0.f, 0.f, 0.f};
    if (X.vcu < FG * (D / 16)) ftile = *(const GAS f32x4*)(p.four_w + (size_t)(fg * FGD + (X.tid >> 2)) * D + fn0 + (X.tid & 3) * 4);
    {   f32x4 va[8], vb[8]; TItem cur, nx; int it = gw;
        if (it < I1 + I2 + I4) { cur = small_item(p, it); titem_load(cur, X.lane, va); }
        while (it < I1 + I2 + I4) {
            const int nxt = it + NGW; if (nxt < I1 + I2 + I4) { nx = small_item(p, nxt); titem_load(nx, X.lane, vb); }
            if (cur.f8) titem_store_f8(cur, X.lane, va, scr, epi::W_SC); else titem_store_bf16(cur, X.lane, va, scr);
#pragma unroll
            for (int i = 0; i < 8; ++i) va[i] = vb[i];
            cur = nx; it = nxt;
        }
    }
    __syncthreads();
    LAS float* ct = (LAS float*)X.lds; LAS float* c128 = ct + S;
    for (int i = X.tid; i < S; i += NTHR) { float sv, cv; sincospif((float)i / (float)(S / 2), &sv, &cv); ct[i] = cv; }
    if (X.tid < FGD) { float sv, cv; sincospif((float)X.tid / 64.f, &sv, &cv); c128[X.tid] = cv; }
    __syncthreads();
    const int gt = X.vcu * NTHR + X.tid, NGT = X.G * NTHR;
    for (int it = gt; it < 512 * 64; it += NGT) { const int r = it >> 6, c0 = (it & 63) * 8; const int part = r >> 8, k1 = r & 255, pc = c0 >> 8, s10 = c0 & 255;
        const int ph = (part == pc) ? 0 : (part == 0 ? -(S / 4) : (S / 4));
        unsigned w[4];
#pragma unroll
        for (int j = 0; j < 4; ++j) { const float a = ct[(16 * k1 * (s10 + 2 * j) + ph) & (S - 1)], b = ct[(16 * k1 * (s10 + 2 * j + 1) + ph) & (S - 1)]; w[j] = pk2(a, b); }
        *(GAS u32x4*)(p.D256 + (size_t)r * 512 + c0) = (u32x4){w[0], w[1], w[2], w[3]}; }
    {
        LAS float* wt = c128 + FGD;
        for (int it = X.vcu; it < FG * (D / 16); it += X.G) { const int g = it / (D / 16), n0 = (it % (D / 16)) * 16;
            __syncthreads();
            if (it == X.vcu) *(LAS f32x4*)(wt + 4 * X.tid) = ftile;
            else for (int i = X.tid; i < FGD * 16; i += NTHR) wt[i] = p.four_w[(size_t)(g * FGD + (i >> 4)) * D + n0 + (i & 15)];
            __syncthreads();
            const int nq = X.tid & 3, c = X.tid >> 2; int idx = 0;
            f32x4 ac = (f32x4){0.f, 0.f, 0.f, 0.f}, as = (f32x4){0.f, 0.f, 0.f, 0.f};
#pragma unroll 8
            for (int j = 0; j < FGD; ++j) { const float tc = c128[idx], ts = c128[(idx + 96) & 127];
                const f32x4 wv = *(const LAS f32x4*)(wt + j * 16 + 4 * nq); ac += wv * tc; as += wv * ts; idx = (idx + c) & 127; }
            *(GAS f32x4*)(p.W2F + (size_t)(g * FGD + c) * D + n0 + 4 * nq) = ac * 0.0013810679320049757f;
            *(GAS f32x4*)(p.W2F + (size_t)(FW + g * FGD + c) * D + n0 + 4 * nq) = as * 0.0013810679320049757f;
        }
    }
    __syncthreads();
    if (do_mod) {
        LAS float* cs = (LAS float*)X.lds;
        LAS float* part = cs + Bn * D;
        for (int i = X.tid; i < Bn * D; i += NTHR) cs[i] = siluf_(p.c[i]);
        __syncthreads();
        const int col = X.tid & 31, ks = X.tid >> 5, j0 = X.vcu * 32;
        float acc[Bn];
#pragma unroll
        for (int b = 0; b < Bn; ++b) acc[b] = 0.f;
#pragma unroll
        for (int k = 0; k < 64; ++k)
#pragma unroll
            for (int b = 0; b < Bn; ++b) acc[b] += cs[b * D + ks * 64 + k] * mw[k];
#pragma unroll
        for (int b = 0; b < Bn; ++b) part[(ks * Bn + b) * 32 + col] = acc[b];
        __syncthreads();
        if (X.tid < Bn * 32) { const int b = X.tid >> 5, cc = X.tid & 31; float s = p.ada_b[j0 + cc];
#pragma unroll
            for (int k2 = 0; k2 < 16; ++k2) s += part[(k2 * Bn + b) * 32 + cc];
            p.MOD[b * NMOD * D + j0 + cc] = s; }
    }
}

__device__ __forceinline__ float row_load_rstd(const float* xr, int lane, f32x4 (&v)[4]) {
    float ss = 0.f;
#pragma unroll
    for (int j = 0; j < 2; ++j) { v[2 * j] = *(const GAS f32x4*)(xr + 8 * lane + 512 * j); v[2 * j + 1] = *(const GAS f32x4*)(xr + 8 * lane + 512 * j + 4); }
#pragma unroll
    for (int q = 0; q < 4; ++q) ss += (v[q][0] * v[q][0] + v[q][1] * v[q][1]) + (v[q][2] * v[q][2] + v[q][3] * v[q][3]);
    return 1.f / sqrtf(wave_sum(ss) * (1.f / D) + 1e-6f);
}
__device__ __forceinline__ void row_issue(const float* xr, int lane, f32x4 (&v)[4]) {
#pragma unroll
    for (int j = 0; j < 4; ++j) v[j] = __builtin_nontemporal_load((const GAS f32x4*)(xr + 4 * lane + 256 * j));
}
__device__ __forceinline__ float row_rstd(const f32x4 (&v)[4]) {
    float ss = 0.f;
#pragma unroll
    for (int q = 0; q < 4; ++q) ss += (v[q][0] * v[q][0] + v[q][1] * v[q][1]) + (v[q][2] * v[q][2] + v[q][3] * v[q][3]);
    return 1.f / sqrtf(wave_sum(ss) * (1.f / D) + 1e-6f);
}
__device__ __forceinline__ TItem moe_item(const P& p, int r) {
    constexpr int I5 = (D / 64) * (F / 32), I6 = (F / 64) * (D / 32);
    TItem t; t.f8 = 1;
    if (r < E * 2 * I5) { const int eh = r / I5, q = r % I5, e = eh >> 1, half = eh & 1; const int kb = q / (F / 32), nb = q % (F / 32), n0 = 32 * nb;
        t.src = (half ? p.w_up : p.w_gate) + (size_t)e * D * F + (size_t)(64 * kb) * F + n0; t.ldw = F; t.ldt = D;
        t.dst = (unsigned char*)p.Wt_gu + (size_t)e * 2 * F * D + (size_t)(256 * (n0 / 128) + 128 * half + (n0 % 128)) * D + 64 * kb; }
    else { r -= E * 2 * I5; const int e = r / I6, q = r % I6; const int kb = q / (D / 32), nb = q % (D / 32);
        t.src = p.w_down + (size_t)e * F * D + (size_t)(64 * kb) * D + 32 * nb; t.ldw = D; t.ldt = F;
        t.dst = (unsigned char*)p.Wt_down + (size_t)e * D * F + (size_t)(32 * nb) * F + 64 * kb; }
    return t;
}
__device__ __forceinline__ void phase_p0b(const Ctx& X0, const P& p) {
    Ctx X = X0; X.tid = (int)threadIdx.x; asm volatile("" : "+v"(X.tid)); X.lane = X.tid & 63;
    const int gw = X.vcu * NWAVES + X.wave, NGW = X.G * NWAVES;
    {
        const int RPW = T / X.G, base = X.vcu * RPW; const float* md = p.MOD + (size_t)(base >> 12) * NMOD * D;
        f32x4 av[4], sv[4];
#pragma unroll
        for (int j = 0; j < 4; ++j) { const int c0 = 4 * X.lane + 256 * j; av[j] = *(const f32x4*)(p.norm1_g + c0) * (*(const f32x4*)(md + D + c0) + 1.f); sv[j] = *(const f32x4*)(md + c0); }
        f32x4 v[4], vn[4], vn2[4]; int i = X.wave; if (i < RPW) row_issue(p.x + (size_t)(base + i) * D, X.lane, v);
        if (i + NWAVES < RPW) row_issue(p.x + (size_t)(base + i + NWAVES) * D, X.lane, vn);
        for (; i < RPW; i += NWAVES) {
            const int m = base + i, in2 = i + 2 * NWAVES; if (in2 < RPW) row_issue(p.x + (size_t)(base + in2) * D, X.lane, vn2);
            const float rstd = row_rstd(v);
#pragma unroll
            for (int j = 0; j < 4; ++j) { const int c0 = 4 * X.lane + 256 * j; const f32x4 o = v[j] * rstd * av[j] + sv[j];
                *(GAS u32x2*)(p.U + (size_t)m * D + c0) = (u32x2){cvt_pk_bf16(o[0], o[1]), cvt_pk_bf16(o[2], o[3])};
                if (GATE_F8) { unsigned q8 = 0u; q8 = __builtin_amdgcn_cvt_pk_fp8_f32(o[0] * epi::U_SC, o[1] * epi::U_SC, q8, false); q8 = __builtin_amdgcn_cvt_pk_fp8_f32(o[2] * epi::U_SC, o[3] * epi::U_SC, q8, true);
                    *(GAS unsigned*)(p.U8X + (size_t)m * D + c0) = q8; } }
#pragma unroll
            for (int q = 0; q < 4; ++q) { v[q] = vn[q]; vn[q] = vn2[q]; }
        }
    }
    LAS float* scr = (LAS float*)(X.lds + X.wave * 16384);
    constexpr int I3 = (D / 64) * (D / 32);
    for (int it = gw; it < I3; it += NGW) { const int kb = it / (D / 32), nb = it % (D / 32); transpose_item(p.W2F, D, 64 * kb, 32 * nb, p.Wt_four, D, 32 * nb, scr, X.lane); }
    constexpr int NIT = E * 2 * (D / 64) * (F / 32) + E * (F / 64) * (D / 32);
#if MOE_F8
    {   f32x4 va[8], vb[8], vc[8]; TItem cur, nx, nx2; int it = gw;
        if (it < NIT) { cur = moe_item(p, it); titem_load(cur, X.lane, va); }
        if (it + NGW < NIT) { nx = moe_item(p, it + NGW); titem_load(nx, X.lane, vb); }
        while (it < NIT) {
            const int n2 = it + 2 * NGW; if (n2 < NIT) { nx2 = moe_item(p, n2); titem_load(nx2, X.lane, vc); }
            titem_store_f8(cur, X.lane, va, scr, epi::W_SC);
#pragma unroll
            for (int i = 0; i < 8; ++i) { va[i] = vb[i]; vb[i] = vc[i]; }
            cur = nx; nx = nx2; it += NGW;
        }
    }
#else
    constexpr int I5 = (D / 64) * (F / 32), I6 = (F / 64) * (D / 32);
    for (int it = gw; it < NIT; it += NGW) { int r = it;
        if (r < E * 2 * I5) { const int eh = r / I5, q = r % I5, e = eh >> 1, half = eh & 1; const int kb = q / (F / 32), nb = q % (F / 32), n0 = 32 * nb;
            transpose_item((half ? p.w_up : p.w_gate) + (size_t)e * D * F, F, 64 * kb, n0, p.Wt_gu + (size_t)e * 2 * F * D, D, 256 * (n0 / 128) + 128 * half + (n0 % 128), scr, X.lane); continue; } r -= E * 2 * I5;
        { const int e = r / I6, q = r % I6; const int kb = q / (D / 32), nb = q % (D / 32);
            transpose_item(p.w_down + (size_t)e * F * D, D, 64 * kb, 32 * nb, p.Wt_down + (size_t)e * D * F, F, 32 * nb, scr, X.lane); } }
#endif
}

__device__ __forceinline__ void phase_conv(const Ctx& X0, const P& p) {
    Ctx X = X0; X.tid = (int)threadIdx.x; asm volatile("" : "+v"(X.tid)); X.lane = X.tid & 63;
    constexpr int CH = 32, ROWS = CH + CK - 1;
    LAS unsigned char* rows = X.lds;
    LAS float* wl = (LAS float*)(X.lds + ROWS * 1024);
    for (int i = X.tid; i < CK * CW; i += NTHR) { const int k = i / CW, ch = i % CW; const int ln = ch >> 3, q = (ch >> 2) & 1, r = ch & 3; wl[((k * 2 + q) * 64 + ln) * 4 + r] = p.dw_w[i]; }
    const int lane = X.lane, w = X.wave;
    f32x4 db[2], lg[2], lb[2];
#pragma unroll
    for (int h = 0; h < 2; ++h) { db[h] = *(const f32x4*)(p.dw_b + 8 * lane + 4 * h); lg[h] = *(const f32x4*)(p.cln_g + 8 * lane + 4 * h); lb[h] = *(const f32x4*)(p.cln_b + 8 * lane + 4 * h); }
    u32x4 pre[8];
#define CV_LOAD(chk) do { const int t0_ = (chk) * CH, b_ = t0_ >> 12, s0_ = t0_ & (S - 1); _Pragma("unroll") for (int q = 0; q < 8; ++q) { const int i = X.tid + q * NTHR, r = i >> 6, cseg = i & 63, s = s0_ + r - CK / 2; \
        pre[q] = (u32x4){0u, 0u, 0u, 0u}; if (i < ROWS * 64 && s >= 0 && s < S) pre[q] = *(const GAS u32x4*)(p.V + ((size_t)(b_ * S + s)) * CW + cseg * 8); } } while (0)
    if (X.vcu < T / CH) CV_LOAD(X.vcu);
    for (int chunk = X.vcu; chunk < T / CH; chunk += X.G) {
        const int t0 = chunk * CH;
        __syncthreads();
#pragma unroll
        for (int q = 0; q < 8; ++q) { const int i = X.tid + q * NTHR; if (i < ROWS * 64) *(LAS u32x4*)(rows + (i >> 6) * 1024 + (i & 63) * 16) = pre[q]; }
        if (chunk + X.G < T / CH) CV_LOAD(chunk + X.G);
        __syncthreads();
        f32x4 acc[4][2]; int zo = 0; asm volatile("" : "+v"(zo));
#pragma unroll
        for (int j = 0; j < 4; ++j) { acc[j][0] = db[0]; acc[j][1] = db[1]; }
#pragma unroll
        for (int rr = 0; rr < CK + 3; ++rr) {
            const u32x4 rv = *(const LAS u32x4*)(rows + (4 * w + rr) * 1024 + lane * 16); f32x4 a0, a1; epi::unpack8(rv, a0, a1);
#pragma unroll
            for (int j = 0; j < 4; ++j) { const int k = rr - j;
                if (k >= 0 && k < CK) { const f32x4 w0 = *(const LAS f32x4*)(wl + ((k * 2 + 0) * 64 + lane + zo) * 4), w1 = *(const LAS f32x4*)(wl + ((k * 2 + 1) * 64 + lane + zo) * 4);
                    acc[j][0] += a0 * w0; acc[j][1] += a1 * w1; } }
        }
#pragma unroll
        for (int j = 0; j < 4; ++j) {
            const f32x4 a0 = acc[j][0], a1 = acc[j][1];
            const float mu = wave_sum((a0[0] + a0[1]) + (a0[2] + a0[3]) + (a1[0] + a1[1]) + (a1[2] + a1[3])) * (1.f / CW);
            const f32x4 d0 = a0 - mu, d1 = a1 - mu;
            const float var = wave_sum((d0[0] * d0[0] + d0[1] * d0[1]) + (d0[2] * d0[2] + d0[3] * d0[3]) + (d1[0] * d1[0] + d1[1] * d1[1]) + (d1[2] * d1[2] + d1[3] * d1[3])) * (1.f / CW);
            const float rstd = 1.f / sqrtf(var + 1e-5f);
            const f32x4 z0 = d0 * rstd * lg[0] + lb[0], z1 = d1 * rstd * lg[1] + lb[1];
            *(GAS u32x4*)(p.ACONV + (size_t)(t0 + 4 * w + j) * CW + 8 * lane) = epi::pack8(epi::silu4(z0), epi::silu4(z1));
        }
    }
#undef CV_LOAD
    __syncthreads();
}


__device__ __forceinline__ void dft16_real(const float (&x)[16], float (&gr)[16], float (&gi)[16]) {
    constexpr float WR[10] = {1.f, 0.92387953251128674f, 0.70710678118654752f, 0.38268343236508977f, 0.f, -0.38268343236508977f, -0.70710678118654752f, -0.92387953251128674f, -1.f, -0.92387953251128674f};
    constexpr float WI[10] = {0.f, -0.38268343236508977f, -0.70710678118654752f, -0.92387953251128674f, -1.f, -0.92387953251128674f, -0.70710678118654752f, -0.38268343236508977f, 0.f, 0.38268343236508977f};
    float zr[4][4], zi[4][4];
#pragma unroll
    for (int b = 0; b < 4; ++b) { const float x0 = x[b], x1 = x[4 + b], x2 = x[8 + b], x3 = x[12 + b];
        const float s02 = x0 + x2, d02 = x0 - x2, s13 = x1 + x3, d13 = x1 - x3;
        const float yr[4] = {s02 + s13, d02, s02 - s13, d02}, yi[4] = {0.f, -d13, 0.f, d13};
#pragma unroll
        for (int c = 0; c < 4; ++c) { const float wr = WR[b * c], wi = WI[b * c]; zr[b][c] = yr[c] * wr - yi[c] * wi; zi[b][c] = yr[c] * wi + yi[c] * wr; } }
#pragma unroll
    for (int c = 0; c < 4; ++c) {
        const float ar = zr[0][c] + zr[2][c], ai = zi[0][c] + zi[2][c], br = zr[0][c] - zr[2][c], bi = zi[0][c] - zi[2][c];
        const float cr = zr[1][c] + zr[3][c], ci = zi[1][c] + zi[3][c], dr = zr[1][c] - zr[3][c], di = zi[1][c] - zi[3][c];
        gr[c] = ar + cr;      gi[c] = ai + ci;
        gr[c + 4] = br + di;  gi[c + 4] = bi - dr;
        gr[c + 8] = ar - cr;  gi[c + 8] = ai - ci;
        gr[c + 12] = br - di; gi[c + 12] = bi + dr;
    }
}
__device__ __forceinline__ void phase_fftA(const Ctx& X0, const P& p) {
    Ctx X = X0; X.tid = (int)threadIdx.x; asm volatile("" : "+v"(X.tid)); X.lane = X.tid & 63;
    LAS float* ct = (LAS float*)X.lds;
    for (int i = X.tid; i < S; i += NTHR) { float sv, cv; sincospif((float)i / (float)(S / 2), &sv, &cv); ct[i] = cv; }
    __syncthreads();
    constexpr float C16[16] = {1.f, 0.92387953251128674f, 0.70710678118654752f, 0.38268343236508977f, 0.f, -0.38268343236508977f, -0.70710678118654752f, -0.92387953251128674f,
                               -1.f, -0.92387953251128674f, -0.70710678118654752f, -0.38268343236508977f, 0.f, 0.38268343236508977f, 0.70710678118654752f, 0.92387953251128674f};
    const int chl = X.tid >> 7, sp = X.tid & 127;
    unsigned pre[16];
#define FA_LOAD(itm) do { const bf16_t* src_ = p.FT + ((size_t)(((itm) >> 7) * FW + ((itm) & 127) * 4 + chl) * S + 2 * sp); _Pragma("unroll") for (int s2 = 0; s2 < 16; ++s2) pre[s2] = *(const GAS unsigned*)(src_ + 256 * s2); } while (0)
    if (X.vcu < Bn * (FW / 4)) FA_LOAD(X.vcu);
    for (int it = X.vcu; it < Bn * (FW / 4); it += X.G) {
        const int b = it >> 7, ch = (it & 127) * 4 + chl;
        float xa[16], xb[16];
#pragma unroll
        for (int s2 = 0; s2 < 16; ++s2) { const unsigned w = pre[s2]; xa[s2] = bf_lo(w); xb[s2] = bf_hi(w); }
        if (it + X.G < Bn * (FW / 4)) FA_LOAD(it + X.G);
        float gar[16], gai[16], gbr[16], gbi[16];
        dft16_real(xa, gar, gai); dft16_real(xb, gbr, gbi);
#pragma unroll
        for (int k2 = 0; k2 < 16; ++k2) {
            const float ar = gar[k2], ai = gai[k2], br = gbr[k2], bi = gbi[k2];
            const int ia = (2 * sp * k2) & (S - 1), ib = ((2 * sp + 1) * k2) & (S - 1);
            const float tca = ct[ia], tsa = ct[(ia - S / 4) & (S - 1)], tcb = ct[ib], tsb = ct[(ib - S / 4) & (S - 1)];
            const float gra = ar * tca + ai * tsa, gia = ai * tca - ar * tsa, grb = br * tcb + bi * tsb, gib = bi * tcb - br * tsb;
            bf16_t* dst = p.GP + ((size_t)((b * 16 + k2) * FW + ch) * 512 + 2 * sp);
            *(GAS unsigned*)dst = cvt_pk_bf16(gra, grb); *(GAS unsigned*)(dst + 256) = cvt_pk_bf16(gia, gib);
        }
    }
    __syncthreads();
}

__device__ __forceinline__ void phase_router(const Ctx& X0, const P& p, const float* H) {
    Ctx X = X0; X.tid = (int)threadIdx.x; asm volatile("" : "+v"(X.tid)); X.lane = X.tid & 63;
    LAS float* GP = (LAS float*)X.lds;
    LAS float* SH = GP + D;
    LAS f32x4* ACCP = (LAS f32x4*)(SH + D);
    LAS float* SSP = (LAS float*)(ACCP + 2 * 8 * 64);
    LAS float* CE = SSP + 2 * 8 * 16;
    const int lane = X.lane, w = X.wave, r = lane & 15, kq = lane >> 4;
    constexpr int NG = T / 16, GPW = NG / 256;
    const int g0 = X.vcu * GPW, b = (g0 * 16) >> 12;
    const float* md = p.MOD + (size_t)b * NMOD * D;
    f32x4 a[4][2], vn[4][2];
    const int cbase = 128 * w + 8 * kq;
#if H_DELTA
#define RT_ISSUE(dst, grp) do { const size_t ro_ = ((size_t)(grp) * 16 + r) * D + cbase; const float* rp = H + ro_; const bf16_t* dp = p.DELTA + ro_; _Pragma("unroll") for (int s = 0; s < 4; ++s) { \
        const u32x4 dw_ = *(const GAS u32x4*)(dp + 32 * s); f32x4 d0_, d1_; epi::unpack8(dw_, d0_, d1_); dst[s][0] = *(const GAS f32x4*)(rp + 32 * s) + d0_; dst[s][1] = *(const GAS f32x4*)(rp + 32 * s + 4) + d1_; } } while (0)
#else
#define RT_ISSUE(dst, grp) do { const float* rp = H + ((size_t)(grp) * 16 + r) * D + cbase; _Pragma("unroll") for (int s = 0; s < 4; ++s) { dst[s][0] = *(const GAS f32x4*)(rp + 32 * s); dst[s][1] = *(const GAS f32x4*)(rp + 32 * s + 4); } } while (0)
#endif
    RT_ISSUE(a, g0);
    for (int i = X.tid; i < D; i += NTHR) { GP[i] = p.norm2_g[i] * (1.f + md[4 * D + i]); SH[i] = md[3 * D + i]; }
    bf16x8 bh[4], bl[4];
#pragma unroll
    for (int s = 0; s < 4; ++s) { unsigned hw[4], lw[4];
#pragma unroll
        for (int j = 0; j < 4; ++j) { const int d = 32 * (4 * w + s) + 8 * kq + 2 * j; const float x0 = p.router_w[(size_t)d * E + r], x1 = p.router_w[(size_t)(d + 1) * E + r];
            const unsigned h = cvt_pk_bf16(x0, x1); hw[j] = h; lw[j] = cvt_pk_bf16(x0 - bf_lo(h), x1 - bf_hi(h)); }
        bh[s] = __builtin_bit_cast(bf16x8, (u32x4){hw[0], hw[1], hw[2], hw[3]}); bl[s] = __builtin_bit_cast(bf16x8, (u32x4){lw[0], lw[1], lw[2], lw[3]}); }
    __syncthreads();
    if (w == 0) {
        float c[E];
#pragma unroll
        for (int e = 0; e < E; ++e) c[e] = 0.f;
        for (int d = lane; d < D; d += 64) { const float sv = SH[d]; const f32x4* wr_ = (const f32x4*)(p.router_w + (size_t)d * E);
#pragma unroll
            for (int q = 0; q < 4; ++q) { const f32x4 wv = wr_[q]; c[4 * q] += sv * wv[0]; c[4 * q + 1] += sv * wv[1]; c[4 * q + 2] += sv * wv[2]; c[4 * q + 3] += sv * wv[3]; } }
#pragma unroll
        for (int e = 0; e < E; ++e) { const float s = wave_sum(c[e]); if (lane == e) CE[e] = s; }
    }
    __syncthreads();
    for (int gi = 0; gi < GPW; ++gi) {
        const int g = g0 + gi, par = gi & 1;
        if (gi + 1 < GPW) RT_ISSUE(vn, g + 1);
        float ss = 0.f; f32x4 acc = (f32x4){0.f, 0.f, 0.f, 0.f};
#pragma unroll
        for (int s = 0; s < 4; ++s) {
            const f32x4 g0v = *(const LAS f32x4*)(GP + cbase + 32 * s), g1v = *(const LAS f32x4*)(GP + cbase + 32 * s + 4);
            const f32x4 v0 = a[s][0], v1 = a[s][1];
            ss += (v0[0] * v0[0] + v0[1] * v0[1]) + (v0[2] * v0[2] + v0[3] * v0[3]) + (v1[0] * v1[0] + v1[1] * v1[1]) + (v1[2] * v1[2] + v1[3] * v1[3]);
            const f32x4 x0 = v0 * g0v, x1 = v1 * g1v; a[s][0] = x0; a[s][1] = x1;
            unsigned hw[4], lw[4];
            hw[0] = cvt_pk_bf16(x0[0], x0[1]); hw[1] = cvt_pk_bf16(x0[2], x0[3]); hw[2] = cvt_pk_bf16(x1[0], x1[1]); hw[3] = cvt_pk_bf16(x1[2], x1[3]);
            lw[0] = cvt_pk_bf16(x0[0] - bf_lo(hw[0]), x0[1] - bf_hi(hw[0])); lw[1] = cvt_pk_bf16(x0[2] - bf_lo(hw[1]), x0[3] - bf_hi(hw[1]));
            lw[2] = cvt_pk_bf16(x1[0] - bf_lo(hw[2]), x1[1] - bf_hi(hw[2])); lw[3] = cvt_pk_bf16(x1[2] - bf_lo(hw[3]), x1[3] - bf_hi(hw[3]));
            const bf16x8 ah = __builtin_bit_cast(bf16x8, (u32x4){hw[0], hw[1], hw[2], hw[3]}), al = __builtin_bit_cast(bf16x8, (u32x4){lw[0], lw[1], lw[2], lw[3]});
            acc = __builtin_amdgcn_mfma_f32_16x16x32_bf16(ah, bh[s], acc, 0, 0, 0);
            acc = __builtin_amdgcn_mfma_f32_16x16x32_bf16(ah, bl[s], acc, 0, 0, 0);
            acc = __builtin_amdgcn_mfma_f32_16x16x32_bf16(al, bh[s], acc, 0, 0, 0);
        }
        ss += __shfl_xor(ss, 16); ss += __shfl_xor(ss, 32);
        ACCP[(par * 8 + w) * 64 + lane] = acc;
        if (lane < 16) SSP[(par * 8 + w) * 16 + lane] = ss;
        __syncthreads();
        float rss = 0.f;
#pragma unroll
        for (int q = 0; q < 8; ++q) rss += SSP[(par * 8 + q) * 16 + r];
        const float rstd = 1.f / sqrtf(rss * (1.f / D) + 1e-6f);
        if (w == (gi & 7)) {
            f32x4 lg = (f32x4){0.f, 0.f, 0.f, 0.f};
#pragma unroll
            for (int q = 0; q < 8; ++q) lg += ACCP[(par * 8 + q) * 64 + lane];
            const float ce = CE[r]; f32x4 o;
#pragma unroll
            for (int q = 0; q < 4; ++q) { const float rs = __shfl(rstd, 4 * kq + q); float z = lg[q] * rs + ce; float mx = z;
#pragma unroll
                for (int sft = 1; sft < 16; sft <<= 1) mx = fmaxf(mx, __shfl_xor(mx, sft));
                const float ex = expf(z - mx); float sm = ex;
#pragma unroll
                for (int sft = 1; sft < 16; sft <<= 1) sm += __shfl_xor(sm, sft);
                o[q] = ex / sm; }
            *(GAS f32x4*)(p.AFF + ((size_t)b * E + r) * S + ((g * 16) & (S - 1)) + 4 * kq) = o;
        }
#pragma unroll
        for (int s = 0; s < 4; ++s) {
            const f32x4 s0 = *(const LAS f32x4*)(SH + cbase + 32 * s), s1 = *(const LAS f32x4*)(SH + cbase + 32 * s + 4);
            const f32x4 u0 = a[s][0] * rstd + s0, u1 = a[s][1] * rstd + s1; const size_t off = ((size_t)g * 16 + r) * D + cbase + 32 * s;
            if (MOE_F8) *(GAS u32x2*)((unsigned char*)p.U + off) = pack8_f8(u0, u1, epi::U_SC);
            else *(GAS u32x4*)(p.U + off) = epi::pack8(u0, u1);
        }
#pragma unroll
        for (int s = 0; s < 4; ++s) { a[s][0] = vn[s][0]; a[s][1] = vn[s][1]; }
    }
#undef RT_ISSUE
    __syncthreads();
}

__device__ __forceinline__ void phase_topk(const Ctx& X0, const P& p) {
    Ctx X = X0; X.tid = (int)threadIdx.x; asm volatile("" : "+v"(X.tid)); X.lane = X.tid & 63;
    LAS unsigned* cnt = (LAS unsigned*)X.lds;
    LAS unsigned* sc = cnt + 48;
    const int lane = X.lane, w = X.wave, tid = X.tid;
    for (int be = X.vcu; be < Bn * E; be += X.G) {
        const int b = be / E, e = be % E;
        const float* src = p.AFF + (size_t)be * S + 8 * tid;
        const f32x4 a0 = *(const GAS f32x4*)src, a1 = *(const GAS f32x4*)(src + 4);
        unsigned key[8];
#pragma unroll
        for (int i = 0; i < 4; ++i) { const float f0 = a0[i], f1 = a1[i]; key[i] = __float_as_uint(f0); key[4 + i] = __float_as_uint(f1); }
        unsigned prefix = 0u, need_k = (unsigned)CAP;
        __syncthreads();
        if (tid < 48) cnt[tid] = 0u;
        __syncthreads();
#pragma unroll 1
        for (int pass = 0; pass < 8; ++pass) {
            const int shift = 28 - 4 * pass; LAS unsigned* hist = cnt + (pass % 3) * 16;
            if (tid < 16) cnt[((pass + 1) % 3) * 16 + tid] = 0u;
#pragma unroll
            for (int i = 0; i < 8; ++i) { const bool match = (pass == 0) || ((key[i] >> (shift + 4)) == (prefix >> (shift + 4)));
                if (match) __hip_atomic_fetch_add(hist + ((key[i] >> shift) & 15u), 1u, __ATOMIC_RELAXED, __HIP_MEMORY_SCOPE_WORKGROUP); }
            __syncthreads();
            unsigned cum = 0u, dsel = 0u, below = 0u; bool found = false;
#pragma unroll
            for (int dgt = 15; dgt >= 0; --dgt) { const unsigned c = hist[dgt]; if (!found) { if (cum + c >= need_k) { dsel = (unsigned)dgt; below = cum; found = true; } else cum += c; } }
            prefix |= dsel << shift; need_k -= below;
        }
        const unsigned Tk = prefix;
        unsigned ngt = 0u, neq = 0u;
#pragma unroll
        for (int i = 0; i < 8; ++i) { ngt += key[i] > Tk; neq += key[i] == Tk; }
        unsigned sg = ngt, se = neq;
#pragma unroll
        for (int o = 1; o < 64; o <<= 1) { const unsigned tg = __shfl_up(sg, o), te = __shfl_up(se, o); if (lane >= o) { sg += tg; se += te; } }
        __syncthreads();
        if (lane == 63) { sc[w] = sg; sc[8 + w] = se; }
        __syncthreads();
        unsigned og = 0u, oe = 0u, totg = 0u;
#pragma unroll
        for (int i = 0; i < 8; ++i) { const unsigned g = sc[i], q = sc[8 + i]; if (i < w) { og += g; oe += q; } totg += g; }
        unsigned pg = og + sg - ngt, pe = oe + se - neq;
        const unsigned need = (unsigned)CAP - totg;
        unsigned iv[4] = {0u, 0u, 0u, 0u};
#pragma unroll
        for (int i = 0; i < 8; ++i) {
            const bool gt = key[i] > Tk, eq = key[i] == Tk; const int s = 8 * tid + i;
            const bool sel = gt || (eq && pe < need);
            const unsigned slot = pg + (pe < need ? pe : need);
            if (sel) { p.ROWL[(size_t)e * ME + b * CAP + slot] = b * S + s; p.WTS[(size_t)e * ME + b * CAP + slot] = __uint_as_float(key[i]); }
            iv[i >> 1] |= (sel ? (slot & 0xffffu) : 0xffffu) << (16 * (i & 1));
            pg += gt; pe += eq;
        }
        *(GAS u32x4*)(p.INV + (size_t)be * S + 8 * tid) = (u32x4){iv[0], iv[1], iv[2], iv[3]};
    }
    __syncthreads();
}

__device__ __forceinline__ void phase_final(const Ctx& X0, const P& p) {
    Ctx X = X0; X.tid = (int)threadIdx.x; asm volatile("" : "+v"(X.tid)); X.lane = X.tid & 63;
    const int lane = X.lane, RPW = T / X.G, base = X.vcu * RPW, b = base >> 12;
    f32x4 g2v[4], fgv[4];
#pragma unroll
    for (int j = 0; j < 4; ++j) { g2v[j] = *(const f32x4*)(p.MOD + (size_t)b * NMOD * D + 5 * D + 4 * lane + 256 * j) * (YB_F8 ? 1.f / epi::YB_SC : 1.f); fgv[j] = *(const f32x4*)(p.final_g + 4 * lane + 256 * j); }
    for (int i = X.wave; i < RPW; i += NWAVES) {
        const int m = base + i; float* hr = p.out + (size_t)m * D;
        f32x4 v[4];
#if H_DELTA
#pragma unroll
        for (int j = 0; j < 4; ++j) { const u32x2 dw = *(const GAS u32x2*)(p.DELTA + (size_t)m * D + 4 * lane + 256 * j);
            v[j] = *(const GAS f32x4*)(p.x + (size_t)m * D + 4 * lane + 256 * j) + (f32x4){bf_lo(dw.x), bf_hi(dw.x), bf_lo(dw.y), bf_hi(dw.y)}; }
#else
#pragma unroll
        for (int j = 0; j < 4; ++j) v[j] = *(const GAS f32x4*)(hr + 4 * lane + 256 * j);
#endif
        const int myslot = (lane < E) ? (int)p.INV[((size_t)(b * E + lane)) * S + (m & (S - 1))] : -1;
        f32x4 y[4];
#pragma unroll
        for (int q = 0; q < 4; ++q) y[q] = (f32x4){0.f, 0.f, 0.f, 0.f};
#pragma unroll
        for (int e = 0; e < E; ++e) { const int slot = __builtin_amdgcn_readlane(myslot, e);
            if (slot >= 0) { const size_t yo = ((size_t)e * ME + b * CAP + slot) * D;
#pragma unroll
                for (int j = 0; j < 4; ++j) {
                    if (YB_F8) { const unsigned wv = *(const GAS unsigned*)((const unsigned char*)p.YB + yo + 4 * lane + 256 * j);
                        const f32x2 lo2 = __builtin_amdgcn_cvt_pk_f32_fp8((int)wv, false), hi2 = __builtin_amdgcn_cvt_pk_f32_fp8((int)wv, true); y[j] += (f32x4){lo2[0], lo2[1], hi2[0], hi2[1]}; }
                    else { const u32x2 wv = *(const GAS u32x2*)(p.YB + yo + 4 * lane + 256 * j); y[j] += (f32x4){bf_lo(wv.x), bf_hi(wv.x), bf_lo(wv.y), bf_hi(wv.y)}; } } } }
        float ss = 0.f;
#pragma unroll
        for (int j = 0; j < 4; ++j) { const f32x4 tt = v[j] + g2v[j] * y[j]; v[j] = tt; ss += (tt[0] * tt[0] + tt[1] * tt[1]) + (tt[2] * tt[2] + tt[3] * tt[3]); }
        const float rstd = 1.f / sqrtf(wave_sum(ss) * (1.f / D) + 1e-6f);
#pragma unroll
        for (int j = 0; j < 4; ++j) *(GAS f32x4*)(hr + 4 * lane + 256 * j) = v[j] * rstd * fgv[j];
    }
}

constexpr size_t MiB = 1u << 20;
constexpr size_t WS_CTL = 0, CTL_ZERO_BYTES = 1 * MiB;
constexpr size_t WS_MOD = 1 * MiB, WS_AFF = 2 * MiB, WS_ROWL = 4 * MiB, WS_WTS = WS_ROWL + 256 * 1024, WS_INV = WS_WTS + 256 * 1024;
constexpr size_t WS_W2F = 6 * MiB, WS_WIN = 10 * MiB, WS_WCONV = 18 * MiB, WS_WFOUR = 19 * MiB, WS_WOUT = 21 * MiB;
constexpr size_t WS_WGU = 24 * MiB, WS_WDOWN = 152 * MiB, WS_U = 216 * MiB, WS_R1 = 280 * MiB, WS_END = 536 * MiB;
constexpr size_t WS_GP = WS_R1, WS_D256 = 23 * MiB, WS_YCONV = WS_R1, WS_V = WS_R1 + 64 * MiB, WS_FT = WS_R1 + 96 * MiB, WS_YFOUR = WS_R1 + 64 * MiB;
constexpr size_t WS_YRI = WS_R1 + 128 * MiB, WS_MERGED = WS_R1 + 128 * MiB, WS_ACONV = WS_R1 + 192 * MiB, WS_ACT = WS_R1 + 128 * MiB  , WS_YB = WS_WGU, WS_DELTA = WS_R1  ;
static_assert(MOE_F8 || !H_DELTA, "the workspace map places the 128 MiB fp8 ACT beside DELTA; a bf16 ACT (256 MiB) needs H_DELTA = 0");
constexpr int LDS_BYTES = 147456, RING_BYTES = 131072, MISC_OFF = RING_BYTES + 320;


#ifndef BARRIER_KIND
#define BARRIER_KIND 2
#endif
#define RLX_AGENT __ATOMIC_RELAXED, __HIP_MEMORY_SCOPE_AGENT
#define XB_TMO      128
#define XB_XCNT(j)  (256  + 64 * (j))
#define XB_XSUB(j)  (1280 + 64 * (j))
#define XB_XGEN(j)  (2304 + 64 * (j))
#define XB_TOP      3328
#define XB_TOPGEN   3392
#define XCD_BAR_WORDS 3456
#define XB_SPIN_CAP (1u << 18)
__device__ __forceinline__ unsigned xb_ld(unsigned* p)              { return __hip_atomic_load(p, __ATOMIC_RELAXED, __HIP_MEMORY_SCOPE_AGENT); }
__device__ __forceinline__ unsigned xb_add(unsigned* p, unsigned v) { return __hip_atomic_fetch_add(p, v, __ATOMIC_RELAXED, __HIP_MEMORY_SCOPE_AGENT); }
__device__ __forceinline__ unsigned xb_xcc_id() { return (unsigned)__builtin_amdgcn_s_getreg((3 << 11) | 20) & 0xFu; }
#define XB_SPIN(cond, bar) do { unsigned _sp = 0; while (cond) { __builtin_amdgcn_s_sleep(1); \
    if ((++_sp & 255u) == 0u) { if (xb_ld(&(bar)[XB_TMO])) break; if (_sp > XB_SPIN_CAP) { atomicAdd(&(bar)[XB_TMO], 1u); break; } } } } while (0)
struct XcdBarrier { unsigned* bar; unsigned x; volatile LAS unsigned* st; };
__device__ __forceinline__ XcdBarrier xcd_barrier_post(unsigned* bar, volatile LAS unsigned* st) {
    XcdBarrier b; b.bar = bar; b.x = xb_xcc_id(); b.st = st;
    if (threadIdx.x == 0) (void)xb_add(&bar[XB_XCNT(b.x)], 1u);
    return b;
}
__device__ __forceinline__ void xcd_barrier_complete(unsigned* bar, unsigned x, unsigned& nloc, unsigned& nx) {
    const unsigned G = gridDim.x * gridDim.y * gridDim.z;
    unsigned sum, cnt, mine, sp = 0u;
    for (;;) {
        sum = 0u; cnt = 0u; mine = 0u;
#pragma unroll
        for (unsigned j = 0; j < 16; ++j) { const unsigned c = xb_ld(&bar[XB_XCNT(j)]); sum += c; cnt += (c > 0u) ? 1u : 0u; mine = (j == x) ? c : mine; }
        if (sum == G) break;
        __builtin_amdgcn_s_sleep(1);
        if ((++sp & 255u) == 0u) { if (xb_ld(&bar[XB_TMO])) break; if (sp > XB_SPIN_CAP) { atomicAdd(&bar[XB_TMO], 1u); break; } }
    }
    nloc = mine > 0u ? mine : 1u; nx = cnt > 0u ? cnt : 1u;
}
__device__ __forceinline__ void xcd_barrier(const XcdBarrier& b) {
    asm volatile("s_waitcnt vmcnt(0)" ::: "memory");
    __syncthreads();
    if (threadIdx.x == 0) {
        unsigned* bar = b.bar;
        __builtin_amdgcn_s_waitcnt(0);
        unsigned nloc = b.st[0], nx = b.st[1];
        if (nloc == 0u) { xcd_barrier_complete(bar, b.x, nloc, nx); b.st[0] = nloc; b.st[1] = nx; }
        const unsigned old = xb_add(&bar[XB_XSUB(b.x)], 1u);
        const unsigned gen = old / nloc;
        if (old + 1u == (gen + 1u) * nloc) {
            __builtin_amdgcn_fence(__ATOMIC_RELEASE, "agent");
            asm volatile("s_waitcnt vmcnt(0)" ::: "memory");
            const unsigned og = xb_add(&bar[XB_TOP], 1u);
            const unsigned tg = og / nx;
            if (og + 1u == (tg + 1u) * nx) xb_add(&bar[XB_TOPGEN], 1u);
            else XB_SPIN(xb_ld(&bar[XB_TOPGEN]) == tg, bar);
            __builtin_amdgcn_fence(__ATOMIC_ACQUIRE, "agent");
            xb_add(&bar[XB_XGEN(b.x)], 1u);
            asm volatile("s_waitcnt vmcnt(0)" ::: "memory");
        } else {
            XB_SPIN(xb_ld(&bar[XB_XGEN(b.x)]) == gen, bar);
            __builtin_amdgcn_fence(__ATOMIC_ACQUIRE, "agent");
            asm volatile("s_waitcnt vmcnt(0)" ::: "memory");
        }
    }
    __syncthreads();
}
constexpr int CW_BAR = 4096;

struct Args { P p; unsigned* ctl; int ph_lo, ph_hi; };

__global__ void __launch_bounds__(NTHR, 2) mk_fwd(Args args) {
    extern __shared__ __attribute__((aligned(16))) unsigned char lds_raw[];
    Ctx X; X.lds = (LAS unsigned char*)lds_raw; X.tid = threadIdx.x; X.lane = X.tid & 63; X.wave = __builtin_amdgcn_readfirstlane(X.tid >> 6);
    X.G = gridDim.x; { const int bx = blockIdx.x; X.vcu = (X.G % 8 == 0) ? (bx % 8) * (X.G / 8) + bx / 8 : bx; }
    const P& p = args.p; const int lo = args.ph_lo, hi = args.ph_hi;
    const int cid = (int)blockIdx.x;
#define IN(k) (lo <= (k) && (k) < hi)
    for (int u = X.tid; u < (LDS_BYTES - RING_BYTES) / 4; u += NTHR) ((LAS unsigned*)(X.lds + RING_BYTES))[u] = 0u;
    __syncthreads();
#if BARRIER_KIND == 1
    cooperative_groups::grid_group cgrid = cooperative_groups::this_grid();
#define GRID_BAR() do { if (hi - lo > 1) cgrid.sync(); } while (0)
#else
    XcdBarrier xbar = xcd_barrier_post(args.ctl + CW_BAR, (volatile LAS unsigned*)(X.lds + MISC_OFF));
#define GRID_BAR() do { if (hi - lo > 1) xcd_barrier(xbar); } while (0)
#endif
#ifdef PROBE_A
    volatile unsigned long long* ts = (volatile unsigned long long*)(args.ctl + 65536);
    int n_stamp = 0;
#define STAMP() do { if (blockIdx.x == 0 && X.tid == 0) ts[n_stamp] = __builtin_amdgcn_s_memrealtime(); ++n_stamp; } while (0)
#else
#define STAMP() do { } while (0)
#endif
    STAMP();
    if (IN(0)) { phase_p0a(X, p); GRID_BAR(); STAMP(); }
    if (IN(1)) { phase_p0b(X, p); GRID_BAR(); STAMP(); }
    if (IN(2)) {
        { pg8::SchedDense Sd; Sd.init(p.U, p.Wt_in, T, 2 * CW, D, X.G, cid); epi::EpiGlu Ep{p.V, p.b_in};
          pg8::gemm_phase<epi::EpiGlu, pg8::SchedDense, false>(X.lds, 2 * D, Sd, Ep); }
        { pg8::SchedDense Sd; Sd.init(p.Wt_in + (size_t)(2 * CW) * D, p.U, FW, T, D, X.G, cid); epi::EpiFT Ep{p.FT, p.b_in + 2 * CW};
          pg8::gemm_phase<epi::EpiFT, pg8::SchedDense, false>(X.lds, 2 * D, Sd, Ep); }
        GRID_BAR(); STAMP();
    }
    if (IN(3)) {
        phase_conv(X, p);
        phase_fftA(X, p);
        GRID_BAR(); STAMP();
        { pg8::SchedDense Sd; Sd.init(p.D256, p.GP, 512, Bn * 16 * FW, 512, X.G, cid); epi::EpiFFT Ep{p.YRI};
          pg8::gemm_phase<epi::EpiFFT, pg8::SchedDense, false>(X.lds, 2 * 512, Sd, Ep); }
        GRID_BAR(); STAMP();
    }
    if (IN(4)) {
        { pg8::SchedDense Sd; Sd.init(p.ACONV, p.Wt_conv, T, D, CW, X.G, cid); epi::EpiBias Ep{p.YCONV, D, p.cb_out};
          pg8::gemm_phase<epi::EpiBias, pg8::SchedDense, false>(X.lds, 2 * CW, Sd, Ep); }
        { pg8::SchedDense Sd; Sd.init(p.YRI, p.Wt_four, T, D, 2 * FW, X.G, cid); epi::EpiBias Ep{p.YFOUR, D, p.four_b};
          pg8::gemm_phase<epi::EpiBias, pg8::SchedDense, false>(X.lds, 4 * FW, Sd, Ep); }
        GRID_BAR(); STAMP();
    }
    if (IN(5)) {
        epi::EpiMerge Ep{p.MERGED, p.YCONV, p.YFOUR, p.b_in};
#if GATE_F8
        pg8::SchedDense Sd; Sd.init(p.U8X, p.Wt_g8, T, 2 * D, D / 2, X.G, cid);
        pg8::gemm_phase<epi::EpiMerge, pg8::SchedDense, false, true>(X.lds, D, Sd, Ep, epi::MX_W, epi::MX_U);
#else
        pg8::SchedDense Sd; Sd.init(p.U, p.Wt_in + (size_t)(2 * CW + FW) * D, T, 2 * D, D, X.G, cid);
        pg8::gemm_phase<epi::EpiMerge, pg8::SchedDense, false>(X.lds, 2 * D, Sd, Ep);
#endif
        GRID_BAR(); STAMP();
    }
    if (IN(6)) {
        pg8::SchedDense Sd; Sd.init(p.MERGED, p.Wt_out, T, D, D, X.G, cid);
#if H_DELTA
        epi::EpiDelta Ep{p.DELTA, p.MOD + 2 * D, p.b_out};
        pg8::gemm_phase<epi::EpiDelta, pg8::SchedDense, false>(X.lds, 2 * D, Sd, Ep);
#else
        epi::EpiResid Ep{p.x, p.out, p.MOD + 2 * D, p.b_out};
        pg8::gemm_phase<epi::EpiResid, pg8::SchedDense, false>(X.lds, 2 * D, Sd, Ep);
#endif
        GRID_BAR(); STAMP();
    }
    if (IN(7)) { phase_router(X, p, H_DELTA ? p.x : p.out); GRID_BAR(); STAMP(); }
    if (IN(8)) { phase_topk(X, p); GRID_BAR(); STAMP(); }
    if (IN(9)) {
        constexpr int esz = MOE_F8 ? 1 : 2;
        pg8::SchedG1 Sd{(const char*)p.U, (const char*)p.Wt_gu, p.ROWL, X.G, cid, esz}; epi::EpiSwiglu<MOE_F8 != 0> Ep{p.ACT};
        pg8::gemm_phase<epi::EpiSwiglu<MOE_F8 != 0>, pg8::SchedG1, true, MOE_F8 != 0>(X.lds, D * esz, Sd, Ep, epi::MX_W, epi::MX_U);
        GRID_BAR(); STAMP();
    }
    if (IN(10)) {
        constexpr int esz = MOE_F8 ? 1 : 2;
        pg8::SchedG2 Sd{(const char*)p.ACT, (const char*)p.Wt_down, X.G, cid, esz}; epi::EpiScaleW Ep{p.YB, p.WTS};
        pg8::gemm_phase<epi::EpiScaleW, pg8::SchedG2, false, MOE_F8 != 0>(X.lds, F * esz, Sd, Ep, epi::MX_W, epi::MX_ACT);
        GRID_BAR(); STAMP();
    }
    if (IN(11)) { phase_final(X, p); }
#ifdef PROBE_A
    STAMP();
    if (blockIdx.x == 0 && X.tid == 0) { const unsigned long long dt = (ts[PROBE_B] - ts[PROBE_A]) * PROBE_AMP, t0 = __builtin_amdgcn_s_memrealtime();
        while (__builtin_amdgcn_s_memrealtime() - t0 < dt) __builtin_amdgcn_s_sleep(8); }
#endif
#undef IN
}

extern "C" void kernel_launch(void* const* d_in, const int* in_sizes, int n_in, void* d_out, int out_size, void* d_ws, size_t ws_size, hipStream_t stream) {
    static int grid = 0;
    if (grid == 0) {
        if (n_in != 23 || in_sizes[0] != T * D || out_size != T * D || ws_size < WS_END) { fprintf(stderr, "kernel_launch: unexpected shapes / workspace (%d inputs, ws %zu)\n", n_in, ws_size); grid = -1; return; }
        int dev = 0, cus = 0;
        if (hipGetDevice(&dev) != hipSuccess || hipDeviceGetAttribute(&cus, hipDeviceAttributeMultiprocessorCount, dev) != hipSuccess) { grid = -1; return; }
        if (hipFuncSetAttribute((const void*)mk_fwd, hipFuncAttributeMaxDynamicSharedMemorySize, LDS_BYTES) != hipSuccess) { fprintf(stderr, "kernel_launch: hipFuncSetAttribute failed\n"); grid = -1; return; }
        if (cus < 256) { fprintf(stderr, "kernel_launch: built for a 256-CU device (one workgroup per CU), found %d CUs\n", cus); grid = -1; return; }
        int per_cu = 0;
        if (hipOccupancyMaxActiveBlocksPerMultiprocessor(&per_cu, (const void*)mk_fwd, NTHR, LDS_BYTES) != hipSuccess || per_cu < 1) { fprintf(stderr, "kernel_launch: occupancy query reports %d workgroups per CU\n", per_cu); grid = -1; return; }
        grid = 256;
    }
    if (grid < 0) return;
    unsigned char* ws = (unsigned char*)d_ws;
    Args a{};
    P& p = a.p;
    p.x = (const float*)d_in[0]; p.c = (const float*)d_in[1]; p.ada_w = (const float*)d_in[2]; p.ada_b = (const float*)d_in[3]; p.norm1_g = (const float*)d_in[4];
    p.w_in = (const float*)d_in[5]; p.b_in = (const float*)d_in[6]; p.dw_w = (const float*)d_in[7]; p.dw_b = (const float*)d_in[8]; p.cln_g = (const float*)d_in[9]; p.cln_b = (const float*)d_in[10];
    p.cw_out = (const float*)d_in[11]; p.cb_out = (const float*)d_in[12]; p.four_w = (const float*)d_in[13]; p.four_b = (const float*)d_in[14]; p.w_out = (const float*)d_in[15]; p.b_out = (const float*)d_in[16];
    p.norm2_g = (const float*)d_in[17]; p.router_w = (const float*)d_in[18]; p.w_gate = (const float*)d_in[19]; p.w_up = (const float*)d_in[20]; p.w_down = (const float*)d_in[21]; p.final_g = (const float*)d_in[22];
    p.out = (float*)d_out;
    p.MOD = (float*)(ws + WS_MOD); p.W2F = (float*)(ws + WS_W2F); p.AFF = (float*)(ws + WS_AFF); p.ROWL = (int*)(ws + WS_ROWL); p.WTS = (float*)(ws + WS_WTS); p.INV = (short*)(ws + WS_INV);
    p.Wt_in = (bf16_t*)(ws + WS_WIN); p.Wt_conv = (bf16_t*)(ws + WS_WCONV); p.Wt_four = (bf16_t*)(ws + WS_WFOUR); p.Wt_out = (bf16_t*)(ws + WS_WOUT);
    p.D256 = (bf16_t*)(ws + WS_D256); p.GP = (bf16_t*)(ws + WS_GP); p.Wt_gu = (bf16_t*)(ws + WS_WGU); p.Wt_down = (bf16_t*)(ws + WS_WDOWN);
    p.U = (bf16_t*)(ws + WS_U); p.V = (bf16_t*)(ws + WS_V); p.FT = (bf16_t*)(ws + WS_FT); p.ACONV = (bf16_t*)(ws + WS_ACONV); p.YRI = (bf16_t*)(ws + WS_YRI);
    p.YCONV = (bf16_t*)(ws + WS_YCONV); p.YFOUR = (bf16_t*)(ws + WS_YFOUR); p.MERGED = (bf16_t*)(ws + WS_MERGED); p.ACT = (bf16_t*)(ws + WS_ACT); p.YB = (bf16_t*)(ws + WS_YB); p.DELTA = (bf16_t*)(ws + WS_DELTA); p.U8X = ws + WS_R1 + 224 * MiB  ; p.Wt_g8 = ws + WS_WIN + (size_t)(2 * CW + FW) * D * 2  ;
    (void)hipMemsetAsync(ws + WS_CTL, 0, CTL_ZERO_BYTES, stream);
    a.ctl = (unsigned*)(ws + WS_CTL);
    a.ph_lo = 0; a.ph_hi = 12;
#ifndef PLAIN_LAUNCH
#define PLAIN_LAUNCH 0
#endif
#if PLAIN_LAUNCH
    hipLaunchKernelGGL(mk_fwd, dim3(grid), dim3(NTHR), LDS_BYTES, stream, a);
#else
    { void* kargs[] = {&a}; hipError_t le = hipLaunchCooperativeKernel((const void*)mk_fwd, dim3(grid), dim3(NTHR), kargs, LDS_BYTES, stream);
      if (le != hipSuccess) fprintf(stderr, "kernel_launch: cooperative launch failed: %s\n", hipGetErrorString(le)); }
#endif
}
```

```cpp
#include <hip/hip_runtime.h>
#include <hip/hip_cooperative_groups.h>
#include <cstdio>
#include <cstdint>

#define LAS __attribute__((address_space(3)))
#define GAS __attribute__((address_space(1)))
typedef unsigned short bf16_t;
typedef short bf16x8 __attribute__((ext_vector_type(8)));
typedef float f32x4 __attribute__((ext_vector_type(4)));
typedef float f32x2 __attribute__((ext_vector_type(2)));
typedef unsigned u32x4 __attribute__((ext_vector_type(4)));
typedef unsigned u32x2 __attribute__((ext_vector_type(2)));
typedef int i32x8 __attribute__((ext_vector_type(8)));
typedef int i32x4 __attribute__((ext_vector_type(4)));

constexpr int Bn = 8, S = 4096, D = 1024, T = Bn * S;
constexpr int CW = 512, CK = 31, FW = 512, FG = 4, FGD = 128;
constexpr int INC = 2 * CW + FW + 2 * D;
constexpr int E = 16, CAP = 2 * S / E;
constexpr int F = 2 * D;
constexpr int NMOD = 6;
constexpr int ME = Bn * CAP;
constexpr int NWAVES = 8, NTHR = 512;

__device__ __forceinline__ float sigmoidf_(float x) { return __builtin_amdgcn_rcpf(1.f + __expf(-x)); }
__device__ __forceinline__ float siluf_(float x) { return x * __builtin_amdgcn_rcpf(1.f + __expf(-x)); }
__device__ __forceinline__ unsigned f2bf(float f) { unsigned u = __builtin_bit_cast(unsigned, f); return (u + 0x7fffu + ((u >> 16) & 1u)) >> 16; }
__device__ __forceinline__ unsigned pk2(float lo, float hi) { return f2bf(lo) | (f2bf(hi) << 16); }
__device__ __forceinline__ unsigned cvt_pk_bf16(float lo, float hi) { unsigned r; asm volatile("v_cvt_pk_bf16_f32 %0, %1, %2" : "=v"(r) : "v"(lo), "v"(hi)); return r; }
__device__ __forceinline__ float bf_lo(unsigned w) { return __builtin_bit_cast(float, w << 16); }
__device__ __forceinline__ float bf_hi(unsigned w) { return __builtin_bit_cast(float, w & 0xffff0000u); }
__device__ __forceinline__ float wave_sum(float v) {
#pragma unroll
    for (int o = 1; o < 64; o <<= 1) v += __shfl_xor(v, o);
    return v;
}
__device__ __forceinline__ u32x2 pack8_f8(const f32x4 v0, const f32x4 v1, const float sc) {
    unsigned a = 0u, b = 0u;
    a = __builtin_amdgcn_cvt_pk_fp8_f32(v0[0] * sc, v0[1] * sc, a, false); a = __builtin_amdgcn_cvt_pk_fp8_f32(v0[2] * sc, v0[3] * sc, a, true);
    b = __builtin_amdgcn_cvt_pk_fp8_f32(v1[0] * sc, v1[1] * sc, b, false); b = __builtin_amdgcn_cvt_pk_fp8_f32(v1[2] * sc, v1[3] * sc, b, true);
    return (u32x2){a, b};
}
#define LDS_WAIT() asm volatile("s_waitcnt lgkmcnt(0)" ::: "memory")
#define VM_WAIT() asm volatile("s_waitcnt vmcnt(0)" ::: "memory")

namespace pg8 {
constexpr int BM = 256, BK = 64, HALF = 128, HTB = HALF * BK * 2  , STAGE_BYTES = 8 * HTB, NXCD = 8, WGM = 8;
__host__ __device__ __forceinline__ int lds_byte(int r, int c) { const int st = (r >> 4) * 2 + (c >> 5), rr = r & 15, cc = c & 31, ob = rr * 64 + cc * 2; return st * 1024 + (ob ^ (((ob >> 9) & 1) << 5)); }
__host__ __device__ __forceinline__ void stage_rc(int b, int& R, int& C) { const int st = b / 1024, sb = b % 1024, swz = sb ^ (((sb >> 9) & 1) << 5); R = (st >> 1) * 16 + swz / 64; C = (st & 1) * 32 + (swz % 64) / 2; }
__host__ __device__ __forceinline__ int f8_off(int r, int fq) { const int rr = r & 15; return ((r >> 4) * 2 + (fq >> 1)) * 1024 + ((rr * 64 + 32 * (fq & 1)) ^ ((rr >> 3) << 5)); }
__host__ __device__ __forceinline__ int perm32(int rho) { const int n = rho >> 4, i = rho & 15; return 8 * (i >> 2) + 4 * n + (i & 3); }

struct Unit { const char* a; const char* b; const int* rows; int pm, pn, e; };

template <class Epi, class Sched, bool GATHER, bool F8 = false, bool I8 = false, bool DRAIN = true>
__device__ __forceinline__ void gemm_phase(LAS unsigned char* lds, const int KB, const Sched& S, const Epi& E, const int sw = 0x7f7f7f7f, const int sx = 0x7f7f7f7f) {
    int tid_ = threadIdx.x; asm volatile("" : "+v"(tid_));
    const int tid = tid_, wid = __builtin_amdgcn_readfirstlane(tid >> 6), lane = tid & 63, wr = wid >> 2, wc = wid & 3, fr = lane & 15, fq = lane >> 4;
    const int nt = KB / (BK * 2);
    int swv = sw, sxv = sx; if constexpr (F8) { asm volatile("" : "+v"(swv), "+v"(sxv)); }
    unsigned voffA[2], voffB[2]; int R0, C0;
#pragma unroll
    for (int i = 0; i < 2; ++i) { int R, C; stage_rc(tid * 16 + i * 8192, R, C); const int Rb = Epi::PERM ? ((R & ~31) + perm32(R & 31)) : R;
        voffA[i] = (unsigned)(R * KB + C * 2); voffB[i] = (unsigned)(Rb * KB + C * 2); if (i == 0) { R0 = R; C0 = C; } }
    const size_t kstep = (size_t)(BK * 2);
    const size_t hstep = (size_t)HALF * KB;
    const unsigned ldsw = (unsigned)wid * 1024u;
    const int aoff = lds_byte(wr * 64 + fr, fq * 8), boff = lds_byte(wc * 32 + fr, fq * 8);
#define PG8_SA(b, h) (((b) * 2 + (h)) * HTB)
#define PG8_SB(b, h) ((4 + (b) * 2 + (h)) * HTB)
#define PG8_STAGE(bufoff, gbase, voff) do { _Pragma("unroll") for (int _i = 0; _i < 2; ++_i) \
        __builtin_amdgcn_global_load_lds((const unsigned*)((const char*)(gbase) + (voff)[_i]), (LAS unsigned*)(lds + (bufoff) + ldsw + _i * 8192), 16, 0, 0); } while (0)
#define PG8_STGA(bufoff, p, h, v) do { if constexpr (GATHER) { PG8_STAGE(bufoff, p, (v) + 2 * (h)); } else { PG8_STAGE(bufoff, (p) + (h) * hstep, voffA); } } while (0)
#define PG8_LD8(p) __builtin_bit_cast(i32x8, __builtin_shufflevector(*(const LAS u32x4*)(p), *(const LAS u32x4*)((p) + 1024), 0, 1, 2, 3, 4, 5, 6, 7))
#define PG8_LDA(dst, b, h) do { if constexpr (F8) { _Pragma("unroll") for (int m = 0; m < 4; ++m) dst##8[m] = PG8_LD8(lds + PG8_SA(b, h) + aoff + m * 2048); } \
      else { _Pragma("unroll") for (int m = 0; m < 4; ++m) _Pragma("unroll") for (int k = 0; k < 2; ++k) dst[m][k] = *(const LAS bf16x8*)(lds + PG8_SA(b, h) + aoff + m * 2048 + k * 1024); } } while (0)
#define PG8_LDB(dst, b, h) do { if constexpr (F8) { _Pragma("unroll") for (int n = 0; n < 2; ++n) dst##8[n] = PG8_LD8(lds + PG8_SB(b, h) + boff + n * 2048); } \
      else { _Pragma("unroll") for (int n = 0; n < 2; ++n) _Pragma("unroll") for (int k = 0; k < 2; ++k) dst[n][k] = *(const LAS bf16x8*)(lds + PG8_SB(b, h) + boff + n * 2048 + k * 1024); } } while (0)
#define PG8_MMA(ai, bj, At, Bt, Z) do { __builtin_amdgcn_s_setprio(1); if constexpr (F8) { _Pragma("unroll") for (int m = 0; m < 4; ++m) _Pragma("unroll") for (int n = 0; n < 2; ++n) { \
        if constexpr ((Z) != 0) asm volatile("v_mfma_scale_f32_16x16x128_f8f6f4 %0, %1, %2, 0, %3, %4 op_sel_hi:[0,0,0]" : "=&v"(acc[ai][bj][m][n]) : "v"(Bt##8[n]), "v"(At##8[m]), "v"(swv), "v"(sxv)); \
        else asm volatile("v_mfma_scale_f32_16x16x128_f8f6f4 %0, %1, %2, %0, %3, %4 op_sel_hi:[0,0,0]" : "+v"(acc[ai][bj][m][n]) : "v"(Bt##8[n]), "v"(At##8[m]), "v"(swv), "v"(sxv)); } } \
      else if constexpr (I8) { _Pragma("unroll") for (int m = 0; m < 4; ++m) _Pragma("unroll") for (int n = 0; n < 2; ++n) _Pragma("unroll") for (int k = 0; k < 2; ++k) \
        acc[ai][bj][m][n] = __builtin_bit_cast(f32x4, __builtin_amdgcn_mfma_i32_16x16x64_i8(__builtin_bit_cast(i32x4, Bt[n][k]), __builtin_bit_cast(i32x4, At[m][k]), ((Z) != 0 && k == 0) ? (i32x4){0, 0, 0, 0} : __builtin_bit_cast(i32x4, acc[ai][bj][m][n]), 0, 0, 0)); } \
      else { _Pragma("unroll") for (int m = 0; m < 4; ++m) _Pragma("unroll") for (int n = 0; n < 2; ++n) _Pragma("unroll") for (int k = 0; k < 2; ++k) \
        acc[ai][bj][m][n] = __builtin_amdgcn_mfma_f32_16x16x32_bf16(Bt[n][k], At[m][k], ((Z) != 0 && k == 0) ? (f32x4){0.f, 0.f, 0.f, 0.f} : acc[ai][bj][m][n], 0, 0, 0); } __builtin_amdgcn_s_setprio(0); } while (0)
#define PG8_WAIT_V(n) asm volatile("s_waitcnt vmcnt(" #n ")" ::: "memory")
#define PG8_WAIT_L(n) asm volatile("s_waitcnt lgkmcnt(" #n ")" ::: "memory")
#define PG8_BAR __builtin_amdgcn_s_barrier()
#define PG8_SCHED __builtin_amdgcn_sched_barrier(0)
#define PG8_ROWS(u, v) do { if constexpr (GATHER) { _Pragma("unroll") for (int _h = 0; _h < 2; ++_h) _Pragma("unroll") for (int _i = 0; _i < 2; ++_i) \
        v[_h * 2 + _i] = (unsigned)((u).rows[_h * 128 + R0 + 64 * _i] * KB + C0 * 2); } } while (0)
#ifdef PROBE_EPI
    LAS unsigned long long* dbg_ = (LAS unsigned long long*)(lds + 139264);
    unsigned long long te0_ = 0;
#if PROBE_EPI == 3 || PROBE_EPI == 4
    if (tid == 0) te0_ = __builtin_amdgcn_s_memrealtime();
#endif
#endif
    Unit cur, nxt; int ui = 0;
    if (!S.next(0, cur)) return;
    f32x4 acc[2][2][4][2];
    if constexpr (!F8)
#pragma unroll
    for (int a = 0; a < 2; ++a)
#pragma unroll
        for (int b = 0; b < 2; ++b)
#pragma unroll
            for (int m = 0; m < 4; ++m)
#pragma unroll
                for (int n = 0; n < 2; ++n) acc[a][b][m][n] = (f32x4){0.f, 0.f, 0.f, 0.f};
    bf16x8 At[4][2], B0[2][2], B1[2][2]; i32x8 At8[4], B08[2], B18[2];
    unsigned vAc[4] = {0u, 0u, 0u, 0u}, vAn[4] = {0u, 0u, 0u, 0u}, vW[4] = {0u, 0u, 0u, 0u};
    PG8_ROWS(cur, vAc);
    const char* cA = cur.a; const char* cB = cur.b;
    PG8_STAGE(PG8_SB(0, 0), cB, voffB); PG8_STAGE(PG8_SB(0, 1), cB + hstep, voffB); PG8_STGA(PG8_SA(0, 0), cA, 0, vAc); PG8_STGA(PG8_SA(0, 1), cA, 1, vAc);
    if (wr == 1) PG8_BAR;
    PG8_WAIT_V(2); PG8_BAR;
    PG8_STAGE(PG8_SB(1, 0), cB + kstep, voffB); PG8_STGA(PG8_SA(1, 0), cA + kstep, 0, vAc); PG8_STAGE(PG8_SB(1, 1), cB + hstep + kstep, voffB);
    PG8_WAIT_V(6); PG8_BAR;
#if defined(PROBE_EPI) && PROBE_EPI == 4
    if (tid == 0 && dbg_[0]) dbg_[1] += __builtin_amdgcn_s_memrealtime() - te0_;
#endif
    for (;;) {
        const bool has_next = S.next(ui + 1, nxt);
        if (has_next) { PG8_ROWS(nxt, vAn); } else {
#pragma unroll
            for (int j = 0; j < 4; ++j) vAn[j] = vAc[j]; }
        const char* nA = has_next ? nxt.a : cA; const char* nB = has_next ? nxt.b : cB;
#if defined(PROBE_EPI) && PROBE_EPI == 2
        if (tid == 0) te0_ = __builtin_amdgcn_s_memrealtime();
#endif
#define PG8_ITER(Z) { \
            const bool last = (t == nt - 2); \
            const char* a1 = cA + (size_t)(t + 1) * kstep; \
            const char* a2 = last ? nA : cA + (size_t)(t + 2) * kstep; const char* b2 = last ? nB : cB + (size_t)(t + 2) * kstep; \
            const char* a3 = a2 + kstep; const char* b3 = b2 + kstep; \
            if constexpr (GATHER) {     \
                if (last) { asm volatile("" ::: "memory"); \
                    _Pragma("unroll") for (int j = 0; j < 4; ++j) vW[j] = vAn[j]; } \
                else { \
                    _Pragma("unroll") for (int j = 0; j < 4; ++j) vW[j] = vAc[j]; } } \
              \
            PG8_LDB(B0, 0, 0); PG8_LDB(B1, 0, 1); PG8_SCHED; PG8_LDA(At, 0, 0); PG8_STGA(PG8_SA(1, 1), a1, 1, vAc); \
            PG8_WAIT_V(8); PG8_WAIT_L(0); PG8_BAR; PG8_MMA(0, 0, At, B0, Z); PG8_MMA(0, 1, At, B1, Z); PG8_BAR; PG8_SCHED; \
              \
            PG8_LDA(At, 0, 1); PG8_STAGE(PG8_SB(0, 0), b2, voffB); PG8_STAGE(PG8_SB(0, 1), b2 + hstep, voffB); PG8_STGA(PG8_SA(0, 0), a2, 0, vW); \
            PG8_WAIT_V(8); PG8_WAIT_L(0); PG8_BAR; PG8_MMA(1, 0, At, B0, Z); PG8_MMA(1, 1, At, B1, Z); PG8_BAR; PG8_SCHED; \
              \
            PG8_LDB(B0, 1, 0); PG8_LDB(B1, 1, 1); PG8_SCHED; PG8_LDA(At, 1, 0); PG8_STGA(PG8_SA(0, 1), a2, 1, vW); \
            PG8_WAIT_V(8); PG8_WAIT_L(0); PG8_BAR; PG8_MMA(0, 0, At, B0, 0); PG8_MMA(0, 1, At, B1, 0); PG8_BAR; PG8_SCHED; \
              \
            PG8_LDA(At, 1, 1); PG8_STAGE(PG8_SB(1, 0), b3, voffB); PG8_STAGE(PG8_SB(1, 1), b3 + hstep, voffB); PG8_STGA(PG8_SA(1, 0), a3, 0, vW); \
            PG8_WAIT_V(8); PG8_WAIT_L(0); PG8_BAR; PG8_MMA(1, 0, At, B0, 0); PG8_MMA(1, 1, At, B1, 0); PG8_BAR; PG8_SCHED; \
        }
        if constexpr (F8) {
            { const int t = 0; PG8_ITER(1) }
#pragma unroll 1
            for (int t = 2; t < nt; t += 2) PG8_ITER(0)
        } else {
#pragma unroll 1
            for (int t = 0; t < nt; t += 2) PG8_ITER(0)
        }
#undef PG8_ITER
#if defined(PROBE_EPI) && PROBE_EPI == 2
        if (tid == 0 && dbg_[0]) dbg_[1] += __builtin_amdgcn_s_memrealtime() - te0_;
#endif
#if defined(PROBE_EPI) && PROBE_EPI == 1
        if (tid == 0) te0_ = __builtin_amdgcn_s_memrealtime();
#endif
        if (wr == 0) PG8_BAR;
        if constexpr (F8) { asm volatile("s_nop 15\n\ts_nop 15" ::: "memory"); }
        { int fr_ = fr, fq_ = fq; asm volatile("" : "+v"(fr_), "+v"(fq_));
          E(acc, cur, wr, wc, fr_, fq_); }
        if (!has_next) break;
        if constexpr (!F8) {
            bf16x8 z8 = (bf16x8){0, 0, 0, 0, 0, 0, 0, 0}; asm volatile("" : "+v"(z8));
#pragma unroll
            for (int a = 0; a < 2; ++a)
#pragma unroll
                for (int b = 0; b < 2; ++b)
#pragma unroll
                    for (int m = 0; m < 4; ++m)
#pragma unroll
                        for (int n = 0; n < 2; ++n) acc[a][b][m][n] = __builtin_amdgcn_mfma_f32_16x16x32_bf16(z8, z8, (f32x4){0.f, 0.f, 0.f, 0.f}, 0, 0, 0);
        }
        cur = nxt; cA = nA; cB = nB; ++ui;
#pragma unroll
        for (int j = 0; j < 4; ++j) vAc[j] = vAn[j];
        if (wr == 1) PG8_BAR;
#if defined(PROBE_EPI) && PROBE_EPI == 1
        if (tid == 0 && dbg_[0]) dbg_[1] += __builtin_amdgcn_s_memrealtime() - te0_;
#endif
    }
#if defined(PROBE_EPI) && PROBE_EPI == 5
    if (tid == 0) te0_ = __builtin_amdgcn_s_memrealtime();
#endif
    if constexpr (DRAIN) PG8_WAIT_V(0);
    PG8_BAR;
#if defined(PROBE_EPI) && PROBE_EPI == 5
    if (tid == 0 && dbg_[0]) dbg_[1] += __builtin_amdgcn_s_memrealtime() - te0_;
#endif
#if defined(PROBE_EPI) && PROBE_EPI == 3
    if (tid == 0 && dbg_[0]) dbg_[1] += __builtin_amdgcn_s_memrealtime() - te0_;
#endif
#undef PG8_SA
#undef PG8_SB
#undef PG8_STAGE
#undef PG8_STGA
#undef PG8_LDA
#undef PG8_LDB
#undef PG8_MMA
#undef PG8_LD8
#undef PG8_WAIT_V
#undef PG8_WAIT_L
#undef PG8_BAR
#undef PG8_SCHED
#undef PG8_ROWS
}

struct SchedDense {
    const char* A; const char* Bt; int nM, nN, nwg, G, c; size_t tstep;
    __device__ void init(const void* A_, const void* Bt_, int M, int N, int K, int G_, int c_) { A = (const char*)A_; Bt = (const char*)Bt_; nM = M / BM; nN = N / BM; nwg = nM * nN; G = G_; c = c_; tstep = (size_t)BM * K * 2; }
    __device__ bool next(int i, Unit& u) const {
        const long L = (long)i * G + c; if (L >= nwg) return false;
        int wgid = (int)L; { const int q = nwg / NXCD, r = nwg % NXCD, xcd = wgid % NXCD, off = wgid / NXCD; wgid = (xcd < r ? xcd * (q + 1) : r * (q + 1) + (xcd - r) * q) + off; }
        const int nig = WGM * nN, gid = wgid / nig, fm = gid * WGM, gsz = (nM - fm) < WGM ? (nM - fm) : WGM;
        u.pm = fm + ((wgid % nig) % gsz); u.pn = (wgid % nig) / gsz; u.e = 0; u.rows = nullptr;
        u.a = A + (size_t)u.pm * tstep; u.b = Bt + (size_t)u.pn * tstep; return true;
    }
};
struct SchedOwn2 {
    SchedDense base; const char* Bt; size_t tstep;
    __device__ void init(const void* A_, const void* Bt_, int M, int Ny, int K, int G_, int c_) { base.init(A_, Bt_, M, Ny, K, G_, c_); Bt = (const char*)Bt_; tstep = (size_t)BM * K * 2; }
    __device__ bool next(int i, Unit& u) const { if (!base.next(i >> 1, u)) return false; u.pn = 2 * u.pn + (i & 1); u.b = Bt + (size_t)u.pn * tstep; return true; }
};
}

#ifndef GATE_F8
#ifndef IN_I8
#define IN_I8 1
#endif
#ifndef FFT_I8
#define FFT_I8 1
#endif
#ifndef CONV_I8
#define CONV_I8 1
#endif
#ifndef OWN_MERGE
#define OWN_MERGE 1
#endif
#ifndef SWIGLU_FOLD
#define SWIGLU_FOLD 1
#endif
#ifndef P0A_BG
#define P0A_BG 6
#endif
#ifndef TOPK_BG
#define TOPK_BG 1
#endif
constexpr int TOPK_BG_ITEMS = 4096;
#ifndef P0A_IDLE
#define P0A_IDLE 1
#endif
constexpr int P0A_IDLE_ITEMS = 2048;
#ifndef OUT_F8
#define OUT_F8 0
#endif
#ifndef IN_F8_GLU
#define IN_F8_GLU 0
#endif
#ifndef IN_F8_FT
#define IN_F8_FT 0
#endif
constexpr size_t FT8_OFF = 6u << 20;
#define IN_F8 (IN_F8_GLU && IN_F8_FT)
#define GATE_F8 1
#endif
#ifndef H_DELTA
#define H_DELTA 1
#endif
#ifndef YB_F8
#define YB_F8 1
#endif
#ifndef MOE_F8
#define MOE_F8 1
#endif

namespace epi {
using pg8::Unit;
#define EPI_ROWS(ai, m) (128 * (ai) + 64 * wr + 16 * (m) + fr)
__device__ __forceinline__ u32x4 pack8(const f32x4 v0, const f32x4 v1) { u32x4 w; w.x = cvt_pk_bf16(v0[0], v0[1]); w.y = cvt_pk_bf16(v0[2], v0[3]); w.z = cvt_pk_bf16(v1[0], v1[1]); w.w = cvt_pk_bf16(v1[2], v1[3]); return w; }
__device__ __forceinline__ f32x4 sig4(const f32x4 v) { return (f32x4){sigmoidf_(v[0]), sigmoidf_(v[1]), sigmoidf_(v[2]), sigmoidf_(v[3])}; }
__device__ __forceinline__ f32x4 silu4(const f32x4 v) { return (f32x4){siluf_(v[0]), siluf_(v[1]), siluf_(v[2]), siluf_(v[3])}; }
__device__ __forceinline__ void unpack8(const u32x4 w, f32x4& v0, f32x4& v1) { v0 = (f32x4){bf_lo(w.x), bf_hi(w.x), bf_lo(w.y), bf_hi(w.y)}; v1 = (f32x4){bf_lo(w.z), bf_hi(w.z), bf_lo(w.w), bf_hi(w.w)}; }

__device__ __forceinline__ f32x4 i2f(const f32x4 a) { return __builtin_convertvector(__builtin_bit_cast(i32x4, a), f32x4); }
#define EPI_ROWSC(dst, ptr, base) float dst[2][4]; { _Pragma("unroll") for (int ai_ = 0; ai_ < 2; ++ai_) _Pragma("unroll") for (int m_ = 0; m_ < 4; ++m_) dst[ai_][m_] = (ptr)[(base) + EPI_ROWS(ai_, m_)]; } __builtin_amdgcn_sched_barrier(0)
struct EpiGlu {
    static constexpr bool PERM = true;
    bf16_t* V; const float* bias; const float* usc; const float* wsc;
    __device__ __forceinline__ void operator()(const f32x4 (&acc)[2][2][4][2], const Unit& u, int wr, int wc, int fr, int fq) const {
        const int ch = u.pn * 128 + wc * 32 + 8 * fq;
        f32x4 ba[2], bg[2], sa[2], sg[2];
#pragma unroll
        for (int n = 0; n < 2; ++n) { ba[n] = *(const f32x4*)(bias + ch + 4 * n); bg[n] = *(const f32x4*)(bias + CW + ch + 4 * n);
            if (IN_I8) { sa[n] = *(const f32x4*)(wsc + u.pn * 256 + wc * 32 + 8 * fq + 4 * n); sg[n] = *(const f32x4*)(wsc + u.pn * 256 + 128 + wc * 32 + 8 * fq + 4 * n); } }
        EPI_ROWSC(srv, IN_I8 ? usc : bias, IN_I8 ? u.pm * 256 : 0);
#pragma unroll
        for (int ai = 0; ai < 2; ++ai)
#pragma unroll
            for (int m = 0; m < 4; ++m) { const size_t row = (size_t)u.pm * 256 + EPI_ROWS(ai, m);
                f32x4 v0, v1;
                if (IN_I8) { const float sr = srv[ai][m];
                    v0 = (i2f(acc[ai][0][m][0]) * (sa[0] * sr) + ba[0]) * sig4(i2f(acc[ai][1][m][0]) * (sg[0] * sr) + bg[0]);
                    v1 = (i2f(acc[ai][0][m][1]) * (sa[1] * sr) + ba[1]) * sig4(i2f(acc[ai][1][m][1]) * (sg[1] * sr) + bg[1]); }
                else { v0 = (acc[ai][0][m][0] + ba[0]) * sig4(acc[ai][1][m][0] + bg[0]); v1 = (acc[ai][0][m][1] + ba[1]) * sig4(acc[ai][1][m][1] + bg[1]); }
                *(u32x4*)(V + row * CW + ch) = pack8(v0, v1); }
    }
};
struct EpiFT {
    static constexpr bool PERM = true;
    bf16_t* FT; const float* bias; const float* usc; const float* wsc;
    __device__ __forceinline__ void operator()(const f32x4 (&acc)[2][2][4][2], const Unit& u, int wr, int wc, int fr, int fq) const {
        f32x4 st[2][2];
        if (IN_I8) {
#pragma unroll
            for (int bj = 0; bj < 2; ++bj)
#pragma unroll
                for (int n = 0; n < 2; ++n) st[bj][n] = *(const f32x4*)(usc + u.pn * 256 + bj * 128 + wc * 32 + 8 * fq + 4 * n); }
        EPI_ROWSC(bvv, bias, u.pm * 256); EPI_ROWSC(swv, IN_I8 ? wsc : bias, u.pm * 256);
#pragma unroll
        for (int ai = 0; ai < 2; ++ai)
#pragma unroll
            for (int m = 0; m < 4; ++m) { const int ch = u.pm * 256 + EPI_ROWS(ai, m); const float bv = bvv[ai][m]; float sw_ = 1.f; if (IN_I8) sw_ = swv[ai][m];
#pragma unroll
                for (int bj = 0; bj < 2; ++bj) { const int tok = u.pn * 256 + bj * 128 + wc * 32 + 8 * fq; const int b = tok >> 12, s = tok & (S - 1);
                    if (IN_I8) *(u32x4*)(FT + ((size_t)(b * FW + ch) * S + s)) = pack8(i2f(acc[ai][bj][m][0]) * (st[bj][0] * sw_) + bv, i2f(acc[ai][bj][m][1]) * (st[bj][1] * sw_) + bv);
                    else *(u32x4*)(FT + ((size_t)(b * FW + ch) * S + s)) = pack8(acc[ai][bj][m][0] + bv, acc[ai][bj][m][1] + bv); } }
    }
};
struct EpiFFT {
    static constexpr bool PERM = true;
    bf16_t* YRI; const float* gsc;
    __device__ __forceinline__ void operator()(const f32x4 (&acc)[2][2][4][2], const Unit& u, int wr, int wc, int fr, int fq) const {
        const int part = u.pm, chb = u.pn & 1, k2 = (u.pn >> 1) & 15, b = u.pn >> 5;
        f32x4 sc[2][2];
        if (FFT_I8) {
#pragma unroll
            for (int bj = 0; bj < 2; ++bj)
#pragma unroll
                for (int n = 0; n < 2; ++n) sc[bj][n] = *(const f32x4*)(gsc + b * FW + chb * 256 + bj * 128 + wc * 32 + 8 * fq + 4 * n) * (1.f / 127.f); }
#pragma unroll
        for (int ai = 0; ai < 2; ++ai)
#pragma unroll
            for (int m = 0; m < 4; ++m) { const int k1 = EPI_ROWS(ai, m);
                bf16_t* rowp = YRI + ((size_t)(b * S + 16 * k1 + k2) * (2 * FW) + part * FW + chb * 256 + wc * 32 + 8 * fq);
#pragma unroll
                for (int bj = 0; bj < 2; ++bj) { if (FFT_I8) *(u32x4*)(rowp + bj * 128) = pack8(i2f(acc[ai][bj][m][0]) * sc[bj][0], i2f(acc[ai][bj][m][1]) * sc[bj][1]);
                    else *(u32x4*)(rowp + bj * 128) = pack8(acc[ai][bj][m][0], acc[ai][bj][m][1]); } }
    }
};
struct EpiBias {
    static constexpr bool PERM = true;
    bf16_t* O; int ldc; const float* bias;
    __device__ __forceinline__ void operator()(const f32x4 (&acc)[2][2][4][2], const Unit& u, int wr, int wc, int fr, int fq) const {
        const int col0 = u.pn * 256 + wc * 32 + 8 * fq;
        f32x4 bv[2][2];
#pragma unroll
        for (int bj = 0; bj < 2; ++bj)
#pragma unroll
            for (int n = 0; n < 2; ++n) bv[bj][n] = *(const f32x4*)(bias + col0 + bj * 128 + 4 * n);
#pragma unroll
        for (int ai = 0; ai < 2; ++ai)
#pragma unroll
            for (int m = 0; m < 4; ++m) { bf16_t* rowp = O + ((size_t)u.pm * 256 + EPI_ROWS(ai, m)) * ldc + col0;
#pragma unroll
                for (int bj = 0; bj < 2; ++bj) *(u32x4*)(rowp + bj * 128) = pack8(acc[ai][bj][m][0] + bv[bj][0], acc[ai][bj][m][1] + bv[bj][1]); }
    }
};
struct EpiBiasI8 {
    static constexpr bool PERM = true;
    bf16_t* O; int ldc; const float* bias; const float* usc; const float* wsc;
    __device__ __forceinline__ void operator()(const f32x4 (&acc)[2][2][4][2], const Unit& u, int wr, int wc, int fr, int fq) const {
        const int col0 = u.pn * 256 + wc * 32 + 8 * fq;
        f32x4 bv[2][2], sc[2][2];
#pragma unroll
        for (int bj = 0; bj < 2; ++bj)
#pragma unroll
            for (int n = 0; n < 2; ++n) { bv[bj][n] = *(const f32x4*)(bias + col0 + bj * 128 + 4 * n); sc[bj][n] = *(const f32x4*)(wsc + col0 + bj * 128 + 4 * n); }
        EPI_ROWSC(srv, usc, u.pm * 256);
#pragma unroll
        for (int ai = 0; ai < 2; ++ai)
#pragma unroll
            for (int m = 0; m < 4; ++m) { const size_t row = (size_t)u.pm * 256 + EPI_ROWS(ai, m); bf16_t* rowp = O + row * ldc + col0; const float sr = srv[ai][m];
#pragma unroll
                for (int bj = 0; bj < 2; ++bj) *(u32x4*)(rowp + bj * 128) = pack8(i2f(acc[ai][bj][m][0]) * (sc[bj][0] * sr) + bv[bj][0], i2f(acc[ai][bj][m][1]) * (sc[bj][1] * sr) + bv[bj][1]); }
    }
};
struct EpiMerge {
    static constexpr bool PERM = true;
    bf16_t* MG; const bf16_t* YC; const bf16_t* YF; const float* bias; const float* usc; const float* wsc;
    __device__ __forceinline__ void operator()(const f32x4 (&acc)[2][2][4][2], const Unit& u, int wr, int wc, int fr, int fq) const {
        const int nn = u.pn * 128 + wc * 32 + 8 * fq;
        u32x4 ya[4][2], yb[4][2];
#pragma unroll
        for (int m = 0; m < 4; ++m) { const size_t off = ((size_t)u.pm * 256 + EPI_ROWS(0, m)) * D + nn; ya[m][0] = __builtin_nontemporal_load((const GAS u32x4*)(YC + off)); ya[m][1] = __builtin_nontemporal_load((const GAS u32x4*)(YF + off)); }
        __builtin_amdgcn_sched_barrier(0);
        f32x4 g[2][2][4][2];
        {   f32x4 b0[2], b1[2], s0[2], s1[2];
#pragma unroll
            for (int n = 0; n < 2; ++n) { b0[n] = *(const f32x4*)(bias + 2 * CW + FW + nn + 4 * n); b1[n] = *(const f32x4*)(bias + 2 * CW + FW + D + nn + 4 * n);
                if (IN_I8) { s0[n] = *(const f32x4*)(wsc + u.pn * 256 + wc * 32 + 8 * fq + 4 * n); s1[n] = *(const f32x4*)(wsc + u.pn * 256 + 128 + wc * 32 + 8 * fq + 4 * n); } }
            EPI_ROWSC(srv, IN_I8 ? usc : bias, IN_I8 ? u.pm * 256 : 0);
#pragma unroll
            for (int ai = 0; ai < 2; ++ai)
#pragma unroll
                for (int m = 0; m < 4; ++m)
#pragma unroll
                    for (int n = 0; n < 2; ++n) {
                        if (IN_I8) { const float sr = srv[ai][m]; g[ai][0][m][n] = sig4(i2f(acc[ai][0][m][n]) * (s0[n] * sr) + b0[n]); g[ai][1][m][n] = sig4(i2f(acc[ai][1][m][n]) * (s1[n] * sr) + b1[n]); }
                        else { g[ai][0][m][n] = sig4(acc[ai][0][m][n] + b0[n]); g[ai][1][m][n] = sig4(acc[ai][1][m][n] + b1[n]); } }
        }
        __builtin_amdgcn_sched_barrier(0);
#pragma unroll
        for (int m = 0; m < 4; ++m) { const size_t off = ((size_t)u.pm * 256 + EPI_ROWS(1, m)) * D + nn; yb[m][0] = __builtin_nontemporal_load((const GAS u32x4*)(YC + off)); yb[m][1] = __builtin_nontemporal_load((const GAS u32x4*)(YF + off)); }
        __builtin_amdgcn_sched_barrier(0);
#pragma unroll
        for (int ai = 0; ai < 2; ++ai) {
#pragma unroll
            for (int m = 0; m < 4; ++m) { const size_t off = ((size_t)u.pm * 256 + EPI_ROWS(ai, m)) * D + nn;
                f32x4 c0, c1, f0, f1; unpack8(ai == 0 ? ya[m][0] : yb[m][0], c0, c1); unpack8(ai == 0 ? ya[m][1] : yb[m][1], f0, f1);
                const f32x4 v0 = g[ai][0][m][0] * c0 + g[ai][1][m][0] * f0, v1 = g[ai][0][m][1] * c1 + g[ai][1][m][1] * f1;
                if (OUT_F8) *(u32x2*)((unsigned char*)MG + off) = pack8_f8(v0, v1, 4.f  );
                else *(u32x4*)(MG + off) = pack8(v0, v1); }
            __builtin_amdgcn_sched_barrier(0);
        }
    }
};
struct EpiResid {
    static constexpr bool PERM = false;
    const float* X; float* H; const float* gate; const float* bias;
    __device__ __forceinline__ void operator()(const f32x4 (&acc)[2][2][4][2], const Unit& u, int wr, int wc, int fr, int fq) const {
        const int col0 = u.pn * 256 + wc * 32 + 4 * fq; const int b = (u.pm * 256) >> 12;
        const float* gp = gate + (size_t)b * NMOD * D + col0; const float* bp = bias + col0;
#pragma unroll
        for (int ai = 0; ai < 2; ++ai) {
            f32x4 xv[4][2][2];
#pragma unroll
            for (int m = 0; m < 4; ++m) { const size_t off = ((size_t)u.pm * 256 + EPI_ROWS(ai, m)) * D + col0;
#pragma unroll
                for (int bj = 0; bj < 2; ++bj)
#pragma unroll
                    for (int n = 0; n < 2; ++n) xv[m][bj][n] = *(const f32x4*)(X + off + bj * 128 + n * 16); }
#pragma unroll
            for (int bj = 0; bj < 2; ++bj)
#pragma unroll
                for (int n = 0; n < 2; ++n) { const f32x4 gv = *(const f32x4*)(gp + bj * 128 + n * 16), bv = *(const f32x4*)(bp + bj * 128 + n * 16);
#pragma unroll
                    for (int m = 0; m < 4; ++m) { const size_t off = ((size_t)u.pm * 256 + EPI_ROWS(ai, m)) * D + col0;
                        *(f32x4*)(H + off + bj * 128 + n * 16) = xv[m][bj][n] + gv * (acc[ai][bj][m][n] + bv); } }
            asm volatile("" ::: "memory");
        }
    }
};
struct EpiDelta {
    static constexpr bool PERM = true;
    bf16_t* DL; const float* gate; const float* bias;
    __device__ __forceinline__ void operator()(const f32x4 (&acc)[2][2][4][2], const Unit& u, int wr, int wc, int fr, int fq) const {
        const int col0 = u.pn * 256 + wc * 32 + 8 * fq; const int b = (u.pm * 256) >> 12;
        f32x4 bv[2][2], gv[2][2];
#pragma unroll
        for (int bj = 0; bj < 2; ++bj)
#pragma unroll
            for (int n = 0; n < 2; ++n) { bv[bj][n] = *(const f32x4*)(bias + col0 + bj * 128 + 4 * n); gv[bj][n] = *(const f32x4*)(gate + (size_t)b * NMOD * D + col0 + bj * 128 + 4 * n); }
#pragma unroll
        for (int ai = 0; ai < 2; ++ai)
#pragma unroll
            for (int m = 0; m < 4; ++m) { bf16_t* rowp = DL + ((size_t)u.pm * 256 + EPI_ROWS(ai, m)) * D + col0;
#pragma unroll
                for (int bj = 0; bj < 2; ++bj) *(u32x4*)(rowp + bj * 128) = pack8(gv[bj][0] * (acc[ai][bj][m][0] + bv[bj][0]), gv[bj][1] * (acc[ai][bj][m][1] + bv[bj][1])); }
    }
};
constexpr float ACT_SC = 2.f, U_SC = 4.f, W_SC = 64.f;
constexpr int MX_U = 0x7d7d7d7d, MX_ACT = 0x7e7e7e7e, MX_W = 0x79797979;
template <bool F8> struct EpiSwiglu {
    static constexpr bool PERM = true;
    void* ACT;
    __device__ __forceinline__ void operator()(const f32x4 (&acc)[2][2][4][2], const Unit& u, int wr, int wc, int fr, int fq) const {
        const int col = u.pn * 128 + wc * 32 + 8 * fq;
#pragma unroll
        for (int ai = 0; ai < 2; ++ai)
#pragma unroll
            for (int m = 0; m < 4; ++m) { const size_t row = (size_t)u.e * ME + u.pm * 256 + EPI_ROWS(ai, m);
                if constexpr (F8 && SWIGLU_FOLD) {
                    f32x4 o[2];
#pragma unroll
                    for (int n = 0; n < 2; ++n)
#pragma unroll
                        for (int q = 0; q < 4; ++q) { const float gq = acc[ai][0][m][n][q]; o[n][q] = gq * acc[ai][1][m][n][q] * __builtin_amdgcn_rcpf(1.f + __builtin_amdgcn_exp2f(-gq)); }
                    *(u32x2*)((unsigned char*)ACT + row * F + col) = pack8_f8(o[0], o[1], 1.f); continue; }
                const f32x4 v0 = silu4(acc[ai][0][m][0]) * acc[ai][1][m][0], v1 = silu4(acc[ai][0][m][1]) * acc[ai][1][m][1];
                if constexpr (F8) *(u32x2*)((unsigned char*)ACT + row * F + col) = pack8_f8(v0, v1, ACT_SC);
                else *(u32x4*)((bf16_t*)ACT + row * F + col) = pack8(v0, v1); }
    }
};
constexpr float YB_SC = 32.f;
struct EpiScaleW {
    static constexpr bool PERM = true;
    void* YB; const float* W;
    __device__ __forceinline__ void operator()(const f32x4 (&acc)[2][2][4][2], const Unit& u, int wr, int wc, int fr, int fq) const {
        const int col0 = u.pn * 256 + wc * 32 + 8 * fq;
        EPI_ROWSC(wv, W, (size_t)u.e * ME + u.pm * 256);
#pragma unroll
        for (int ai = 0; ai < 2; ++ai)
#pragma unroll
            for (int m = 0; m < 4; ++m) { const size_t row = (size_t)u.e * ME + u.pm * 256 + EPI_ROWS(ai, m); const float w = wv[ai][m];
#pragma unroll
                for (int bj = 0; bj < 2; ++bj) {
                    if (YB_F8) *(u32x2*)((unsigned char*)YB + row * D + col0 + bj * 128) = pack8_f8(acc[ai][bj][m][0], acc[ai][bj][m][1], w * YB_SC);
                    else *(u32x4*)((bf16_t*)YB + row * D + col0 + bj * 128) = pack8(acc[ai][bj][m][0] * w, acc[ai][bj][m][1] * w); } }
    }
};
#undef EPI_ROWS
}

namespace pg8 {
struct SchedG1 {
    const char* U; const char* W; const int* rowl; int G, c, esz;
    __device__ bool next(int i, Unit& u) const {
        int e;
#ifdef PWR_N
        if (G == 256) { const int xcd = c & 7, j = c >> 3; if (j >= PWR_N) return false; const int L = i * PWR_N + j; if (L >= 512) return false; e = 2 * xcd + (L >> 8); const int l = L & 255; u.pm = (l & 7) + ((l >> 5) & 1) * 8; u.pn = ((l >> 3) & 3) + (l >> 6) * 4; }
        else
#endif
        if (G == 256) { if (i >= 16) return false; const int xcd = c & 7, j = c >> 3, ri = i & 7; e = 2 * xcd + (i >> 3); u.pm = (ri & 1) * 8 + (j & 7); u.pn = (ri >> 1) * 4 + (j >> 3); }
        else { const int L = i * G + c; if (L >= E * 256) return false; e = L >> 8; const int l = L & 255; u.pm = l & 15; u.pn = l >> 4; }
        u.e = e; u.a = U; u.rows = rowl + e * ME + u.pm * 256; u.b = W + ((size_t)e * 2 * F + (size_t)u.pn * 256) * D * esz; return true;
    }
};
struct SchedG2 {
    const char* ACT; const char* W; int G, c, esz;
    __device__ bool next(int i, Unit& u) const {
        int e;
        if (G == 256) { if (i >= 4) return false; const int xcd = c & 7, j = c >> 3; e = 2 * xcd + (i >> 1); u.pm = (i & 1) * 8 + (j & 7); u.pn = j >> 3; }
        else { const int L = i * G + c; if (L >= E * 64) return false; e = L >> 6; const int l = L & 63; u.pm = l & 15; u.pn = l >> 4; }
        u.e = e; u.rows = nullptr;
        u.a = ACT + ((size_t)e * ME + (size_t)u.pm * 256) * F * esz; u.b = W + ((size_t)e * D + (size_t)u.pn * 256) * F * esz; return true;
    }
};
}

struct Ctx {
    LAS unsigned char* lds; int tid, lane, wave, vcu, G;
};

__device__ __forceinline__ void transpose_item(const float* W, int ldw, int k0, int n0, bf16_t* WT, int ldt, int dst_row0, LAS float* scr, int lane) {
#pragma unroll 8
    for (int i = 0; i < 32; ++i) { const int kk = 2 * i + (lane >> 5); scr[kk * 33 + (lane & 31)] = W[(size_t)(k0 + kk) * ldw + n0 + (lane & 31)]; }
    LDS_WAIT(); asm volatile("" ::: "memory");
    const int c = lane & 7;
#pragma unroll
    for (int j = 0; j < 4; ++j) { const int n = (lane >> 3) + 8 * j; const LAS float* s = scr + (8 * c) * 33 + n;
        u32x4 o; o.x = pk2(s[0 * 33], s[1 * 33]); o.y = pk2(s[2 * 33], s[3 * 33]); o.z = pk2(s[4 * 33], s[5 * 33]); o.w = pk2(s[6 * 33], s[7 * 33]);
        *(GAS u32x4*)(WT + (size_t)(dst_row0 + n) * ldt + k0 + 8 * c) = o; }
    LDS_WAIT(); asm volatile("" ::: "memory");
}
struct TItem { const float* src; unsigned char* dst; int ldw, ldt, f8, n0; float sc; };
__device__ __forceinline__ void titem_load(const TItem& t, int lane, f32x4 (&v)[8]) {
#pragma unroll
    for (int i = 0; i < 8; ++i) v[i] = __builtin_nontemporal_load((const GAS f32x4*)(t.src + (size_t)(8 * i + (lane >> 3)) * t.ldw + (lane & 7) * 4));
}
__device__ __forceinline__ void titem_store_f8(const TItem& t, int lane, const f32x4 (&v)[8], LAS float* scr, float sc) {
#pragma unroll
    for (int i = 0; i < 8; ++i) { LAS float* d = scr + (8 * i + (lane >> 3)) * 33 + (lane & 7) * 4; d[0] = v[i][0]; d[1] = v[i][1]; d[2] = v[i][2]; d[3] = v[i][3]; }
    LDS_WAIT(); asm volatile("" ::: "memory");
#pragma unroll
    for (int j = 0; j < 2; ++j) { const int idx = lane + 64 * j, n = idx >> 2, c = idx & 3; const LAS float* s = scr + (16 * c) * 33 + n;
        unsigned w[4];
#pragma unroll
        for (int q = 0; q < 4; ++q) { unsigned tt = 0u; tt = __builtin_amdgcn_cvt_pk_fp8_f32(s[(4 * q + 0) * 33] * sc, s[(4 * q + 1) * 33] * sc, tt, false); tt = __builtin_amdgcn_cvt_pk_fp8_f32(s[(4 * q + 2) * 33] * sc, s[(4 * q + 3) * 33] * sc, tt, true); w[q] = tt; }
        *(GAS u32x4*)(t.dst + (size_t)n * t.ldt + 16 * c) = (u32x4){w[0], w[1], w[2], w[3]}; }
    LDS_WAIT(); asm volatile("" ::: "memory");
}
__device__ __forceinline__ void titem_colmax(const TItem& t, int lane, const f32x4 (&v)[8], unsigned* cmax) {
    f32x4 m = (f32x4){0.f, 0.f, 0.f, 0.f};
#pragma unroll
    for (int i = 0; i < 8; ++i) { m[0] = fmaxf(m[0], fabsf(v[i][0])); m[1] = fmaxf(m[1], fabsf(v[i][1])); m[2] = fmaxf(m[2], fabsf(v[i][2])); m[3] = fmaxf(m[3], fabsf(v[i][3])); }
#pragma unroll
    for (int o = 8; o < 64; o <<= 1) { m[0] = fmaxf(m[0], __shfl_xor(m[0], o)); m[1] = fmaxf(m[1], __shfl_xor(m[1], o)); m[2] = fmaxf(m[2], __shfl_xor(m[2], o)); m[3] = fmaxf(m[3], __shfl_xor(m[3], o)); }
    if (lane < 8) {
#pragma unroll
        for (int q = 0; q < 4; ++q) __hip_atomic_fetch_max(cmax + t.n0 + 4 * lane + q, __float_as_uint(m[q]), __ATOMIC_RELAXED, __HIP_MEMORY_SCOPE_AGENT); }
}
__device__ __forceinline__ unsigned q8_put(float x, unsigned sel, unsigned old) { return __builtin_amdgcn_cvt_pk_u8_f32(__builtin_rintf(x) + 128.f, sel, old); }
__device__ __forceinline__ unsigned q8_pack4(float a, float b, float c, float d) { unsigned w = 0u; w = q8_put(a, 0, w); w = q8_put(b, 1, w); w = q8_put(c, 2, w); w = q8_put(d, 3, w); return w ^ 0x80808080u; }
__device__ __forceinline__ void titem_store_i8(const TItem& t, int lane, const f32x4 (&v)[8], LAS float* scr, const unsigned* cmax, float* wsc_row0) {
#pragma unroll
    for (int i = 0; i < 8; ++i) { LAS float* d = scr + (8 * i + (lane >> 3)) * 33 + (lane & 7) * 4; d[0] = v[i][0]; d[1] = v[i][1]; d[2] = v[i][2]; d[3] = v[i][3]; }
    LDS_WAIT(); asm volatile("" ::: "memory");
#pragma unroll
    for (int j = 0; j < 2; ++j) { const int idx = lane + 64 * j, n = idx >> 2, c = idx & 3; const LAS float* s = scr + (16 * c) * 33 + n;
        const float cm = __uint_as_float(cmax[t.n0 + n]), inv = cm > 0.f ? 127.f / cm : 0.f;
        unsigned w[4];
#pragma unroll
        for (int q = 0; q < 4; ++q) w[q] = q8_pack4(s[(4 * q + 0) * 33] * inv, s[(4 * q + 1) * 33] * inv, s[(4 * q + 2) * 33] * inv, s[(4 * q + 3) * 33] * inv);
        *(GAS u32x4*)(t.dst + (size_t)n * t.ldt + 16 * c) = (u32x4){w[0], w[1], w[2], w[3]};
        if (wsc_row0 != nullptr && c == 0) wsc_row0[n] = cm * (1.f / 127.f); }
    LDS_WAIT(); asm volatile("" ::: "memory");
}
__device__ __forceinline__ int win_row(int n0) {
    if (n0 < 2 * CW) { const int half = n0 / CW, ch = n0 % CW; return 256 * (ch / 128) + 128 * half + (ch % 128); }
    if (n0 < 2 * CW + FW) return n0;
    const int cc = n0 - (2 * CW + FW), half = cc / D, c2 = cc % D; return 2 * CW + FW + 256 * (c2 / 128) + 128 * half + (c2 % 128);
}

struct P {
    const float *x, *c, *ada_w, *ada_b, *norm1_g, *w_in, *b_in, *dw_w, *dw_b, *cln_g, *cln_b, *cw_out, *cb_out, *four_w, *four_b, *w_out, *b_out, *norm2_g, *router_w, *w_gate, *w_up, *w_down, *final_g;
    float* out;
    float* MOD; float* W2F; float* AFF; int* ROWL; float* WTS; short* INV;
    bf16_t *Wt_in, *Wt_conv, *Wt_four, *Wt_out, *D256, *GP, *Wt_gu, *Wt_down;
    bf16_t *U, *V, *FT, *ACONV, *YRI, *YCONV, *YFOUR, *MERGED, *ACT, *YB, *DELTA; unsigned char *U8X, *Wt_g8;
};
#define P_GSC(p) ((p).MOD + 65536)
#define P_USC(p) ((p).MOD + 131072)
#define P_ASC(p) ((p).MOD + 163840)
#define P_WSC(p) ((p).MOD + 196608)
#define P_CMAX(p) ((unsigned*)(p).MOD - 131072)

__device__ __forceinline__ void titem_store_bf16(const TItem& t, int lane, const f32x4 (&v)[8], LAS float* scr) {
#pragma unroll
    for (int i = 0; i < 8; ++i) { LAS float* d = scr + (8 * i + (lane >> 3)) * 33 + (lane & 7) * 4; d[0] = v[i][0]; d[1] = v[i][1]; d[2] = v[i][2]; d[3] = v[i][3]; }
    LDS_WAIT(); asm volatile("" ::: "memory");
    const int c = lane & 7;
#pragma unroll
    for (int j = 0; j < 4; ++j) { const int n = (lane >> 3) + 8 * j; const LAS float* s = scr + (8 * c) * 33 + n;
        u32x4 o; o.x = pk2(s[0 * 33], s[1 * 33]); o.y = pk2(s[2 * 33], s[3 * 33]); o.z = pk2(s[4 * 33], s[5 * 33]); o.w = pk2(s[6 * 33], s[7 * 33]);
        *(GAS u32x4*)(t.dst + ((size_t)n * t.ldt + 8 * c) * 2) = o; }
    LDS_WAIT(); asm volatile("" ::: "memory");
}
__device__ __forceinline__ TItem small_item(const P& p, int r) {
    constexpr int I1 = (D / 64) * (INC / 32), I2 = (CW / 64) * (D / 32);
    TItem t;
    t.f8 = 0; t.sc = epi::W_SC;
    t.n0 = 0;
    if (r < I1) { const int kb = r / (INC / 32), nb = r % (INC / 32); t.src = p.w_in + (size_t)(64 * kb) * INC + 32 * nb; t.ldw = INC; t.ldt = D; t.dst = (unsigned char*)(p.Wt_in + (size_t)win_row(32 * nb) * D + 64 * kb);
        if (IN_I8) { t.f8 = 2; t.n0 = 32 * nb; t.dst = (unsigned char*)p.Wt_in + (size_t)win_row(32 * nb) * D + 64 * kb; return t; }
        if ((IN_F8_GLU && 32 * nb < 2 * CW) || (IN_F8_FT && 32 * nb >= 2 * CW && 32 * nb < 2 * CW + FW)) { t.f8 = 1; t.dst = (unsigned char*)p.Wt_in + (32 * nb >= 2 * CW ? FT8_OFF - (size_t)(2 * CW) * D : (size_t)0) + (size_t)win_row(32 * nb) * D + 64 * kb; }
        if (GATE_F8 && 32 * nb >= 2 * CW + FW) { t.f8 = 1; t.dst = p.Wt_g8 + (size_t)(win_row(32 * nb) - (2 * CW + FW)) * D + 64 * kb; }
        return t; }
    r -= I1;
    if (r < I2) { const int kb = r / (D / 32), nb = r % (D / 32); t.src = p.cw_out + (size_t)(64 * kb) * D + 32 * nb; t.ldw = D; t.ldt = CW; t.dst = (unsigned char*)(p.Wt_conv + (size_t)(32 * nb) * CW + 64 * kb);
        if (CONV_I8) { t.f8 = 2; t.n0 = 4096 + 32 * nb; t.dst = (unsigned char*)p.Wt_conv + (size_t)(32 * nb) * CW + 64 * kb; }
        return t; }
    r -= I2;
    { const int kb = r / (D / 32), nb = r % (D / 32); t.src = p.w_out + (size_t)(64 * kb) * D + 32 * nb; t.ldw = D; t.ldt = D; t.dst = (unsigned char*)(p.Wt_out + (size_t)(32 * nb) * D + 64 * kb);
      if (OUT_F8) { t.f8 = 1; t.dst = (unsigned char*)p.Wt_out + (size_t)(32 * nb) * D + 64 * kb; } return t; }
}
__device__ __forceinline__ TItem moe_item(const P& p, int r);
__device__ __forceinline__ void phase_p0a(const Ctx& X0, const P& p) {
    Ctx X = X0; X.tid = (int)threadIdx.x; asm volatile("" : "+v"(X.tid)); X.lane = X.tid & 63;
    LAS float* scr = (LAS float*)(X.lds + X.wave * 16384);
    const int gw = X.vcu * NWAVES + X.wave, NGW = X.G * NWAVES;
#ifdef PROBE_P0A
    unsigned long long tqa_[6];
#define PA(k) do { __syncthreads(); if (X.tid == 0) tqa_[k] = __builtin_amdgcn_s_memrealtime(); } while (0)
#else
#define PA(k) do { } while (0)
#endif
    PA(0);
    constexpr int I1 = (D / 64) * (INC / 32), I2 = (CW / 64) * (D / 32), I4 = (D / 64) * (D / 32);
    const bool do_mod = X.vcu < NMOD * D / 32; const int mcol = X.tid & 31, mks = X.tid >> 5, mj0 = X.vcu * 32;
    float mw[64];
    if (do_mod) {
#pragma unroll
        for (int k = 0; k < 64; ++k) mw[k] = __builtin_nontemporal_load(p.ada_w + (size_t)(mks * 64 + k) * (NMOD * D) + mj0 + mcol); }
    const int fg = X.vcu / (D / 16), fn0 = (X.vcu % (D / 16)) * 16;
    f32x4 ftile = (f32x4){0.f, 0.f, 0.f, 0.f};
    if (X.vcu < FG * (D / 16)) ftile = *(const GAS f32x4*)(p.four_w + (size_t)(fg * FGD + (X.tid >> 2)) * D + fn0 + (X.tid & 3) * 4);
    constexpr int NITM = E * 2 * (D / 64) * (F / 32) + E * (F / 64) * (D / 32);
    LAS float* scr_bg = (LAS float*)(X.lds + 49152 + X.wave * 8448);
    f32x4 bgv[8]; TItem bgi;
#define BG_ISSUE(k) do { if (MOE_F8 && (k) < P0A_BG && X.G == 256) { bgi = moe_item(p, NITM - 1 - (gw + (k) * NGW)); titem_load(bgi, X.lane, bgv); } } while (0)
#define BG_FINISH(k) do { if (MOE_F8 && (k) < P0A_BG && X.G == 256) titem_store_f8(bgi, X.lane, bgv, scr_bg, bgi.sc); } while (0)
    BG_ISSUE(0);
    {   f32x4 va[8], vb[8]; TItem cur, nx; int it = gw;
        if (it < I1 + I2 + I4) { cur = small_item(p, it); titem_load(cur, X.lane, va); }
        while (it < I1 + I2 + I4) {
            const int nxt = it + NGW; if (nxt < I1 + I2 + I4) { nx = small_item(p, nxt); titem_load(nx, X.lane, vb); }
            if (cur.f8 == 2) titem_colmax(cur, X.lane, va, P_CMAX(p)); else if (cur.f8) titem_store_f8(cur, X.lane, va, scr, epi::W_SC); else titem_store_bf16(cur, X.lane, va, scr);
#pragma unroll
            for (int i = 0; i < 8; ++i) va[i] = vb[i];
            cur = nx; it = nxt;
        }
    }
    PA(1);
    __syncthreads();
    BG_FINISH(0); BG_ISSUE(1);
    LAS float* ct = (LAS float*)X.lds; LAS float* c128 = ct + S;
    for (int i = X.tid; i < S; i += NTHR) { float sv, cv; sincospif((float)i / (float)(S / 2), &sv, &cv); ct[i] = cv; }
    if (X.tid < FGD) { float sv, cv; sincospif((float)X.tid / 64.f, &sv, &cv); c128[X.tid] = cv; }
    __syncthreads();
    const int gt = X.vcu * NTHR + X.tid, NGT = X.G * NTHR;
    if (FFT_I8) for (int it = gt; it < 512 * 32; it += NGT) { const int r = it >> 5, c0 = (it & 31) * 16; const int part = r >> 8, k1 = r & 255, pc = c0 >> 8, s10 = c0 & 255;
        const int ph = (part == pc) ? 0 : (part == 0 ? -(S / 4) : (S / 4));
        unsigned w[4];
#pragma unroll
        for (int j = 0; j < 4; ++j) w[j] = q8_pack4(127.f * ct[(16 * k1 * (s10 + 4 * j) + ph) & (S - 1)], 127.f * ct[(16 * k1 * (s10 + 4 * j + 1) + ph) & (S - 1)], 127.f * ct[(16 * k1 * (s10 + 4 * j + 2) + ph) & (S - 1)], 127.f * ct[(16 * k1 * (s10 + 4 * j + 3) + ph) & (S - 1)]);
        *(GAS u32x4*)((unsigned char*)p.D256 + (size_t)r * 512 + c0) = (u32x4){w[0], w[1], w[2], w[3]}; }
    else for (int it = gt; it < 512 * 64; it += NGT) { const int r = it >> 6, c0 = (it & 63) * 8; const int part = r >> 8, k1 = r & 255, pc = c0 >> 8, s10 = c0 & 255;
        const int ph = (part == pc) ? 0 : (part == 0 ? -(S / 4) : (S / 4));
        unsigned w[4];
#pragma unroll
        for (int j = 0; j < 4; ++j) { const float a = ct[(16 * k1 * (s10 + 2 * j) + ph) & (S - 1)], b = ct[(16 * k1 * (s10 + 2 * j + 1) + ph) & (S - 1)]; w[j] = pk2(a, b); }
        *(GAS u32x4*)(p.D256 + (size_t)r * 512 + c0) = (u32x4){w[0], w[1], w[2], w[3]}; }
    PA(2);
    BG_FINISH(1); BG_ISSUE(2);
    {
        LAS float* wt = c128 + FGD;
        for (int it = X.vcu; it < FG * (D / 16); it += X.G) { const int g = it / (D / 16), n0 = (it % (D / 16)) * 16;
            __syncthreads();
            if (it == X.vcu) *(LAS f32x4*)(wt + 4 * X.tid) = ftile;
            else for (int i = X.tid; i < FGD * 16; i += NTHR) wt[i] = p.four_w[(size_t)(g * FGD + (i >> 4)) * D + n0 + (i & 15)];
            __syncthreads();
            const int nq = X.tid & 3, c = X.tid >> 2; int idx = 0;
            f32x4 ac = (f32x4){0.f, 0.f, 0.f, 0.f}, as = (f32x4){0.f, 0.f, 0.f, 0.f};
#pragma unroll 8
            for (int j = 0; j < FGD; ++j) { const float tc = c128[idx], ts = c128[(idx + 96) & 127];
                const f32x4 wv = *(const LAS f32x4*)(wt + j * 16 + 4 * nq); ac += wv * tc; as += wv * ts; idx = (idx + c) & 127; }
            *(GAS f32x4*)(p.W2F + (size_t)(g * FGD + c) * D + n0 + 4 * nq) = ac * 0.0013810679320049757f;
            *(GAS f32x4*)(p.W2F + (size_t)(FW + g * FGD + c) * D + n0 + 4 * nq) = as * 0.0013810679320049757f;
        }
    }
    PA(3);
    BG_FINISH(2);
    float cpre[Bn * D / NTHR];
    if (do_mod) {
#pragma unroll
        for (int n = 0; n < Bn * D / NTHR; ++n) cpre[n] = p.c[X.tid + n * NTHR]; }
    __builtin_amdgcn_sched_barrier(0);
    BG_ISSUE(3);
    __syncthreads();
    if (do_mod) {
        LAS float* cs = (LAS float*)X.lds;
        LAS float* part = cs + Bn * D;
#pragma unroll
        for (int n = 0; n < Bn * D / NTHR; ++n) cs[X.tid + n * NTHR] = siluf_(cpre[n]);
        __syncthreads();
        BG_FINISH(3); BG_ISSUE(4);
        const int col = X.tid & 31, ks = X.tid >> 5, j0 = X.vcu * 32;
        float acc[Bn];
#pragma unroll
        for (int b = 0; b < Bn; ++b) acc[b] = 0.f;
#pragma unroll
        for (int k = 0; k < 64; ++k)
#pragma unroll
            for (int b = 0; b < Bn; ++b) acc[b] += cs[b * D + ks * 64 + k] * mw[k];
#pragma unroll
        for (int b = 0; b < Bn; ++b) part[(ks * Bn + b) * 32 + col] = acc[b];
        BG_FINISH(4); BG_ISSUE(5);
        __syncthreads();
        if (X.tid < Bn * 32) { const int b = X.tid >> 5, cc = X.tid & 31; float s = p.ada_b[j0 + cc];
#pragma unroll
            for (int k2 = 0; k2 < 16; ++k2) s += part[(k2 * Bn + b) * 32 + cc];
            p.MOD[b * NMOD * D + j0 + cc] = s; }
        BG_FINISH(5);
    } else {
        BG_FINISH(3); BG_ISSUE(4); BG_FINISH(4); BG_ISSUE(5); BG_FINISH(5);
        if (P0A_IDLE && MOE_F8 && X.G == 256) {
            constexpr int RI = NITM - P0A_BG * 2048 - (TOPK_BG ? TOPK_BG_ITEMS : 0) - P0A_IDLE_ITEMS, NWI = (256 - NMOD * D / 32) * NWAVES;
            static_assert(P0A_IDLE_ITEMS % ((256 - NMOD * D / 32) * NWAVES) == 0, "donated items: whole rounds of the idle waves");
            const int iw = (X.vcu - NMOD * D / 32) * NWAVES + X.wave;
            f32x4 xa[8], xb[8]; TItem ci, ni;
            ci = moe_item(p, RI + iw); titem_load(ci, X.lane, xa);
            for (int j = 0; j < P0A_IDLE_ITEMS / NWI; ++j) {
                if (j + 1 < P0A_IDLE_ITEMS / NWI) { ni = moe_item(p, RI + iw + (j + 1) * NWI); titem_load(ni, X.lane, xb); }
                titem_store_f8(ci, X.lane, xa, scr_bg, ci.sc);
#pragma unroll
                for (int i = 0; i < 8; ++i) xa[i] = xb[i];
                ci = ni;
            }
        }
    }
#undef BG_ISSUE
#undef BG_FINISH
    PA(4);
#ifdef PROBE_P0A
    if (X.tid == 0) ((LAS unsigned long long*)(X.lds + 139264))[1] = tqa_[PROBE_P0A + 1] - tqa_[PROBE_P0A];
#endif
#undef PA
}

__device__ __forceinline__ float row_load_rstd(const float* xr, int lane, f32x4 (&v)[4]) {
    float ss = 0.f;
#pragma unroll
    for (int j = 0; j < 2; ++j) { v[2 * j] = *(const GAS f32x4*)(xr + 8 * lane + 512 * j); v[2 * j + 1] = *(const GAS f32x4*)(xr + 8 * lane + 512 * j + 4); }
#pragma unroll
    for (int q = 0; q < 4; ++q) ss += (v[q][0] * v[q][0] + v[q][1] * v[q][1]) + (v[q][2] * v[q][2] + v[q][3] * v[q][3]);
    return 1.f / sqrtf(wave_sum(ss) * (1.f / D) + 1e-6f);
}
__device__ __forceinline__ void row_issue(const float* xr, int lane, f32x4 (&v)[4]) {
#pragma unroll
    for (int j = 0; j < 4; ++j) v[j] = __builtin_nontemporal_load((const GAS f32x4*)(xr + 4 * lane + 256 * j));
}
__device__ __forceinline__ float row_rstd(const f32x4 (&v)[4]) {
    float ss = 0.f;
#pragma unroll
    for (int q = 0; q < 4; ++q) ss += (v[q][0] * v[q][0] + v[q][1] * v[q][1]) + (v[q][2] * v[q][2] + v[q][3] * v[q][3]);
    return 1.f / sqrtf(wave_sum(ss) * (1.f / D) + 1e-6f);
}
__device__ __forceinline__ TItem moe_item(const P& p, int r) {
    constexpr int I5 = (D / 64) * (F / 32), I6 = (F / 64) * (D / 32);
    TItem t; t.f8 = 1; t.n0 = 0; t.sc = epi::W_SC;
    if (r < E * 2 * I5) { const int eh = r / I5, q = r % I5, e = eh >> 1, half = eh & 1; const int kb = q / (F / 32), nb = q % (F / 32), n0 = 32 * nb;
        t.src = (half ? p.w_up : p.w_gate) + (size_t)e * D * F + (size_t)(64 * kb) * F + n0; t.ldw = F; t.ldt = D;
        if (SWIGLU_FOLD) t.sc = half ? epi::W_SC * epi::ACT_SC * 0.6931471805599453f : epi::W_SC * 1.4426950408889634f;
        t.dst = (unsigned char*)p.Wt_gu + (size_t)e * 2 * F * D + (size_t)(256 * (n0 / 128) + 128 * half + (n0 % 128)) * D + 64 * kb; }
    else { r -= E * 2 * I5; const int e = r / I6, q = r % I6; const int kb = q / (D / 32), nb = q % (D / 32);
        t.src = p.w_down + (size_t)e * F * D + (size_t)(64 * kb) * D + 32 * nb; t.ldw = D; t.ldt = F;
        t.dst = (unsigned char*)p.Wt_down + (size_t)e * D * F + (size_t)(32 * nb) * F + 64 * kb; }
    return t;
}
__device__ __forceinline__ void phase_p0b(const Ctx& X0, const P& p) {
    Ctx X = X0; X.tid = (int)threadIdx.x; asm volatile("" : "+v"(X.tid)); X.lane = X.tid & 63;
    const int gw = X.vcu * NWAVES + X.wave, NGW = X.G * NWAVES;
#ifdef PROBE_SUB
    LAS unsigned long long* dbg_ = (LAS unsigned long long*)(X.lds + 139264); unsigned long long tq_[4];
#define PSUB(k) do { __syncthreads(); if (X.tid == 0) tq_[k] = __builtin_amdgcn_s_memrealtime(); } while (0)
#else
#define PSUB(k) do { } while (0)
#endif
    PSUB(0);
    {
        const int RPW = T / X.G, base = X.vcu * RPW; const float* md = p.MOD + (size_t)(base >> 12) * NMOD * D;
        f32x4 av[4], sv[4];
#pragma unroll
        for (int j = 0; j < 4; ++j) { const int c0 = 4 * X.lane + 256 * j; av[j] = *(const f32x4*)(p.norm1_g + c0) * (*(const f32x4*)(md + D + c0) + 1.f); sv[j] = *(const f32x4*)(md + c0); }
        f32x4 v[4], vn[4], vn2[4]; int i = X.wave; if (i < RPW) row_issue(p.x + (size_t)(base + i) * D, X.lane, v);
        if (i + NWAVES < RPW) row_issue(p.x + (size_t)(base + i + NWAVES) * D, X.lane, vn);
        for (; i < RPW; i += NWAVES) {
            const int m = base + i, in2 = i + 2 * NWAVES; if (in2 < RPW) row_issue(p.x + (size_t)(base + in2) * D, X.lane, vn2);
            const float rstd = row_rstd(v);
            f32x4 ov[4];
#pragma unroll
            for (int j = 0; j < 4; ++j) { const int c0 = 4 * X.lane + 256 * j; const f32x4 o = v[j] * rstd * av[j] + sv[j];
                if (!IN_F8 && !IN_I8) *(GAS u32x2*)(p.U + (size_t)m * D + c0) = (u32x2){cvt_pk_bf16(o[0], o[1]), cvt_pk_bf16(o[2], o[3])};
                if (IN_I8) ov[j] = o;
                else if (GATE_F8) { unsigned q8 = 0u; q8 = __builtin_amdgcn_cvt_pk_fp8_f32(o[0] * epi::U_SC, o[1] * epi::U_SC, q8, false); q8 = __builtin_amdgcn_cvt_pk_fp8_f32(o[2] * epi::U_SC, o[3] * epi::U_SC, q8, true);
                    *(GAS unsigned*)(p.U8X + (size_t)m * D + c0) = q8; } }
            if (IN_I8) {
                float am = 0.f;
#pragma unroll
                for (int j = 0; j < 4; ++j) am = fmaxf(fmaxf(am, fmaxf(fabsf(ov[j][0]), fabsf(ov[j][1]))), fmaxf(fabsf(ov[j][2]), fabsf(ov[j][3])));
#pragma unroll
                for (int o = 1; o < 64; o <<= 1) am = fmaxf(am, __shfl_xor(am, o));
                const float inv = am > 0.f ? 127.f / am : 0.f;
#pragma unroll
                for (int j = 0; j < 4; ++j) *(GAS unsigned*)(p.U8X + (size_t)m * D + 4 * X.lane + 256 * j) = q8_pack4(ov[j][0] * inv, ov[j][1] * inv, ov[j][2] * inv, ov[j][3] * inv);
                if (X.lane == 0) P_USC(p)[m] = am * (1.f / 127.f); }
#pragma unroll
            for (int q = 0; q < 4; ++q) { v[q] = vn[q]; vn[q] = vn2[q]; }
        }
    }
    PSUB(1);
    LAS float* scr = (LAS float*)(X.lds + X.wave * 16384);
    constexpr int NIT = E * 2 * (D / 64) * (F / 32) + E * (F / 64) * (D / 32);
    PSUB(2);
#if MOE_F8
    {
        constexpr int IS1 = IN_I8 ? (D / 64) * (INC / 32) : 0, IS2 = CONV_I8 ? (CW / 64) * (D / 32) : 0, IS3 = (D / 64) * (D / 32), ISM = IS1 + IS2 + IS3;
        const int NALL = ISM + NIT - ((MOE_F8 && X.G == 256) ? P0A_BG * 2048 + (TOPK_BG ? TOPK_BG_ITEMS : 0) + (P0A_IDLE ? P0A_IDLE_ITEMS : 0) : 0);
        static_assert(IN_I8 || !CONV_I8, "the unified P0b item stream takes cw_out items only together with the w_in items");
        auto item_of = [&](int r) -> TItem {
            if (r < IS1 + IS2) return small_item(p, r);
            if (r < ISM) { const int q = r - IS1 - IS2, kb = q / (D / 32), nb = q % (D / 32); TItem t; t.f8 = 0; t.n0 = 0; t.src = p.W2F + (size_t)(64 * kb) * D + 32 * nb; t.ldw = D; t.ldt = D; t.dst = (unsigned char*)(p.Wt_four + (size_t)(32 * nb) * D + 64 * kb); return t; }
            return moe_item(p, r - ISM); };
        f32x4 va[8], vb[8], vc[8]; TItem cur, nx, nx2; int it = gw;
        if (it < NALL) { cur = item_of(it); titem_load(cur, X.lane, va); }
        if (it + NGW < NALL) { nx = item_of(it + NGW); titem_load(nx, X.lane, vb); }
        while (it < NALL) {
            const int n2 = it + 2 * NGW; if (n2 < NALL) { nx2 = item_of(n2); titem_load(nx2, X.lane, vc); }
            if (cur.f8 == 1) titem_store_f8(cur, X.lane, va, scr, cur.sc);
            else if (cur.f8 == 2) { float* wp = nullptr; if (it < INC / 32) wp = P_WSC(p) + win_row(cur.n0); else if (it >= IS1 && it < IS1 + D / 32) wp = P_WSC(p) + cur.n0;
                titem_store_i8(cur, X.lane, va, scr, P_CMAX(p), wp); }
            else titem_store_bf16(cur, X.lane, va, scr);
#pragma unroll
            for (int i = 0; i < 8; ++i) { va[i] = vb[i]; vb[i] = vc[i]; }
            cur = nx; nx = nx2; it += NGW;
        }
    }
#else
    constexpr int I5 = (D / 64) * (F / 32), I6 = (F / 64) * (D / 32);
    for (int it = gw; it < NIT; it += NGW) { int r = it;
        if (r < E * 2 * I5) { const int eh = r / I5, q = r % I5, e = eh >> 1, half = eh & 1; const int kb = q / (F / 32), nb = q % (F / 32), n0 = 32 * nb;
            transpose_item((half ? p.w_up : p.w_gate) + (size_t)e * D * F, F, 64 * kb, n0, p.Wt_gu + (size_t)e * 2 * F * D, D, 256 * (n0 / 128) + 128 * half + (n0 % 128), scr, X.lane); continue; } r -= E * 2 * I5;
        { const int e = r / I6, q = r % I6; const int kb = q / (D / 32), nb = q % (D / 32);
            transpose_item(p.w_down + (size_t)e * F * D, D, 64 * kb, 32 * nb, p.Wt_down + (size_t)e * D * F, F, 32 * nb, scr, X.lane); } }
#endif
    PSUB(3);
#ifdef PROBE_SUB
    if (X.tid == 0) dbg_[1] = tq_[PROBE_SUB + 1] - tq_[PROBE_SUB];
#endif
#undef PSUB
}

__device__ __forceinline__ void dft16_real(const float (&x)[16], float (&gr)[16], float (&gi)[16]) {
    constexpr float WR[10] = {1.f, 0.92387953251128674f, 0.70710678118654752f, 0.38268343236508977f, 0.f, -0.38268343236508977f, -0.70710678118654752f, -0.92387953251128674f, -1.f, -0.92387953251128674f};
    constexpr float WI[10] = {0.f, -0.38268343236508977f, -0.70710678118654752f, -0.92387953251128674f, -1.f, -0.92387953251128674f, -0.70710678118654752f, -0.38268343236508977f, 0.f, 0.38268343236508977f};
    float zr[4][4], zi[4][4];
#pragma unroll
    for (int b = 0; b < 4; ++b) { const float x0 = x[b], x1 = x[4 + b], x2 = x[8 + b], x3 = x[12 + b];
        const float s02 = x0 + x2, d02 = x0 - x2, s13 = x1 + x3, d13 = x1 - x3;
        const float yr[4] = {s02 + s13, d02, s02 - s13, d02}, yi[4] = {0.f, -d13, 0.f, d13};
#pragma unroll
        for (int c = 0; c < 4; ++c) { const float wr = WR[b * c], wi = WI[b * c]; zr[b][c] = yr[c] * wr - yi[c] * wi; zi[b][c] = yr[c] * wi + yi[c] * wr; } }
#pragma unroll
    for (int c = 0; c < 4; ++c) {
        const float ar = zr[0][c] + zr[2][c], ai = zi[0][c] + zi[2][c], br = zr[0][c] - zr[2][c], bi = zi[0][c] - zi[2][c];
        const float cr = zr[1][c] + zr[3][c], ci = zi[1][c] + zi[3][c], dr = zr[1][c] - zr[3][c], di = zi[1][c] - zi[3][c];
        gr[c] = ar + cr;      gi[c] = ai + ci;
        gr[c + 4] = br + di;  gi[c + 4] = bi - dr;
        gr[c + 8] = ar - cr;  gi[c + 8] = ai - ci;
        gr[c + 12] = br - di; gi[c + 12] = bi + dr;
    }
}
__device__ __forceinline__ void phase_conv(const Ctx& X0, const P& p) {
    Ctx X = X0; X.tid = (int)threadIdx.x; asm volatile("" : "+v"(X.tid)); X.lane = X.tid & 63;
    constexpr int CH = 32, ROWS = CH + CK - 1;
    LAS unsigned char* rows = X.lds;
    LAS float* wl = (LAS float*)(X.lds + ROWS * 1024);
    for (int i = X.tid; i < CK * CW; i += NTHR) { const int k = i / CW, ch = i % CW; const int ln = ch >> 3, q = (ch >> 2) & 1, r = ch & 3; wl[((k * 2 + q) * 64 + ln) * 4 + r] = p.dw_w[i]; }
    const int lane = X.lane, w = X.wave;
    f32x4 db[2], lg[2], lb[2];
#pragma unroll
    for (int h = 0; h < 2; ++h) { db[h] = *(const f32x4*)(p.dw_b + 8 * lane + 4 * h); lg[h] = *(const f32x4*)(p.cln_g + 8 * lane + 4 * h); lb[h] = *(const f32x4*)(p.cln_b + 8 * lane + 4 * h); }
    u32x4 pre[8];
#define CV_LOAD(chk) do { const int t0_ = (chk) * CH, b_ = t0_ >> 12, s0_ = t0_ & (S - 1); _Pragma("unroll") for (int q = 0; q < 8; ++q) { const int i = X.tid + q * NTHR, r = i >> 6, cseg = i & 63, s = s0_ + r - CK / 2; \
        pre[q] = (u32x4){0u, 0u, 0u, 0u}; if (i < ROWS * 64 && s >= 0 && s < S) pre[q] = *(const GAS u32x4*)(p.V + ((size_t)(b_ * S + s)) * CW + cseg * 8); } } while (0)
    if (X.vcu < T / CH) CV_LOAD(X.vcu);
    for (int chunk = X.vcu; chunk < T / CH; chunk += X.G) {
        const int t0 = chunk * CH;
        __syncthreads();
#pragma unroll
        for (int q = 0; q < 8; ++q) { const int i = X.tid + q * NTHR; if (i < ROWS * 64) *(LAS u32x4*)(rows + (i >> 6) * 1024 + (i & 63) * 16) = pre[q]; }
        if (chunk + X.G < T / CH) CV_LOAD(chunk + X.G);
        __syncthreads();
        f32x4 acc[4][2]; int zo = 0; asm volatile("" : "+v"(zo));
#pragma unroll
        for (int j = 0; j < 4; ++j) { acc[j][0] = db[0]; acc[j][1] = db[1]; }
#pragma unroll
        for (int rr = 0; rr < CK + 3; ++rr) {
            const u32x4 rv = *(const LAS u32x4*)(rows + (4 * w + rr) * 1024 + lane * 16); f32x4 a0, a1; epi::unpack8(rv, a0, a1);
#pragma unroll
            for (int j = 0; j < 4; ++j) { const int k = rr - j;
                if (k >= 0 && k < CK) { const f32x4 w0 = *(const LAS f32x4*)(wl + ((k * 2 + 0) * 64 + lane + zo) * 4), w1 = *(const LAS f32x4*)(wl + ((k * 2 + 1) * 64 + lane + zo) * 4);
                    acc[j][0] += a0 * w0; acc[j][1] += a1 * w1; } }
        }
#pragma unroll
        for (int j = 0; j < 4; ++j) {
            const f32x4 a0 = acc[j][0], a1 = acc[j][1];
            const float mu = wave_sum((a0[0] + a0[1]) + (a0[2] + a0[3]) + (a1[0] + a1[1]) + (a1[2] + a1[3])) * (1.f / CW);
            const f32x4 d0 = a0 - mu, d1 = a1 - mu;
            const float var = wave_sum((d0[0] * d0[0] + d0[1] * d0[1]) + (d0[2] * d0[2] + d0[3] * d0[3]) + (d1[0] * d1[0] + d1[1] * d1[1]) + (d1[2] * d1[2] + d1[3] * d1[3])) * (1.f / CW);
            const float rstd = 1.f / sqrtf(var + 1e-5f);
            const f32x4 z0 = d0 * rstd * lg[0] + lb[0], z1 = d1 * rstd * lg[1] + lb[1];
            if (CONV_I8) { const f32x4 q0 = epi::silu4(z0), q1 = epi::silu4(z1);
                float am = fmaxf(fmaxf(fmaxf(fabsf(q0[0]), fabsf(q0[1])), fmaxf(fabsf(q0[2]), fabsf(q0[3]))), fmaxf(fmaxf(fabsf(q1[0]), fabsf(q1[1])), fmaxf(fabsf(q1[2]), fabsf(q1[3]))));
#pragma unroll
                for (int of = 1; of < 64; of <<= 1) am = fmaxf(am, __shfl_xor(am, of));
                const float inv = am > 0.f ? 127.f / am : 0.f;
                *(GAS u32x2*)((unsigned char*)p.ACONV + (size_t)(t0 + 4 * w + j) * CW + 8 * lane) = (u32x2){q8_pack4(q0[0] * inv, q0[1] * inv, q0[2] * inv, q0[3] * inv), q8_pack4(q1[0] * inv, q1[1] * inv, q1[2] * inv, q1[3] * inv)};
                P_ASC(p)[t0 + 4 * w + j] = am * (1.f / 127.f); }
            else *(GAS u32x4*)(p.ACONV + (size_t)(t0 + 4 * w + j) * CW + 8 * lane) = epi::pack8(epi::silu4(z0), epi::silu4(z1));
        }
    }
#undef CV_LOAD
    __syncthreads();
}
__device__ __forceinline__ void phase_convfft(const Ctx& X0, const P& p) {
    Ctx X = X0; X.tid = (int)threadIdx.x; asm volatile("" : "+v"(X.tid)); X.lane = X.tid & 63;
    constexpr int CH = 32, ROWS = CH + CK - 1;
#ifdef PROBE_CV
    unsigned long long tcs_ = 0; if (X.tid == 0) tcs_ = __builtin_amdgcn_s_memrealtime();
#endif
    LAS unsigned char* rows = X.lds;
    LAS float* wl = (LAS float*)(X.lds + ROWS * 1024);
    static_assert(CK * CW == 31 * NTHR, "tap table: 31 values per thread");
    float twv[31];
#pragma unroll
    for (int n = 0; n < 31; ++n) twv[n] = p.dw_w[X.tid + n * NTHR];
    __builtin_amdgcn_sched_barrier(0);
    const int lane = X.lane, w = X.wave;
    const int chl = X.tid >> 7, sp = X.tid & 127;
    unsigned fpre[16];
#define FA_LOAD(itm) do { const bf16_t* src_ = p.FT + ((size_t)(((itm) >> 7) * FW + ((itm) & 127) * 4 + chl) * S + 2 * sp); _Pragma("unroll") for (int s2 = 0; s2 < 16; ++s2) fpre[s2] = *(const GAS unsigned*)(src_ + 256 * s2); } while (0)
    if (X.vcu < Bn * (FW / 4)) FA_LOAD(X.vcu);
    f32x4 db[2], lg[2], lb[2];
#pragma unroll
    for (int h = 0; h < 2; ++h) { db[h] = *(const f32x4*)(p.dw_b + 8 * lane + 4 * h); lg[h] = *(const f32x4*)(p.cln_g + 8 * lane + 4 * h); lb[h] = *(const f32x4*)(p.cln_b + 8 * lane + 4 * h); }
    u32x4 pre[8];
#define CV_LOAD(chk) do { const int t0_ = (chk) * CH, b_ = t0_ >> 12, s0_ = t0_ & (S - 1); _Pragma("unroll") for (int q = 0; q < 8; ++q) { const int i = X.tid + q * NTHR, r = i >> 6, cseg = i & 63, s = s0_ + r - CK / 2; \
        pre[q] = (u32x4){0u, 0u, 0u, 0u}; if (i < ROWS * 64 && s >= 0 && s < S) pre[q] = *(const GAS u32x4*)(p.V + ((size_t)(b_ * S + s)) * CW + cseg * 8); } } while (0)
    if (X.vcu < T / CH) CV_LOAD(X.vcu);
    __builtin_amdgcn_sched_barrier(0);
#pragma unroll
    for (int n = 0; n < 31; ++n) { const int i = X.tid + n * NTHR, k = i / CW, ch = i % CW; const int ln = ch >> 3, q = (ch >> 2) & 1, r = ch & 3; wl[((k * 2 + q) * 64 + ln) * 4 + r] = twv[n]; }
#ifdef PROBE_CV
    unsigned long long tcv_[4] = {0ull, 0ull, 0ull, 0ull}, tc0_ = 0;
#define PCV(k) do { if (X.tid == 0) { const unsigned long long n_ = __builtin_amdgcn_s_memrealtime(); tcv_[k] += n_ - tc0_; tc0_ = n_; } } while (0)
    if (X.tid == 0) { tc0_ = __builtin_amdgcn_s_memrealtime(); tcv_[3] = tc0_ - tcs_; }
#else
#define PCV(k) do { } while (0)
#endif
    for (int chunk = X.vcu; chunk < T / CH; chunk += X.G) {
        const int t0 = chunk * CH;
        __syncthreads();
#pragma unroll
        for (int q = 0; q < 8; ++q) { const int i = X.tid + q * NTHR; if (i < ROWS * 64) *(LAS u32x4*)(rows + (i >> 6) * 1024 + (i & 63) * 16) = pre[q]; }
        __syncthreads();
        PCV(0);
        f32x4 acc[4][2]; int zo = 0; asm volatile("" : "+v"(zo));
#pragma unroll
        for (int j = 0; j < 4; ++j) { acc[j][0] = db[0]; acc[j][1] = db[1]; }
#pragma unroll
        for (int rr = 0; rr < CK + 3; ++rr) {
            const u32x4 rv = *(const LAS u32x4*)(rows + (4 * w + rr) * 1024 + lane * 16); f32x4 a0, a1; epi::unpack8(rv, a0, a1);
#pragma unroll
            for (int j = 0; j < 4; ++j) { const int k = rr - j;
                if (k >= 0 && k < CK) { const f32x4 w0 = *(const LAS f32x4*)(wl + ((k * 2 + 0) * 64 + lane + zo) * 4), w1 = *(const LAS f32x4*)(wl + ((k * 2 + 1) * 64 + lane + zo) * 4);
                    acc[j][0] += a0 * w0; acc[j][1] += a1 * w1; } }
        }
#pragma unroll
        for (int j = 0; j < 4; ++j) {
            const f32x4 a0 = acc[j][0], a1 = acc[j][1];
            const float mu = wave_sum((a0[0] + a0[1]) + (a0[2] + a0[3]) + (a1[0] + a1[1]) + (a1[2] + a1[3])) * (1.f / CW);
            const f32x4 d0 = a0 - mu, d1 = a1 - mu;
            const float var = wave_sum((d0[0] * d0[0] + d0[1] * d0[1]) + (d0[2] * d0[2] + d0[3] * d0[3]) + (d1[0] * d1[0] + d1[1] * d1[1]) + (d1[2] * d1[2] + d1[3] * d1[3])) * (1.f / CW);
            const float rstd = 1.f / sqrtf(var + 1e-5f);
            const f32x4 z0 = d0 * rstd * lg[0] + lb[0], z1 = d1 * rstd * lg[1] + lb[1];
            if (CONV_I8) { const f32x4 q0 = epi::silu4(z0), q1 = epi::silu4(z1);
                float am = fmaxf(fmaxf(fmaxf(fabsf(q0[0]), fabsf(q0[1])), fmaxf(fabsf(q0[2]), fabsf(q0[3]))), fmaxf(fmaxf(fabsf(q1[0]), fabsf(q1[1])), fmaxf(fabsf(q1[2]), fabsf(q1[3]))));
#pragma unroll
                for (int of = 1; of < 64; of <<= 1) am = fmaxf(am, __shfl_xor(am, of));
                const float inv = am > 0.f ? 127.f / am : 0.f;
                *(GAS u32x2*)((unsigned char*)p.ACONV + (size_t)(t0 + 4 * w + j) * CW + 8 * lane) = (u32x2){q8_pack4(q0[0] * inv, q0[1] * inv, q0[2] * inv, q0[3] * inv), q8_pack4(q1[0] * inv, q1[1] * inv, q1[2] * inv, q1[3] * inv)};
                P_ASC(p)[t0 + 4 * w + j] = am * (1.f / 127.f); }
            else *(GAS u32x4*)(p.ACONV + (size_t)(t0 + 4 * w + j) * CW + 8 * lane) = epi::pack8(epi::silu4(z0), epi::silu4(z1));
        }
        __builtin_amdgcn_sched_barrier(0);
        PCV(1);
        if (chunk + X.G < T / CH) CV_LOAD(chunk + X.G);
        {
            const int it = chunk; if (it < Bn * (FW / 4)) {
            const int fb = it >> 7, ch = (it & 127) * 4 + chl; int spo = sp; asm volatile("" : "+v"(spo));
            float xa[16], xb[16];
#pragma unroll
            for (int s2 = 0; s2 < 16; ++s2) { const unsigned wv = fpre[s2]; xa[s2] = bf_lo(wv); xb[s2] = bf_hi(wv); }
            if (it + X.G < Bn * (FW / 4)) FA_LOAD(it + X.G);
            float gar[16], gai[16], gbr[16], gbi[16];
            dft16_real(xa, gar, gai); dft16_real(xb, gbr, gbi);
            if (FFT_I8) {
                float o[16][4]; float am = 0.f;
#pragma unroll
                for (int k2 = 0; k2 < 16; ++k2) {
                    const int kk = k2 <= 8 ? k2 : 16 - k2; const float sgn = k2 <= 8 ? 1.f : -1.f;
                    const float ar = gar[kk], ai = sgn * gai[kk], br = gbr[kk], bi = sgn * gbi[kk];
                    const float fa = (float)((2 * spo * k2) & (S - 1)) * (1.f / S), fb2 = (float)(((2 * spo + 1) * k2) & (S - 1)) * (1.f / S);
                    const float tca = __builtin_amdgcn_cosf(fa), tsa = __builtin_amdgcn_sinf(fa), tcb = __builtin_amdgcn_cosf(fb2), tsb = __builtin_amdgcn_sinf(fb2);
                    o[k2][0] = ar * tca + ai * tsa; o[k2][1] = br * tcb + bi * tsb; o[k2][2] = ai * tca - ar * tsa; o[k2][3] = bi * tcb - br * tsb;
                    am = fmaxf(fmaxf(am, fmaxf(fabsf(o[k2][0]), fabsf(o[k2][1]))), fmaxf(fabsf(o[k2][2]), fabsf(o[k2][3]))); }
#pragma unroll
                for (int of = 1; of < 64; of <<= 1) am = fmaxf(am, __shfl_xor(am, of));
                LAS float* mx = (LAS float*)(X.lds + 130048);
                if (lane == 0) mx[w] = am;
                __syncthreads();
                am = fmaxf(mx[2 * chl], mx[2 * chl + 1]);
                const float inv = am > 0.f ? 127.f / am : 0.f;
                if (sp == 0) P_GSC(p)[fb * FW + ch] = am * (1.f / 127.f);
#pragma unroll
                for (int k2 = 0; k2 < 16; ++k2) { unsigned char* dst = (unsigned char*)p.GP + ((size_t)((fb * 16 + k2) * FW + ch) * 512 + 2 * spo);
                    unsigned wre = 0u, wim = 0u; wre = q8_put(o[k2][0] * inv, 0, wre); wre = q8_put(o[k2][1] * inv, 1, wre); wim = q8_put(o[k2][2] * inv, 0, wim); wim = q8_put(o[k2][3] * inv, 1, wim);
                    *(GAS unsigned short*)dst = (unsigned short)(wre ^ 0x8080u); *(GAS unsigned short*)(dst + 256) = (unsigned short)(wim ^ 0x8080u); }
            } else {
#pragma unroll
            for (int k2 = 0; k2 < 16; ++k2) {
                const int kk = k2 <= 8 ? k2 : 16 - k2; const float sgn = k2 <= 8 ? 1.f : -1.f;
                const float ar = gar[kk], ai = sgn * gai[kk], br = gbr[kk], bi = sgn * gbi[kk];
                const float fa = (float)((2 * spo * k2) & (S - 1)) * (1.f / S), fb2 = (float)(((2 * spo + 1) * k2) & (S - 1)) * (1.f / S);
                const float tca = __builtin_amdgcn_cosf(fa), tsa = __builtin_amdgcn_sinf(fa), tcb = __builtin_amdgcn_cosf(fb2), tsb = __builtin_amdgcn_sinf(fb2);
                const float gra = ar * tca + ai * tsa, gia = ai * tca - ar * tsa, grb = br * tcb + bi * tsb, gib = bi * tcb - br * tsb;
                bf16_t* dst = p.GP + ((size_t)((fb * 16 + k2) * FW + ch) * 512 + 2 * spo);
                *(GAS unsigned*)dst = cvt_pk_bf16(gra, grb); *(GAS unsigned*)(dst + 256) = cvt_pk_bf16(gia, gib);
            } }
            }
        }
        PCV(2);
    }
#ifdef PROBE_CV
    if (X.tid == 0) ((LAS unsigned long long*)(X.lds + 139264))[1] = tcv_[PROBE_CV];
#endif
#undef PCV
#undef FA_LOAD
#undef CV_LOAD
    __syncthreads();
}


__device__ __forceinline__ void phase_fftA(const Ctx& X0, const P& p) {
    Ctx X = X0; X.tid = (int)threadIdx.x; asm volatile("" : "+v"(X.tid)); X.lane = X.tid & 63;
    LAS float* ct = (LAS float*)X.lds;
    for (int i = X.tid; i < S; i += NTHR) { float sv, cv; sincospif((float)i / (float)(S / 2), &sv, &cv); ct[i] = cv; }
    __syncthreads();
    constexpr float C16[16] = {1.f, 0.92387953251128674f, 0.70710678118654752f, 0.38268343236508977f, 0.f, -0.38268343236508977f, -0.70710678118654752f, -0.92387953251128674f,
                               -1.f, -0.92387953251128674f, -0.70710678118654752f, -0.38268343236508977f, 0.f, 0.38268343236508977f, 0.70710678118654752f, 0.92387953251128674f};
    const int chl = X.tid >> 7, sp = X.tid & 127;
    unsigned pre[16];
#define FA_LOAD(itm) do { const bf16_t* src_ = p.FT + ((size_t)(((itm) >> 7) * FW + ((itm) & 127) * 4 + chl) * S + 2 * sp); _Pragma("unroll") for (int s2 = 0; s2 < 16; ++s2) pre[s2] = *(const GAS unsigned*)(src_ + 256 * s2); } while (0)
    if (X.vcu < Bn * (FW / 4)) FA_LOAD(X.vcu);
    for (int it = X.vcu; it < Bn * (FW / 4); it += X.G) {
        const int b = it >> 7, ch = (it & 127) * 4 + chl;
        float xa[16], xb[16];
#pragma unroll
        for (int s2 = 0; s2 < 16; ++s2) { const unsigned w = pre[s2]; xa[s2] = bf_lo(w); xb[s2] = bf_hi(w); }
        if (it + X.G < Bn * (FW / 4)) FA_LOAD(it + X.G);
        float gar[16], gai[16], gbr[16], gbi[16];
        dft16_real(xa, gar, gai); dft16_real(xb, gbr, gbi);
#pragma unroll
        for (int k2 = 0; k2 < 16; ++k2) {
            const float ar = gar[k2], ai = gai[k2], br = gbr[k2], bi = gbi[k2];
            const int ia = (2 * sp * k2) & (S - 1), ib = ((2 * sp + 1) * k2) & (S - 1);
            const float tca = ct[ia], tsa = ct[(ia - S / 4) & (S - 1)], tcb = ct[ib], tsb = ct[(ib - S / 4) & (S - 1)];
            const float gra = ar * tca + ai * tsa, gia = ai * tca - ar * tsa, grb = br * tcb + bi * tsb, gib = bi * tcb - br * tsb;
            bf16_t* dst = p.GP + ((size_t)((b * 16 + k2) * FW + ch) * 512 + 2 * sp);
            *(GAS unsigned*)dst = cvt_pk_bf16(gra, grb); *(GAS unsigned*)(dst + 256) = cvt_pk_bf16(gia, gib);
        }
    }
    __syncthreads();
}

template <class BarF>
__device__ __forceinline__ void phase_router(const Ctx& X0, const P& p, const float* H, BarF bar) {
    Ctx X = X0; X.tid = (int)threadIdx.x; asm volatile("" : "+v"(X.tid)); X.lane = X.tid & 63;
#ifdef PROBE_RT
    unsigned long long trs_ = 0; if (X.tid == 0) trs_ = __builtin_amdgcn_s_memrealtime();
#endif
    LAS float* GP = (LAS float*)X.lds;
    LAS float* SH = GP + D;
    LAS f32x4* ACCP = (LAS f32x4*)(SH + D);
    LAS float* SSP = (LAS float*)(ACCP + 2 * 8 * 64);
    LAS float* CE = SSP + 2 * 8 * 16;
    const int lane = X.lane, w = X.wave, r = lane & 15, kq = lane >> 4;
    constexpr int NG = T / 16, GPW = NG / 256;
    const int g0 = X.vcu * GPW, b = (g0 * 16) >> 12;
    const float* md = p.MOD + (size_t)b * NMOD * D;
    f32x4 a[4][2], vn[4][2];
    const int cbase = 128 * w + 8 * kq;
#if H_DELTA
#define RT_ISSUE(dst, grp) do { const size_t ro_ = ((size_t)(grp) * 16 + r) * D + cbase; const float* rp = H + ro_; const bf16_t* dp = p.DELTA + ro_; _Pragma("unroll") for (int s = 0; s < 4; ++s) { \
        const u32x4 dw_ = *(const GAS u32x4*)(dp + 32 * s); f32x4 d0_, d1_; epi::unpack8(dw_, d0_, d1_); dst[s][0] = *(const GAS f32x4*)(rp + 32 * s) + d0_; dst[s][1] = *(const GAS f32x4*)(rp + 32 * s + 4) + d1_; } } while (0)
#else
#define RT_ISSUE(dst, grp) do { const float* rp = H + ((size_t)(grp) * 16 + r) * D + cbase; _Pragma("unroll") for (int s = 0; s < 4; ++s) { dst[s][0] = *(const GAS f32x4*)(rp + 32 * s); dst[s][1] = *(const GAS f32x4*)(rp + 32 * s + 4); } } while (0)
#endif
    float rw[4][4][2];
#pragma unroll
    for (int s = 0; s < 4; ++s)
#pragma unroll
        for (int j = 0; j < 4; ++j) { const int d = 32 * (4 * w + s) + 8 * kq + 2 * j; rw[s][j][0] = p.router_w[(size_t)d * E + r]; rw[s][j][1] = p.router_w[(size_t)(d + 1) * E + r]; }
    float gs[D / NTHR][3]; f32x4 cw[D / NTHR][4];
#pragma unroll
    for (int h = 0; h < D / NTHR; ++h) { const int d = X.tid + h * NTHR; gs[h][0] = p.norm2_g[d]; gs[h][1] = md[4 * D + d]; gs[h][2] = md[3 * D + d];
#pragma unroll
        for (int q = 0; q < 4; ++q) cw[h][q] = ((const f32x4*)(p.router_w + (size_t)d * E))[q]; }
    __builtin_amdgcn_sched_barrier(0);
    __builtin_amdgcn_sched_barrier(0);
#pragma unroll
    for (int h = 0; h < D / NTHR; ++h) { const int d = X.tid + h * NTHR; GP[d] = gs[h][0] * (1.f + gs[h][1]); SH[d] = gs[h][2]; }
    bf16x8 bh[4], bl[4];
#pragma unroll
    for (int s = 0; s < 4; ++s) { unsigned hw[4], lw[4];
#pragma unroll
        for (int j = 0; j < 4; ++j) { const float x0 = rw[s][j][0], x1 = rw[s][j][1];
            const unsigned h = cvt_pk_bf16(x0, x1); hw[j] = h; lw[j] = cvt_pk_bf16(x0 - bf_lo(h), x1 - bf_hi(h)); }
        bh[s] = __builtin_bit_cast(bf16x8, (u32x4){hw[0], hw[1], hw[2], hw[3]}); bl[s] = __builtin_bit_cast(bf16x8, (u32x4){lw[0], lw[1], lw[2], lw[3]}); }
    {
        LAS float* CEP = CE + 16;
        float c[E];
#pragma unroll
        for (int e = 0; e < E; ++e) c[e] = 0.f;
#pragma unroll
        for (int h = 0; h < D / NTHR; ++h) { const float sv = gs[h][2];
#pragma unroll
            for (int q = 0; q < 4; ++q) { const f32x4 wv = cw[h][q]; c[4 * q] += sv * wv[0]; c[4 * q + 1] += sv * wv[1]; c[4 * q + 2] += sv * wv[2]; c[4 * q + 3] += sv * wv[3]; } }
#pragma unroll
        for (int e = 0; e < E; ++e) { const float s = wave_sum(c[e]); if (lane == e) CEP[w * 16 + e] = s; }
        __syncthreads();
        if (X.tid < E) { float s = 0.f;
#pragma unroll
            for (int q = 0; q < 8; ++q) s += CEP[q * 16 + X.tid];
            CE[X.tid] = s; }
    }
    bar();
    RT_ISSUE(a, g0);
#ifdef PROBE_RT
    unsigned long long trt_ = 0; if (X.tid == 0) trt_ = __builtin_amdgcn_s_memrealtime();
#if PROBE_RT == 2
    if (X.tid == 0) ((LAS unsigned long long*)(X.lds + 139264))[1] = trt_ - trs_;
#endif
#endif
    for (int gi = 0; gi < GPW; ++gi) {
        const int g = g0 + gi, par = gi & 1;
        if (gi + 1 < GPW) RT_ISSUE(vn, g + 1);
        float ss = 0.f; f32x4 acc = (f32x4){0.f, 0.f, 0.f, 0.f};
#pragma unroll
        for (int s = 0; s < 4; ++s) {
            const f32x4 g0v = *(const LAS f32x4*)(GP + cbase + 32 * s), g1v = *(const LAS f32x4*)(GP + cbase + 32 * s + 4);
            const f32x4 v0 = a[s][0], v1 = a[s][1];
            ss += (v0[0] * v0[0] + v0[1] * v0[1]) + (v0[2] * v0[2] + v0[3] * v0[3]) + (v1[0] * v1[0] + v1[1] * v1[1]) + (v1[2] * v1[2] + v1[3] * v1[3]);
            const f32x4 x0 = v0 * g0v, x1 = v1 * g1v; a[s][0] = x0; a[s][1] = x1;
            unsigned hw[4], lw[4];
            hw[0] = cvt_pk_bf16(x0[0], x0[1]); hw[1] = cvt_pk_bf16(x0[2], x0[3]); hw[2] = cvt_pk_bf16(x1[0], x1[1]); hw[3] = cvt_pk_bf16(x1[2], x1[3]);
            lw[0] = cvt_pk_bf16(x0[0] - bf_lo(hw[0]), x0[1] - bf_hi(hw[0])); lw[1] = cvt_pk_bf16(x0[2] - bf_lo(hw[1]), x0[3] - bf_hi(hw[1]));
            lw[2] = cvt_pk_bf16(x1[0] - bf_lo(hw[2]), x1[1] - bf_hi(hw[2])); lw[3] = cvt_pk_bf16(x1[2] - bf_lo(hw[3]), x1[3] - bf_hi(hw[3]));
            const bf16x8 ah = __builtin_bit_cast(bf16x8, (u32x4){hw[0], hw[1], hw[2], hw[3]}), al = __builtin_bit_cast(bf16x8, (u32x4){lw[0], lw[1], lw[2], lw[3]});
            acc = __builtin_amdgcn_mfma_f32_16x16x32_bf16(ah, bh[s], acc, 0, 0, 0);
            acc = __builtin_amdgcn_mfma_f32_16x16x32_bf16(ah, bl[s], acc, 0, 0, 0);
            acc = __builtin_amdgcn_mfma_f32_16x16x32_bf16(al, bh[s], acc, 0, 0, 0);
        }
        ss += __shfl_xor(ss, 16); ss += __shfl_xor(ss, 32);
        ACCP[(par * 8 + w) * 64 + lane] = acc;
        if (lane < 16) SSP[(par * 8 + w) * 16 + lane] = ss;
        __syncthreads();
        float rss = 0.f;
#pragma unroll
        for (int q = 0; q < 8; ++q) rss += SSP[(par * 8 + q) * 16 + r];
        const float rstd = 1.f / sqrtf(rss * (1.f / D) + 1e-6f);
        if (w == (gi & 7)) {
            f32x4 lg = (f32x4){0.f, 0.f, 0.f, 0.f};
#pragma unroll
            for (int q = 0; q < 8; ++q) lg += ACCP[(par * 8 + q) * 64 + lane];
            const float ce = CE[r]; f32x4 o;
#pragma unroll
            for (int q = 0; q < 4; ++q) { const float rs = __shfl(rstd, 4 * kq + q); float z = lg[q] * rs + ce; float mx = z;
#pragma unroll
                for (int sft = 1; sft < 16; sft <<= 1) mx = fmaxf(mx, __shfl_xor(mx, sft));
                const float ex = expf(z - mx); float sm = ex;
#pragma unroll
                for (int sft = 1; sft < 16; sft <<= 1) sm += __shfl_xor(sm, sft);
                o[q] = ex / sm; }
            *(GAS f32x4*)(p.AFF + ((size_t)b * E + r) * S + ((g * 16) & (S - 1)) + 4 * kq) = o;
        }
#pragma unroll
        for (int s = 0; s < 4; ++s) {
            const f32x4 s0 = *(const LAS f32x4*)(SH + cbase + 32 * s), s1 = *(const LAS f32x4*)(SH + cbase + 32 * s + 4);
            const f32x4 u0 = a[s][0] * rstd + s0, u1 = a[s][1] * rstd + s1; const size_t off = ((size_t)g * 16 + r) * D + cbase + 32 * s;
            if (MOE_F8) *(GAS u32x2*)((unsigned char*)p.U + off) = pack8_f8(u0, u1, epi::U_SC);
            else *(GAS u32x4*)(p.U + off) = epi::pack8(u0, u1);
        }
#pragma unroll
        for (int s = 0; s < 4; ++s) { a[s][0] = vn[s][0]; a[s][1] = vn[s][1]; }
    }
#undef RT_ISSUE
    __syncthreads();
#ifdef PROBE_RT
    if (PROBE_RT == 1 && X.tid == 0) ((LAS unsigned long long*)(X.lds + 139264))[1] = __builtin_amdgcn_s_memrealtime() - trt_;
#endif
}

__device__ __forceinline__ void phase_topk(const Ctx& X0, const P& p) {
    Ctx X = X0; X.tid = (int)threadIdx.x; asm volatile("" : "+v"(X.tid)); X.lane = X.tid & 63;
    LAS unsigned* cnt = (LAS unsigned*)X.lds;
    LAS unsigned* sc = cnt + 768;
    const int lane = X.lane, w = X.wave, tid = X.tid;
    if (TOPK_BG && MOE_F8 && X.G == 256 && X.vcu >= Bn * E) {
        constexpr int NITM = E * 2 * (D / 64) * (F / 32) + E * (F / 64) * (D / 32), R0 = NITM - P0A_BG * 2048 - TOPK_BG_ITEMS, NW = (256 - Bn * E) * NWAVES;
        static_assert(TOPK_BG_ITEMS % ((256 - Bn * E) * NWAVES) == 0, "top-k phase background items: whole rounds");
        LAS float* scr = (LAS float*)(X.lds + w * 16384);
        const int iw = (X.vcu - Bn * E) * NWAVES + w;
        f32x4 va[8], vb[8]; TItem cur, nx; int j = 0;
        cur = moe_item(p, R0 + iw); titem_load(cur, lane, va);
        for (; j < TOPK_BG_ITEMS / NW; ++j) {
            if (j + 1 < TOPK_BG_ITEMS / NW) { nx = moe_item(p, R0 + iw + (j + 1) * NW); titem_load(nx, lane, vb); }
            titem_store_f8(cur, lane, va, scr, cur.sc);
#pragma unroll
            for (int i = 0; i < 8; ++i) va[i] = vb[i];
            cur = nx;
        }
    }
    for (int be = X.vcu; be < Bn * E; be += X.G) {
        const int b = be / E, e = be % E;
        const float* src = p.AFF + (size_t)be * S + 8 * tid;
        const f32x4 a0 = *(const GAS f32x4*)src, a1 = *(const GAS f32x4*)(src + 4);
        unsigned key[8];
#pragma unroll
        for (int i = 0; i < 4; ++i) { const float f0 = a0[i], f1 = a1[i]; key[i] = __float_as_uint(f0); key[4 + i] = __float_as_uint(f1); }
        unsigned prefix = 0u, need_k = (unsigned)CAP;
        __syncthreads();
        for (int i = tid; i < 3 * 256; i += NTHR) cnt[i] = 0u;
        __syncthreads();
#pragma unroll 1
        for (int pass = 0; pass < 8; ++pass) {
            const int shift = 28 - 4 * pass; LAS unsigned* hist = cnt + (pass % 3) * 256;
            if (tid < 256) cnt[((pass + 1) % 3) * 256 + tid] = 0u;
#pragma unroll
            for (int i = 0; i < 8; ++i) { const bool match = (pass == 0) || ((key[i] >> (shift + 4)) == (prefix >> (shift + 4)));
                if (match) __hip_atomic_fetch_add(hist + (lane & 15) * 16 + ((key[i] >> shift) & 15u), 1u, __ATOMIC_RELAXED, __HIP_MEMORY_SCOPE_WORKGROUP); }
            __syncthreads();
            unsigned c = hist[(4 * (lane >> 4) + 0) * 16 + (lane & 15)] + hist[(4 * (lane >> 4) + 1) * 16 + (lane & 15)] + hist[(4 * (lane >> 4) + 2) * 16 + (lane & 15)] + hist[(4 * (lane >> 4) + 3) * 16 + (lane & 15)];
            c += __shfl_xor(c, 16); c += __shfl_xor(c, 32);
            unsigned cum = 0u, dsel = 0u, below = 0u; bool found = false;
#pragma unroll
            for (int dgt = 15; dgt >= 0; --dgt) { const unsigned cd = (unsigned)__builtin_amdgcn_readlane((int)c, dgt); if (!found) { if (cum + cd >= need_k) { dsel = (unsigned)dgt; below = cum; found = true; } else cum += cd; } }
            prefix |= dsel << shift; need_k -= below;
        }
        const unsigned Tk = prefix;
        unsigned ngt = 0u, neq = 0u;
#pragma unroll
        for (int i = 0; i < 8; ++i) { ngt += key[i] > Tk; neq += key[i] == Tk; }
        unsigned sg = ngt, se = neq;
#pragma unroll
        for (int o = 1; o < 64; o <<= 1) { const unsigned tg = __shfl_up(sg, o), te = __shfl_up(se, o); if (lane >= o) { sg += tg; se += te; } }
        __syncthreads();
        if (lane == 63) { sc[w] = sg; sc[8 + w] = se; }
        __syncthreads();
        unsigned og = 0u, oe = 0u, totg = 0u;
#pragma unroll
        for (int i = 0; i < 8; ++i) { const unsigned g = sc[i], q = sc[8 + i]; if (i < w) { og += g; oe += q; } totg += g; }
        unsigned pg = og + sg - ngt, pe = oe + se - neq;
        const unsigned need = (unsigned)CAP - totg;
        unsigned iv[4] = {0u, 0u, 0u, 0u};
#pragma unroll
        for (int i = 0; i < 8; ++i) {
            const bool gt = key[i] > Tk, eq = key[i] == Tk; const int s = 8 * tid + i;
            const bool sel = gt || (eq && pe < need);
            const unsigned slot = pg + (pe < need ? pe : need);
            if (sel) { p.ROWL[(size_t)e * ME + b * CAP + slot] = b * S + s; p.WTS[(size_t)e * ME + b * CAP + slot] = __uint_as_float(key[i]); }
            iv[i >> 1] |= (sel ? (slot & 0xffffu) : 0xffffu) << (16 * (i & 1));
            pg += gt; pe += eq;
        }
        *(GAS u32x4*)(p.INV + (size_t)be * S + 8 * tid) = (u32x4){iv[0], iv[1], iv[2], iv[3]};
    }
    __syncthreads();
}

__device__ __forceinline__ void phase_final(const Ctx& X0, const P& p) {
    Ctx X = X0; X.tid = (int)threadIdx.x; asm volatile("" : "+v"(X.tid)); X.lane = X.tid & 63;
    const int lane = X.lane, RPW = T / X.G, base = X.vcu * RPW, b = base >> 12;
    f32x4 g2v[4], fgv[4];
#pragma unroll
    for (int j = 0; j < 4; ++j) { g2v[j] = *(const f32x4*)(p.MOD + (size_t)b * NMOD * D + 5 * D + 4 * lane + 256 * j) * (YB_F8 ? 1.f / epi::YB_SC : 1.f); fgv[j] = *(const f32x4*)(p.final_g + 4 * lane + 256 * j); }
#if H_DELTA
#define FN_ISSUE(vx, vd, sl, row) do { const int m_ = base + (row); _Pragma("unroll") for (int j = 0; j < 4; ++j) { vd[j] = *(const GAS u32x2*)(p.DELTA + (size_t)m_ * D + 4 * lane + 256 * j); vx[j] = *(const GAS f32x4*)(p.x + (size_t)m_ * D + 4 * lane + 256 * j); } \
        sl = (lane < E) ? (int)p.INV[((size_t)(b * E + lane)) * S + (m_ & (S - 1))] : -1; } while (0)
    f32x4 nx_[4]; u32x2 nd_[4]; int nslot = -1;
    if (X.wave < RPW) FN_ISSUE(nx_, nd_, nslot, X.wave);
#endif
    for (int i = X.wave; i < RPW; i += NWAVES) {
        const int m = base + i; float* hr = p.out + (size_t)m * D;
        f32x4 v[4];
#if H_DELTA
#pragma unroll
        for (int j = 0; j < 4; ++j) v[j] = nx_[j] + (f32x4){bf_lo(nd_[j].x), bf_hi(nd_[j].x), bf_lo(nd_[j].y), bf_hi(nd_[j].y)};
        const int myslot_pre = nslot;
        if (i + NWAVES < RPW) FN_ISSUE(nx_, nd_, nslot, i + NWAVES);
#else
#pragma unroll
        for (int j = 0; j < 4; ++j) v[j] = *(const GAS f32x4*)(hr + 4 * lane + 256 * j);
#endif
#if H_DELTA
        const int myslot = myslot_pre;
#else
        const int myslot = (lane < E) ? (int)p.INV[((size_t)(b * E + lane)) * S + (m & (S - 1))] : -1;
#endif
        f32x4 y[4];
#pragma unroll
        for (int q = 0; q < 4; ++q) y[q] = (f32x4){0.f, 0.f, 0.f, 0.f};
#pragma unroll
        for (int e = 0; e < E; ++e) { const int slot = __builtin_amdgcn_readlane(myslot, e);
            if (slot >= 0) { const size_t yo = ((size_t)e * ME + b * CAP + slot) * D;
#pragma unroll
                for (int j = 0; j < 4; ++j) {
                    if (YB_F8) { const unsigned wv = *(const GAS unsigned*)((const unsigned char*)p.YB + yo + 4 * lane + 256 * j);
                        const f32x2 lo2 = __builtin_amdgcn_cvt_pk_f32_fp8((int)wv, false), hi2 = __builtin_amdgcn_cvt_pk_f32_fp8((int)wv, true); y[j] += (f32x4){lo2[0], lo2[1], hi2[0], hi2[1]}; }
                    else { const u32x2 wv = *(const GAS u32x2*)(p.YB + yo + 4 * lane + 256 * j); y[j] += (f32x4){bf_lo(wv.x), bf_hi(wv.x), bf_lo(wv.y), bf_hi(wv.y)}; } } } }
        float ss = 0.f;
#pragma unroll
        for (int j = 0; j < 4; ++j) { const f32x4 tt = v[j] + g2v[j] * y[j]; v[j] = tt; ss += (tt[0] * tt[0] + tt[1] * tt[1]) + (tt[2] * tt[2] + tt[3] * tt[3]); }
        const float rstd = 1.f / sqrtf(wave_sum(ss) * (1.f / D) + 1e-6f);
#pragma unroll
        for (int j = 0; j < 4; ++j) *(GAS f32x4*)(hr + 4 * lane + 256 * j) = v[j] * rstd * fgv[j];
    }
#undef FN_ISSUE
}

constexpr size_t MiB = 1u << 20;
constexpr size_t WS_CTL = 0, CTL_ZERO_BYTES = 1 * MiB;
constexpr size_t WS_MOD = 1 * MiB, WS_AFF = 2 * MiB, WS_ROWL = 4 * MiB, WS_WTS = WS_ROWL + 256 * 1024, WS_INV = WS_WTS + 256 * 1024;
constexpr size_t WS_W2F = 6 * MiB, WS_WIN = 10 * MiB, WS_WCONV = 18 * MiB, WS_WFOUR = 19 * MiB, WS_WOUT = 21 * MiB;
constexpr size_t WS_WGU = 24 * MiB, WS_WDOWN = 152 * MiB, WS_U = 216 * MiB, WS_R1 = 280 * MiB, WS_END = 536 * MiB;
constexpr size_t WS_GP = WS_R1, WS_D256 = 23 * MiB, WS_YCONV = WS_R1, WS_V = WS_R1 + 64 * MiB, WS_FT = WS_R1 + 96 * MiB, WS_YFOUR = WS_R1 + 64 * MiB;
constexpr size_t WS_YRI = WS_R1 + 128 * MiB, WS_MERGED = WS_R1 + 128 * MiB, WS_ACONV = WS_R1 + 192 * MiB, WS_ACT = WS_R1 + 128 * MiB  , WS_YB = WS_WGU, WS_DELTA = WS_R1  ;
static_assert(MOE_F8 || !H_DELTA, "the workspace map places the 128 MiB fp8 ACT beside DELTA; a bf16 ACT (256 MiB) needs H_DELTA = 0");
constexpr int LDS_BYTES = 147456, RING_BYTES = 131072, MISC_OFF = RING_BYTES + 320;


#ifndef BARRIER_KIND
#define BARRIER_KIND 2
#endif
#define RLX_AGENT __ATOMIC_RELAXED, __HIP_MEMORY_SCOPE_AGENT
#define XB_TMO      128
#define XB_XCNT(j)  (256  + 64 * (j))
#define XB_XSUB(j)  (1280 + 64 * (j))
#define XB_XGEN(j)  (2304 + 64 * (j))
#define XB_TOP      3328
#define XB_TOPGEN   3392
#define XCD_BAR_WORDS 3456
#define XB_SPIN_CAP (1u << 18)
__device__ __forceinline__ unsigned xb_ld(unsigned* p)              { return __hip_atomic_load(p, __ATOMIC_RELAXED, __HIP_MEMORY_SCOPE_AGENT); }
__device__ __forceinline__ unsigned xb_add(unsigned* p, unsigned v) { return __hip_atomic_fetch_add(p, v, __ATOMIC_RELAXED, __HIP_MEMORY_SCOPE_AGENT); }
__device__ __forceinline__ unsigned xb_xcc_id() { return (unsigned)__builtin_amdgcn_s_getreg((3 << 11) | 20) & 0xFu; }
#define XB_SPIN(cond, bar) do { unsigned _sp = 0; while (cond) { __builtin_amdgcn_s_sleep(1); \
    if ((++_sp & 255u) == 0u) { if (xb_ld(&(bar)[XB_TMO])) break; if (_sp > XB_SPIN_CAP) { atomicAdd(&(bar)[XB_TMO], 1u); break; } } } } while (0)
struct XcdBarrier { unsigned* bar; unsigned x; volatile LAS unsigned* st; };
__device__ __forceinline__ XcdBarrier xcd_barrier_post(unsigned* bar, volatile LAS unsigned* st) {
    XcdBarrier b; b.bar = bar; b.x = xb_xcc_id(); b.st = st;
    if (threadIdx.x == 0) (void)xb_add(&bar[XB_XCNT(b.x)], 1u);
    return b;
}
__device__ __forceinline__ void xcd_barrier_complete(unsigned* bar, unsigned x, unsigned& nloc, unsigned& nx) {
    const unsigned G = gridDim.x * gridDim.y * gridDim.z;
    unsigned sum, cnt, mine, sp = 0u;
    for (;;) {
        sum = 0u; cnt = 0u; mine = 0u;
#pragma unroll
        for (unsigned j = 0; j < 16; ++j) { const unsigned c = xb_ld(&bar[XB_XCNT(j)]); sum += c; cnt += (c > 0u) ? 1u : 0u; mine = (j == x) ? c : mine; }
        if (sum == G) break;
        __builtin_amdgcn_s_sleep(1);
        if ((++sp & 255u) == 0u) { if (xb_ld(&bar[XB_TMO])) break; if (sp > XB_SPIN_CAP) { atomicAdd(&bar[XB_TMO], 1u); break; } }
    }
    nloc = mine > 0u ? mine : 1u; nx = cnt > 0u ? cnt : 1u;
}
__device__ __forceinline__ void xcd_barrier(const XcdBarrier& b) {
    asm volatile("s_waitcnt vmcnt(0)" ::: "memory");
    __syncthreads();
    if (threadIdx.x == 0) {
        unsigned* bar = b.bar;
        __builtin_amdgcn_s_waitcnt(0);
        unsigned nloc = b.st[0], nx = b.st[1];
        if (nloc == 0u) { xcd_barrier_complete(bar, b.x, nloc, nx); b.st[0] = nloc; b.st[1] = nx; }
        const unsigned old = xb_add(&bar[XB_XSUB(b.x)], 1u);
        const unsigned gen = old / nloc;
        if (old + 1u == (gen + 1u) * nloc) {
            __builtin_amdgcn_fence(__ATOMIC_RELEASE, "agent");
            asm volatile("s_waitcnt vmcnt(0)" ::: "memory");
            const unsigned og = xb_add(&bar[XB_TOP], 1u);
            const unsigned tg = og / nx;
            if (og + 1u == (tg + 1u) * nx) xb_add(&bar[XB_TOPGEN], 1u);
            else XB_SPIN(xb_ld(&bar[XB_TOPGEN]) == tg, bar);
            __builtin_amdgcn_fence(__ATOMIC_ACQUIRE, "agent");
            xb_add(&bar[XB_XGEN(b.x)], 1u);
            asm volatile("s_waitcnt vmcnt(0)" ::: "memory");
        } else {
            XB_SPIN(xb_ld(&bar[XB_XGEN(b.x)]) == gen, bar);
            __builtin_amdgcn_fence(__ATOMIC_ACQUIRE, "agent");
            asm volatile("s_waitcnt vmcnt(0)" ::: "memory");
        }
    }
    __syncthreads();
}
constexpr int CW_BAR = 4096;

struct Args { P p; unsigned* ctl; int ph_lo, ph_hi; };

__global__ void __launch_bounds__(NTHR, 2) mk_fwd(Args args) {
    extern __shared__ __attribute__((aligned(16))) unsigned char lds_raw[];
    Ctx X; X.lds = (LAS unsigned char*)lds_raw; X.tid = threadIdx.x; X.lane = X.tid & 63; X.wave = __builtin_amdgcn_readfirstlane(X.tid >> 6);
    X.G = gridDim.x; { const int bx = blockIdx.x; X.vcu = (X.G % 8 == 0) ? (bx % 8) * (X.G / 8) + bx / 8 : bx; }
    const P& p = args.p; const int lo = args.ph_lo, hi = args.ph_hi;
    const int cid = (int)blockIdx.x;
#define IN(k) (lo <= (k) && (k) < hi)
    for (int u = X.tid; u < (LDS_BYTES - RING_BYTES) / 4; u += NTHR) ((LAS unsigned*)(X.lds + RING_BYTES))[u] = 0u;
    __syncthreads();
#if BARRIER_KIND == 1
    cooperative_groups::grid_group cgrid = cooperative_groups::this_grid();
#define GRID_BAR() do { if (hi - lo > 1) cgrid.sync(); } while (0)
#else
    XcdBarrier xbar = xcd_barrier_post(args.ctl + CW_BAR, (volatile LAS unsigned*)(X.lds + MISC_OFF));
#define GRID_BAR() do { if (hi - lo > 1) xcd_barrier(xbar); } while (0)
#endif
#ifdef PROBE_A
    volatile unsigned long long* ts = (volatile unsigned long long*)(args.ctl + 65536);
    int n_stamp = 0;
#ifdef PROBE_EPI
#ifndef PROBE_BLK
#define PROBE_BLK 0
#endif
#define STAMP() do { if (X.tid == 0) { if (blockIdx.x == 0) ts[n_stamp] = __builtin_amdgcn_s_memrealtime(); ((LAS unsigned long long*)(X.lds + 139264))[0] = (n_stamp == PROBE_A) ? 1ull : 0ull; } ++n_stamp; __syncthreads(); } while (0)
#else
#define STAMP() do { if (blockIdx.x == 0 && X.tid == 0) ts[n_stamp] = __builtin_amdgcn_s_memrealtime(); ++n_stamp; } while (0)
#endif
#else
#define STAMP() do { } while (0)
#endif
    STAMP();
    if (IN(0)) { phase_p0a(X, p); GRID_BAR(); STAMP(); }
    if (IN(1)) { phase_p0b(X, p); GRID_BAR(); STAMP(); }
    if (IN(2)) {
#if IN_I8
        { pg8::SchedDense Sd; Sd.init(p.U8X, p.Wt_in, T, 2 * CW, D / 2, X.G, cid); epi::EpiGlu Ep{p.V, p.b_in, P_USC(p), P_WSC(p)};
          pg8::gemm_phase<epi::EpiGlu, pg8::SchedDense, false, false, true, false>(X.lds, D, Sd, Ep); }
        { pg8::SchedDense Sd; Sd.init((const unsigned char*)p.Wt_in + (size_t)(2 * CW) * D, p.U8X, FW, T, D / 2, X.G, cid); epi::EpiFT Ep{p.FT, p.b_in + 2 * CW, P_USC(p), P_WSC(p) + 2 * CW};
          pg8::gemm_phase<epi::EpiFT, pg8::SchedDense, false, false, true>(X.lds, D, Sd, Ep); }
#else
#if IN_F8_GLU
        { pg8::SchedDense Sd; Sd.init(p.U8X, p.Wt_in, T, 2 * CW, D / 2, X.G, cid); epi::EpiGlu Ep{p.V, p.b_in, nullptr, nullptr};
          pg8::gemm_phase<epi::EpiGlu, pg8::SchedDense, false, true>(X.lds, D, Sd, Ep, epi::MX_W, epi::MX_U); }
#else
        { pg8::SchedDense Sd; Sd.init(p.U, p.Wt_in, T, 2 * CW, D, X.G, cid); epi::EpiGlu Ep{p.V, p.b_in, nullptr, nullptr};
          pg8::gemm_phase<epi::EpiGlu, pg8::SchedDense, false>(X.lds, 2 * D, Sd, Ep); }
#endif
#if IN_F8_FT
        { pg8::SchedDense Sd; Sd.init((const unsigned char*)p.Wt_in + FT8_OFF, p.U8X, FW, T, D / 2, X.G, cid); epi::EpiFT Ep{p.FT, p.b_in + 2 * CW, nullptr, nullptr};
          pg8::gemm_phase<epi::EpiFT, pg8::SchedDense, false, true>(X.lds, D, Sd, Ep, epi::MX_U, epi::MX_W); }
#else
        { pg8::SchedDense Sd; Sd.init(p.Wt_in + (size_t)(2 * CW) * D, p.U, FW, T, D, X.G, cid); epi::EpiFT Ep{p.FT, p.b_in + 2 * CW, nullptr, nullptr};
          pg8::gemm_phase<epi::EpiFT, pg8::SchedDense, false>(X.lds, 2 * D, Sd, Ep); }
#endif
#endif
        GRID_BAR(); STAMP();
    }
    if (IN(3)) {
        phase_convfft(X, p);
        GRID_BAR(); STAMP();
#if FFT_I8
        { pg8::SchedDense Sd; Sd.init(p.D256, p.GP, 512, Bn * 16 * FW, 256, X.G, cid); epi::EpiFFT Ep{p.YRI, P_GSC(p)};
          pg8::gemm_phase<epi::EpiFFT, pg8::SchedDense, false, false, true>(X.lds, 512, Sd, Ep); }
#else
        { pg8::SchedDense Sd; Sd.init(p.D256, p.GP, 512, Bn * 16 * FW, 512, X.G, cid); epi::EpiFFT Ep{p.YRI, nullptr};
          pg8::gemm_phase<epi::EpiFFT, pg8::SchedDense, false>(X.lds, 2 * 512, Sd, Ep); }
#endif
        GRID_BAR(); STAMP();
    }
    if (IN(4)) {
#if CONV_I8
        { pg8::SchedDense Sd; Sd.init(p.ACONV, p.Wt_conv, T, D, CW / 2, X.G, cid); epi::EpiBiasI8 Ep{p.YCONV, D, p.cb_out, P_ASC(p), P_WSC(p) + 4096};
          pg8::gemm_phase<epi::EpiBiasI8, pg8::SchedDense, false, false, true, false>(X.lds, CW, Sd, Ep); }
#else
        { pg8::SchedDense Sd; Sd.init(p.ACONV, p.Wt_conv, T, D, CW, X.G, cid); epi::EpiBias Ep{p.YCONV, D, p.cb_out};
          pg8::gemm_phase<epi::EpiBias, pg8::SchedDense, false>(X.lds, 2 * CW, Sd, Ep); }
#endif
        { pg8::SchedDense Sd; Sd.init(p.YRI, p.Wt_four, T, D, 2 * FW, X.G, cid); epi::EpiBias Ep{p.YFOUR, D, p.four_b};
          pg8::gemm_phase<epi::EpiBias, pg8::SchedDense, false, false, false, !(OWN_MERGE && IN_I8)>(X.lds, 4 * FW, Sd, Ep); }
#if OWN_MERGE && IN_I8
        STAMP();
#else
        GRID_BAR(); STAMP();
#endif
    }
    if (IN(5)) {
        epi::EpiMerge Ep{p.MERGED, p.YCONV, p.YFOUR, p.b_in, P_USC(p), P_WSC(p) + 2 * CW + FW};
#ifdef STAGGER_MERGE
        if ((cid >> 3) & 1) { const unsigned long long t0_ = __builtin_amdgcn_s_memrealtime(); while (__builtin_amdgcn_s_memrealtime() - t0_ < (unsigned long long)STAGGER_MERGE) __builtin_amdgcn_s_sleep(4); }
#endif
#if IN_I8 && OWN_MERGE
        pg8::SchedOwn2 Sd; Sd.init(p.U8X, (const unsigned char*)p.Wt_in + (size_t)(2 * CW + FW) * D, T, D, D / 2, X.G, cid);
        pg8::gemm_phase<epi::EpiMerge, pg8::SchedOwn2, false, false, true>(X.lds, D, Sd, Ep);
#elif IN_I8
        pg8::SchedDense Sd; Sd.init(p.U8X, (const unsigned char*)p.Wt_in + (size_t)(2 * CW + FW) * D, T, 2 * D, D / 2, X.G, cid);
        pg8::gemm_phase<epi::EpiMerge, pg8::SchedDense, false, false, true>(X.lds, D, Sd, Ep);
#elif GATE_F8
        pg8::SchedDense Sd; Sd.init(p.U8X, p.Wt_g8, T, 2 * D, D / 2, X.G, cid);
        pg8::gemm_phase<epi::EpiMerge, pg8::SchedDense, false, true>(X.lds, D, Sd, Ep, epi::MX_W, epi::MX_U);
#else
        pg8::SchedDense Sd; Sd.init(p.U, p.Wt_in + (size_t)(2 * CW + FW) * D, T, 2 * D, D, X.G, cid);
        pg8::gemm_phase<epi::EpiMerge, pg8::SchedDense, false>(X.lds, 2 * D, Sd, Ep);
#endif
        GRID_BAR(); STAMP();
    }
    if (IN(6)) {
        pg8::SchedDense Sd; Sd.init(p.MERGED, p.Wt_out, T, D, OUT_F8 ? D / 2 : D, X.G, cid);
#if H_DELTA
        epi::EpiDelta Ep{p.DELTA, p.MOD + 2 * D, p.b_out};
        pg8::gemm_phase<epi::EpiDelta, pg8::SchedDense, false, OUT_F8 != 0>(X.lds, OUT_F8 ? D : 2 * D, Sd, Ep, epi::MX_W, epi::MX_U);
#else
        epi::EpiResid Ep{p.x, p.out, p.MOD + 2 * D, p.b_out};
        pg8::gemm_phase<epi::EpiResid, pg8::SchedDense, false>(X.lds, 2 * D, Sd, Ep);
#endif
        if (!IN(7)) { GRID_BAR(); STAMP(); }
    }
    if (IN(7)) { phase_router(X, p, H_DELTA ? p.x : p.out, [&]() { if (IN(6)) { GRID_BAR(); STAMP(); } }); GRID_BAR(); STAMP(); }
    if (IN(8)) { phase_topk(X, p); GRID_BAR(); STAMP(); }
    if (IN(9)) {
        constexpr int esz = MOE_F8 ? 1 : 2;
        pg8::SchedG1 Sd{(const char*)p.U, (const char*)p.Wt_gu, p.ROWL, X.G, cid, esz}; epi::EpiSwiglu<MOE_F8 != 0> Ep{p.ACT};
        pg8::gemm_phase<epi::EpiSwiglu<MOE_F8 != 0>, pg8::SchedG1, true, MOE_F8 != 0>(X.lds, D * esz, Sd, Ep, epi::MX_W, epi::MX_U);
        GRID_BAR(); STAMP();
    }
    if (IN(10)) {
        constexpr int esz = MOE_F8 ? 1 : 2;
        pg8::SchedG2 Sd{(const char*)p.ACT, (const char*)p.Wt_down, X.G, cid, esz}; epi::EpiScaleW Ep{p.YB, p.WTS};
        pg8::gemm_phase<epi::EpiScaleW, pg8::SchedG2, false, MOE_F8 != 0>(X.lds, F * esz, Sd, Ep, epi::MX_W, epi::MX_ACT);
        GRID_BAR(); STAMP();
    }
    if (IN(11)) { phase_final(X, p); }
#ifdef PROBE_A
    STAMP();
#ifdef PROBE_EPI
    if (blockIdx.x == PROBE_BLK && X.tid == 0) { ts[40] = ((LAS unsigned long long*)(X.lds + 139264))[1]; __threadfence(); ts[41] = 1ull; }
    if (blockIdx.x == 0 && X.tid == 0) { while (__hip_atomic_load((unsigned long long*)&ts[41], __ATOMIC_RELAXED, __HIP_MEMORY_SCOPE_AGENT) == 0ull) __builtin_amdgcn_s_sleep(8); __threadfence(); }
#endif
    if (blockIdx.x == 0 && X.tid == 0) {
#ifdef PROBE_EPI
        const unsigned long long dt = ts[40] * PROBE_AMP, t0 = __builtin_amdgcn_s_memrealtime();
#else
        const unsigned long long dt = (ts[PROBE_B] - ts[PROBE_A]) * PROBE_AMP, t0 = __builtin_amdgcn_s_memrealtime();
#endif

        while (__builtin_amdgcn_s_memrealtime() - t0 < dt) __builtin_amdgcn_s_sleep(8); }
#endif
#undef IN
}

extern "C" void kernel_launch(void* const* d_in, const int* in_sizes, int n_in, void* d_out, int out_size, void* d_ws, size_t ws_size, hipStream_t stream) {
    static int grid = 0;
    if (grid == 0) {
        if (n_in != 23 || in_sizes[0] != T * D || out_size != T * D || ws_size < WS_END) { fprintf(stderr, "kernel_launch: unexpected shapes / workspace (%d inputs, ws %zu)\n", n_in, ws_size); grid = -1; return; }
        int dev = 0, cus = 0;
        if (hipGetDevice(&dev) != hipSuccess || hipDeviceGetAttribute(&cus, hipDeviceAttributeMultiprocessorCount, dev) != hipSuccess) { grid = -1; return; }
        if (hipFuncSetAttribute((const void*)mk_fwd, hipFuncAttributeMaxDynamicSharedMemorySize, LDS_BYTES) != hipSuccess) { fprintf(stderr, "kernel_launch: hipFuncSetAttribute failed\n"); grid = -1; return; }
        if (cus < 256) { fprintf(stderr, "kernel_launch: built for a 256-CU device (one workgroup per CU), found %d CUs\n", cus); grid = -1; return; }
        int per_cu = 0;
        if (hipOccupancyMaxActiveBlocksPerMultiprocessor(&per_cu, (const void*)mk_fwd, NTHR, LDS_BYTES) != hipSuccess || per_cu < 1) { fprintf(stderr, "kernel_launch: occupancy query reports %d workgroups per CU\n", per_cu); grid = -1; return; }
        grid = 256;
    }
    if (grid < 0) return;
    unsigned char* ws = (unsigned char*)d_ws;
    Args a{};
    P& p = a.p;
    p.x = (const float*)d_in[0]; p.c = (const float*)d_in[1]; p.ada_w = (const float*)d_in[2]; p.ada_b = (const float*)d_in[3]; p.norm1_g = (const float*)d_in[4];
    p.w_in = (const float*)d_in[5]; p.b_in = (const float*)d_in[6]; p.dw_w = (const float*)d_in[7]; p.dw_b = (const float*)d_in[8]; p.cln_g = (const float*)d_in[9]; p.cln_b = (const float*)d_in[10];
    p.cw_out = (const float*)d_in[11]; p.cb_out = (const float*)d_in[12]; p.four_w = (const float*)d_in[13]; p.four_b = (const float*)d_in[14]; p.w_out = (const float*)d_in[15]; p.b_out = (const float*)d_in[16];
    p.norm2_g = (const float*)d_in[17]; p.router_w = (const float*)d_in[18]; p.w_gate = (const float*)d_in[19]; p.w_up = (const float*)d_in[20]; p.w_down = (const float*)d_in[21]; p.final_g = (const float*)d_in[22];
    p.out = (float*)d_out;
    p.MOD = (float*)(ws + WS_MOD); p.W2F = (float*)(ws + WS_W2F); p.AFF = (float*)(ws + WS_AFF); p.ROWL = (int*)(ws + WS_ROWL); p.WTS = (float*)(ws + WS_WTS); p.INV = (short*)(ws + WS_INV);
    p.Wt_in = (bf16_t*)(ws + WS_WIN); p.Wt_conv = (bf16_t*)(ws + WS_WCONV); p.Wt_four = (bf16_t*)(ws + WS_WFOUR); p.Wt_out = (bf16_t*)(ws + WS_WOUT);
    p.D256 = (bf16_t*)(ws + WS_D256); p.GP = (bf16_t*)(ws + WS_GP); p.Wt_gu = (bf16_t*)(ws + WS_WGU); p.Wt_down = (bf16_t*)(ws + WS_WDOWN);
    p.U = (bf16_t*)(ws + WS_U); p.V = (bf16_t*)(ws + WS_V); p.FT = (bf16_t*)(ws + WS_FT); p.ACONV = (bf16_t*)(ws + WS_ACONV); p.YRI = (bf16_t*)(ws + WS_YRI);
    p.YCONV = (bf16_t*)(ws + WS_YCONV); p.YFOUR = (bf16_t*)(ws + WS_YFOUR); p.MERGED = (bf16_t*)(ws + ((OWN_MERGE && IN_I8) ? WS_U   : WS_MERGED)); p.ACT = (bf16_t*)(ws + WS_ACT); p.YB = (bf16_t*)(ws + WS_YB); p.DELTA = (bf16_t*)(ws + WS_DELTA); p.U8X = ws + WS_R1 + 224 * MiB  ; p.Wt_g8 = ws + WS_WIN + (size_t)(2 * CW + FW) * D * 2  ;
    (void)hipMemsetAsync(ws + WS_CTL, 0, CTL_ZERO_BYTES, stream);
    a.ctl = (unsigned*)(ws + WS_CTL);
    a.ph_lo = 0; a.ph_hi = 12;
#ifndef PLAIN_LAUNCH
#define PLAIN_LAUNCH 0
#endif
#if PLAIN_LAUNCH
    hipLaunchKernelGGL(mk_fwd, dim3(grid), dim3(NTHR), LDS_BYTES, stream, a);
#else
    { void* kargs[] = {&a}; hipError_t le = hipLaunchCooperativeKernel((const void*)mk_fwd, dim3(grid), dim3(NTHR), kargs, LDS_BYTES, stream);
      if (le != hipSuccess) fprintf(stderr, "kernel_launch: cooperative launch failed: %s\n", hipGetErrorString(le)); }
#endif
}
```
